# Optimizing an MI355X kernel written in HIP

```python
import math
import jax, jax.numpy as jnp
from jax import lax
import numpy as np

D_MODEL = 4096
BATCH = 4
SEQ = 2048
DEPTH = 2

HEAD_DIM = 128
CONV_W = 4
GDN_HEADS = D_MODEL // 256
GDN_WIDTH = GDN_HEADS * HEAD_DIM
GDN_CHUNK = 64
RG_WIDTH = D_MODEL // 2
RG_BLOCK = 128
RG_BLOCKS = RG_WIDTH // RG_BLOCK
LRU_C = 8.0
SB_HEADS = D_MODEL // 256
SB_WIDTH = SB_HEADS * HEAD_DIM
SB_BLOCK = 128
S5_WIDTH = D_MODEL // 4
S5_GROUP = 16
S5_GROUPS = S5_WIDTH // S5_GROUP
S5_STATE = 64
PEER_HEADS = 8
PEER_NKEYS = 128
PEER_EXPERTS = PEER_NKEYS * PEER_NKEYS
PEER_QDIM = 256
PEER_HALF = PEER_QDIM // 2
PEER_TOPK = 16
PEER_TOKEN_BLOCK = 64
N_EVEN = (DEPTH + 1) // 2
N_ODD = DEPTH // 2
DN_ALPHA = (2.0 * DEPTH) ** 0.25
DN_BETA = (8.0 * DEPTH) ** -0.25
LN_EPS = 1e-5
RMS_EPS = 1e-6
EVEN_IN = 4 * GDN_WIDTH + 2 * GDN_HEADS + 2 * RG_WIDTH
EVEN_MIX = GDN_WIDTH + RG_WIDTH
ODD_IN = 3 * SB_WIDTH + S5_WIDTH
ODD_MIX = SB_WIDTH + S5_WIDTH

kernel_name = 'hybrid_gdn_rglru_stickbreak_s5_peer'


def _split(t, sizes):
    idx = [int(i) for i in np.cumsum(sizes)[:-1]]
    return jnp.split(t, idx, axis=-1)


def layer_norm(x, g, b):
    xf = x.astype(jnp.float32)
    mu = jnp.mean(xf, -1, keepdims=True)
    var = jnp.mean(jnp.square(xf - mu), -1, keepdims=True)
    return (xf - mu) * lax.rsqrt(var + LN_EPS) * g.astype(jnp.float32) + b.astype(jnp.float32)


def l2norm(t):
    return t * lax.rsqrt(jnp.sum(t * t, -1, keepdims=True) + RMS_EPS)


def causal_dwconv(x, w):
    S_ = x.shape[1]
    xp = jnp.pad(x, ((0, 0), (CONV_W - 1, 0), (0, 0)))
    return sum(w[k] * xp[:, k:k + S_] for k in range(CONV_W))


def _linear_combine(e1, e2):
    a1, b1 = e1
    a2, b2 = e2
    return a1 * a2, a2 * b1 + b2


def _complex_combine(e1, e2):
    a1r, a1i, b1r, b1i = e1
    a2r, a2i, b2r, b2i = e2
    return (a2r * a1r - a2i * a1i, a2r * a1i + a2i * a1r,
            a2r * b1r - a2i * b1i + b2r, a2r * b1i + a2i * b1r + b2i)


def gated_delta_rule(q, k, v, g, beta):
    B_, S_, H, dk = q.shape
    dv = v.shape[-1]
    C = GDN_CHUNK
    n = S_ // C

    def to_chunks(t):
        t = t.reshape((B_, n, C, H) + t.shape[3:])
        return t.transpose((1, 0, 3, 2) + tuple(range(4, t.ndim)))

    q, k, v, g, beta = [to_chunks(t) for t in (q, k, v, g, beta)]
    gc = jnp.cumsum(g, axis=-1)
    idx = jnp.arange(C)
    causal = idx[:, None] >= idx[None, :]
    gamma = jnp.exp(jnp.where(causal, gc[..., :, None] - gc[..., None, :], -jnp.inf))
    kb = k * beta[..., None]
    m = jnp.einsum('nbhid,nbhjd->nbhij', kb, k) * gamma
    m = jnp.where(idx[:, None] > idx[None, :], m, 0.0)
    eye = jnp.eye(C, dtype=m.dtype)
    t_inv = lax.linalg.triangular_solve(m + eye, jnp.broadcast_to(eye, m.shape),
                                        left_side=True, lower=True, unit_diagonal=True)
    u = t_inv @ (v * beta[..., None])
    w = t_inv @ (kb * jnp.exp(gc)[..., None])
    a_qk = jnp.einsum('nbhid,nbhjd->nbhij', q, k) * gamma
    g_last = gc[..., -1]
    k_tail = k * jnp.exp(g_last[..., None] - gc)[..., None]
    q_dec = q * jnp.exp(gc)[..., None]

    def step(state, inp):
        u_i, w_i, qd_i, a_i, kt_i, gl_i = inp
        v_new = u_i - w_i @ state
        o_i = qd_i @ state + a_i @ v_new
        state = state * jnp.exp(gl_i)[..., None, None] + jnp.swapaxes(kt_i, -1, -2) @ v_new
        return state, o_i

    s0 = jnp.zeros((B_, H, dk, dv), jnp.float32)
    _, o = lax.scan(step, s0, (u, w, q_dec, a_qk, k_tail, g_last))
    return o.transpose(1, 0, 3, 2, 4).reshape(B_, S_, H, dv)


def even_mixer(x, w_in, gdn_conv_w, gdn_A_log, gdn_dt_bias, gdn_norm_w,
               rg_conv_w, rg_conv_b, rg_wa, rg_ba, rg_wx, rg_bx, rg_lambda, w_out):
    f32 = jnp.float32
    B_, S_, _ = x.shape
    proj = x @ w_in
    qkv, z, a_raw, b_raw, rg_in, rg_gate = _split(
        proj, [3 * GDN_WIDTH, GDN_WIDTH, GDN_HEADS, GDN_HEADS, RG_WIDTH, RG_WIDTH])
    qkv = jax.nn.silu(causal_dwconv(qkv, gdn_conv_w).astype(f32))
    q, k, v = [t.reshape(B_, S_, GDN_HEADS, HEAD_DIM) for t in jnp.split(qkv, 3, axis=-1)]
    q = l2norm(q) * HEAD_DIM ** -0.5
    k = l2norm(k)
    beta = jax.nn.sigmoid(b_raw.astype(f32))
    g = -jnp.exp(gdn_A_log.astype(f32)) * jax.nn.softplus(a_raw.astype(f32) + gdn_dt_bias.astype(f32))
    o = gated_delta_rule(q, k, v, g, beta)
    o = o * lax.rsqrt(jnp.mean(o * o, -1, keepdims=True) + RMS_EPS) * gdn_norm_w.astype(f32)
    o = o * jax.nn.silu(z.astype(f32).reshape(B_, S_, GDN_HEADS, HEAD_DIM))
    gdn_out = o.reshape(B_, S_, GDN_WIDTH)
    xr = (causal_dwconv(rg_in, rg_conv_w) + rg_conv_b).astype(f32)
    xb = xr.reshape(B_, S_, RG_BLOCKS, RG_BLOCK)
    r = jax.nn.sigmoid(jnp.einsum('bsni,nij->bsnj', xb, rg_wa.astype(f32)).reshape(B_, S_, RG_WIDTH)
                       + rg_ba.astype(f32))
    i_g = jax.nn.sigmoid(jnp.einsum('bsni,nij->bsnj', xb, rg_wx.astype(f32)).reshape(B_, S_, RG_WIDTH)
                         + rg_bx.astype(f32))
    log_a = -LRU_C * r * jax.nn.softplus(-rg_lambda.astype(f32))
    a = jnp.exp(log_a)
    b = jnp.sqrt(jnp.maximum(-jnp.expm1(2.0 * log_a), 0.0)) * (i_g * xr)
    _, h = lax.associative_scan(_linear_combine, (a, b), axis=1)
    rg_out = h * jax.nn.gelu(rg_gate.astype(f32))
    mixed = jnp.concatenate([gdn_out, rg_out], axis=-1).astype(w_out.dtype)
    return mixed @ w_out


def stick_breaking_attention(q, k, v):
    S_ = q.shape[2]
    d = q.shape[-1]
    outs = []
    for blk in range(S_ // SB_BLOCK):
        t0 = blk * SB_BLOCK
        end = t0 + SB_BLOCK
        z = jnp.einsum('bhtd,bhsd->bhts', q[:, :, t0:end], k[:, :, :end]) * d ** -0.5
        t_pos = t0 + jnp.arange(SB_BLOCK)
        s_pos = jnp.arange(end)
        mask = s_pos[None, :] < t_pos[:, None]
        log1m = jnp.where(mask, jax.nn.log_sigmoid(-z), 0.0)
        tail = lax.cumsum(log1m, axis=3, reverse=True) - log1m
        wts = jnp.where(mask, jnp.exp(jax.nn.log_sigmoid(z) + tail), 0.0)
        outs.append(jnp.einsum('bhts,bhsd->bhtd', wts, v[:, :, :end]))
    return jnp.concatenate(outs, axis=2)


def s5_ssm(u, A_re, A_im, log_dt, B_re, B_im, C_re, C_im, D):
    f32 = jnp.float32
    B_, S_, _ = u.shape
    ug = u.reshape(B_, S_, S5_GROUPS, S5_GROUP)
    dt = jnp.exp(log_dt.astype(f32))[:, None]
    lr = jnp.minimum(A_re.astype(f32), -1e-4)
    li = A_im.astype(f32)
    mag = jnp.exp(lr * dt)
    ab_re = mag * jnp.cos(li * dt)
    ab_im = mag * jnp.sin(li * dt)
    den = lr * lr + li * li
    nr = ab_re - 1.0
    ni = ab_im
    cr = (nr * lr + ni * li) / den
    ci = (ni * lr - nr * li) / den
    br_, bi_ = B_re.astype(f32), B_im.astype(f32)
    bb_re = cr[..., None] * br_ - ci[..., None] * bi_
    bb_im = cr[..., None] * bi_ + ci[..., None] * br_
    bu_re = jnp.einsum('bsgc,gnc->bsgn', ug, bb_re)
    bu_im = jnp.einsum('bsgc,gnc->bsgn', ug, bb_im)
    a_re = jnp.broadcast_to(ab_re, bu_re.shape)
    a_im = jnp.broadcast_to(ab_im, bu_re.shape)
    _, _, h_re, h_im = lax.associative_scan(_complex_combine, (a_re, a_im, bu_re, bu_im), axis=1)
    y = (jnp.einsum('bsgn,gcn->bsgc', h_re, C_re.astype(f32))
         - jnp.einsum('bsgn,gcn->bsgc', h_im, C_im.astype(f32)))
    return y.reshape(B_, S_, S5_WIDTH) + D.astype(f32) * u


def odd_mixer(x, w_in, s5_A_re, s5_A_im, s5_log_dt, s5_B_re, s5_B_im, s5_C_re, s5_C_im,
              s5_D, s5_glu_w, s5_glu_b, w_out):
    f32 = jnp.float32
    B_, S_, _ = x.shape
    proj = x @ w_in
    q, k, v, u = _split(proj, [SB_WIDTH, SB_WIDTH, SB_WIDTH, S5_WIDTH])
    heads = lambda t: t.astype(f32).reshape(B_, S_, SB_HEADS, HEAD_DIM).transpose(0, 2, 1, 3)
    sb = stick_breaking_attention(heads(q), heads(k), heads(v))
    sb_out = sb.transpose(0, 2, 1, 3).reshape(B_, S_, SB_WIDTH)
    y = s5_ssm(u.astype(f32), s5_A_re, s5_A_im, s5_log_dt, s5_B_re, s5_B_im, s5_C_re, s5_C_im, s5_D)
    yg = jax.nn.gelu(y)
    s5_out = yg * jax.nn.sigmoid(yg @ s5_glu_w.astype(f32) + s5_glu_b.astype(f32))
    mixed = jnp.concatenate([sb_out, s5_out], axis=-1).astype(w_out.dtype)
    return mixed @ w_out


def peer_ffn(x, wq, keys, U, V):
    B_, S_, Dm = x.shape
    T = B_ * S_
    xt = x.reshape(T, Dm)
    q = (xt @ wq).astype(jnp.float32).reshape(T, PEER_HEADS, 2, PEER_HALF)
    kf = keys.astype(jnp.float32)
    s1 = jnp.einsum('thd,hnd->thn', q[:, :, 0], kf[:, 0])
    s2 = jnp.einsum('thd,hnd->thn', q[:, :, 1], kf[:, 1])
    v1, i1 = lax.top_k(s1, PEER_TOPK)
    v2, i2 = lax.top_k(s2, PEER_TOPK)
    cand = (v1[..., :, None] + v2[..., None, :]).reshape(T, PEER_HEADS, PEER_TOPK * PEER_TOPK)
    sc, pos = lax.top_k(cand, PEER_TOPK)
    expert = (jnp.take_along_axis(i1, pos // PEER_TOPK, axis=-1) * PEER_NKEYS
              + jnp.take_along_axis(i2, pos % PEER_TOPK, axis=-1))
    gate = jax.nn.softmax(sc, axis=-1)
    nb = T // PEER_TOKEN_BLOCK

    def block_fn(args):
        xb, eb, gb = args
        act = jax.nn.gelu(jnp.einsum('phkd,pd->phk', U[eb], xb).astype(jnp.float32))
        wts = (gb * act).astype(V.dtype)
        return jnp.einsum('phk,phkd->pd', wts, V[eb])

    out = lax.map(block_fn, (xt.reshape(nb, PEER_TOKEN_BLOCK, Dm),
                             expert.reshape(nb, PEER_TOKEN_BLOCK, PEER_HEADS, PEER_TOPK),
                             gate.reshape(nb, PEER_TOKEN_BLOCK, PEER_HEADS, PEER_TOPK)))
    return out.reshape(B_, S_, Dm)


def setup_inputs(seed: int = 0) -> dict:
    key = jax.random.key(seed)
    ks = iter(jax.random.split(key, 48))
    f32 = jnp.float32
    nrm = lambda shape, std: jax.random.normal(next(ks), shape, f32) * std
    unif = lambda shape, lo, hi: jax.random.uniform(next(ks), shape, f32, lo, hi)
    dt_g = jnp.exp(unif((N_EVEN, GDN_HEADS), math.log(1e-3), math.log(1e-1)))
    p_lru = unif((N_EVEN, RG_WIDTH), 0.9, 0.999) ** (1.0 / LRU_C)
    return {
        'x': nrm((BATCH, SEQ, D_MODEL), 1.0),
        'w_in_e': nrm((N_EVEN, D_MODEL, EVEN_IN), D_MODEL ** -0.5),
        'gdn_conv_w': nrm((N_EVEN, CONV_W, 3 * GDN_WIDTH), CONV_W ** -0.5),
        'gdn_A_log': jnp.log(unif((N_EVEN, GDN_HEADS), 1.0, 16.0)),
        'gdn_dt_bias': dt_g + jnp.log(-jnp.expm1(-dt_g)),
        'gdn_norm_w': 1.0 + nrm((N_EVEN, HEAD_DIM), 0.01),
        'rg_conv_w': nrm((N_EVEN, CONV_W, RG_WIDTH), CONV_W ** -0.5),
        'rg_conv_b': nrm((N_EVEN, RG_WIDTH), 0.01),
        'rg_wa': nrm((N_EVEN, RG_BLOCKS, RG_BLOCK, RG_BLOCK), RG_BLOCK ** -0.5),
        'rg_ba': nrm((N_EVEN, RG_WIDTH), 0.01),
        'rg_wx': nrm((N_EVEN, RG_BLOCKS, RG_BLOCK, RG_BLOCK), RG_BLOCK ** -0.5),
        'rg_bx': nrm((N_EVEN, RG_WIDTH), 0.01),
        'rg_lambda': jnp.log(p_lru) - jnp.log1p(-p_lru),
        'w_out_e': nrm((N_EVEN, EVEN_MIX, D_MODEL), EVEN_MIX ** -0.5 * DN_BETA),
        'w_in_o': nrm((N_ODD, D_MODEL, ODD_IN), D_MODEL ** -0.5),
        's5_A_re': -0.5 + nrm((N_ODD, S5_GROUPS, S5_STATE), 0.01),
        's5_A_im': math.pi * jnp.arange(S5_STATE, dtype=f32) + nrm((N_ODD, S5_GROUPS, S5_STATE), 0.01),
        's5_log_dt': unif((N_ODD, S5_GROUPS), math.log(1e-3), math.log(1e-1)),
        's5_B_re': nrm((N_ODD, S5_GROUPS, S5_STATE, S5_GROUP), (2 * S5_GROUP) ** -0.5),
        's5_B_im': nrm((N_ODD, S5_GROUPS, S5_STATE, S5_GROUP), (2 * S5_GROUP) ** -0.5),
        's5_C_re': nrm((N_ODD, S5_GROUPS, S5_GROUP, S5_STATE), 0.5),
        's5_C_im': nrm((N_ODD, S5_GROUPS, S5_GROUP, S5_STATE), 0.5),
        's5_D': nrm((N_ODD, S5_WIDTH), 0.5),
        's5_glu_w': nrm((N_ODD, S5_WIDTH, S5_WIDTH), S5_WIDTH ** -0.5),
        's5_glu_b': nrm((N_ODD, S5_WIDTH), 0.01),
        'w_out_o': nrm((N_ODD, ODD_MIX, D_MODEL), ODD_MIX ** -0.5 * DN_BETA),
        'ln_mix_g': 1.0 + nrm((DEPTH, D_MODEL), 0.01),
        'ln_mix_b': nrm((DEPTH, D_MODEL), 0.01),
        'peer_wq': nrm((DEPTH, D_MODEL, PEER_HEADS * PEER_QDIM), D_MODEL ** -0.5),
        'peer_keys': nrm((DEPTH, PEER_HEADS, 2, PEER_NKEYS, PEER_HALF), PEER_HALF ** -0.5),
        'peer_u': nrm((DEPTH, PEER_EXPERTS, D_MODEL), D_MODEL ** -0.5),
        'peer_v': nrm((DEPTH, PEER_EXPERTS, D_MODEL), DN_BETA * PEER_HEADS ** -0.5),
        'ln_ffn_g': 1.0 + nrm((DEPTH, D_MODEL), 0.01),
        'ln_ffn_b': nrm((DEPTH, D_MODEL), 0.01),
    }


def reference(x, w_in_e, gdn_conv_w, gdn_A_log, gdn_dt_bias, gdn_norm_w, rg_conv_w, rg_conv_b,
              rg_wa, rg_ba, rg_wx, rg_bx, rg_lambda, w_out_e, w_in_o, s5_A_re, s5_A_im, s5_log_dt,
              s5_B_re, s5_B_im, s5_C_re, s5_C_im, s5_D, s5_glu_w, s5_glu_b, w_out_o,
              ln_mix_g, ln_mix_b, peer_wq, peer_keys, peer_u, peer_v, ln_ffn_g, ln_ffn_b):
    h = x
    for layer in range(DEPTH):
        j = layer // 2
        if layer % 2 == 0:
            mix = even_mixer(h, w_in_e[j], gdn_conv_w[j], gdn_A_log[j], gdn_dt_bias[j], gdn_norm_w[j],
                             rg_conv_w[j], rg_conv_b[j], rg_wa[j], rg_ba[j], rg_wx[j], rg_bx[j],
                             rg_lambda[j], w_out_e[j])
        else:
            mix = odd_mixer(h, w_in_o[j], s5_A_re[j], s5_A_im[j], s5_log_dt[j], s5_B_re[j], s5_B_im[j],
                            s5_C_re[j], s5_C_im[j], s5_D[j], s5_glu_w[j], s5_glu_b[j], w_out_o[j])
        h = layer_norm(DN_ALPHA * h + mix, ln_mix_g[layer], ln_mix_b[layer]).astype(x.dtype)
        ffn = peer_ffn(h, peer_wq[layer], peer_keys[layer], peer_u[layer], peer_v[layer])
        h = layer_norm(DN_ALPHA * h + ffn, ln_ffn_g[layer], ln_ffn_b[layer]).astype(x.dtype)
    return h
```

```cpp
#include <hip/hip_runtime.h>
#include <cstdio>
#include <cstdint>

#define GAS __attribute__((address_space(1)))
#define LAS __attribute__((address_space(3)))
typedef unsigned short bf16;
typedef unsigned v4u __attribute__((ext_vector_type(4)));
typedef unsigned v2u __attribute__((ext_vector_type(2)));
typedef float v4f __attribute__((ext_vector_type(4)));
typedef float v2f __attribute__((ext_vector_type(2)));
typedef short v8s __attribute__((ext_vector_type(8)));

constexpr int NB = 4, SEQ = 2048, DM = 4096, NTOK = NB * SEQ;
constexpr int GW = 2048, GH = 16, HD = 128;
constexpr int RGW = 2048, RGB = 128, RGN = 16;
constexpr int EVEN_IN_SRC = 12320;
constexpr int EVEN_IN = 12288;
constexpr int PE_Z = 6144, PE_RGIN = 8192, PE_RGGATE = 10240;
constexpr int ODD_IN = 7168;
constexpr int SBW = 2048, S5W = 1024, S5G = 64, S5N = 64, S5C = 16;
constexpr int ODD_MIX = 3072;
constexpr int PH = 8, PNK = 128, PHALF = 128, PTOPK = 16, PQ = 2048, PE = 16384;
constexpr float DN_ALPHA = 1.41421356237f;
constexpr float LN_EPS = 1e-5f, RMS_EPS = 1e-6f;

constexpr size_t MiB = 1u << 20;
constexpr size_t WS_CTL = 0, CTL_ZERO_BYTES = 1 * MiB;
constexpr size_t WS_WINE = 1 * MiB;
constexpr size_t WS_WAB = 97 * MiB;
constexpr size_t WS_WOUTE = 98 * MiB;
constexpr size_t WS_WINO = 130 * MiB;
constexpr size_t WS_WOUTO = 186 * MiB;
constexpr size_t WS_WQ0 = 210 * MiB;
constexpr size_t WS_WQ1 = 226 * MiB;
constexpr size_t WS_GLU = 242 * MiB;
constexpr size_t WS_RGW = 244 * MiB;
constexpr size_t WS_U0 = 246 * MiB;
constexpr size_t WS_U1 = 374 * MiB;
constexpr size_t WS_VT0 = 502 * MiB;
constexpr size_t WS_VT1 = 630 * MiB;
constexpr size_t WS_HB = 758 * MiB;
constexpr size_t WS_WB = 1014 * MiB;
constexpr size_t WS_XB0 = 1270 * MiB;
constexpr size_t WS_XB1 = 1334 * MiB;
constexpr size_t WS_RES = 1398 * MiB;
constexpr size_t WS_MIX = 1526 * MiB;
constexpr size_t WS_MIXED = 1590 * MiB;
constexpr size_t WS_Q = 1654 * MiB;
constexpr size_t WS_IDX = 1718 * MiB;
constexpr size_t WS_GATE = 1722 * MiB;
constexpr size_t WS_A = 1726 * MiB;
constexpr size_t WS_B = 1790 * MiB;
constexpr size_t WS_BETA = 1854 * MiB;
constexpr size_t WS_EG = 1855 * MiB;
constexpr size_t WS_YG = 1856 * MiB;
constexpr size_t WS_END = 1872 * MiB;
constexpr int CW_BAR = 4096;

constexpr int RING_BYTES = 131072;
constexpr int MISC_OFF = RING_BYTES + 320;
constexpr int LDS_BYTES = 147456;
constexpr int NWAVES = 8, NTHR = 512;

__device__ __forceinline__ unsigned pk2(float lo, float hi) { unsigned r; asm("v_cvt_pk_bf16_f32 %0, %1, %2" : "=v"(r) : "v"(lo), "v"(hi)); return r; }
__device__ __forceinline__ float bflo(unsigned w) { return __uint_as_float(w << 16); }
__device__ __forceinline__ float bfhi(unsigned w) { return __uint_as_float(w & 0xffff0000u); }
__device__ __forceinline__ float bf2f(bf16 h) { return __uint_as_float(((unsigned)h) << 16); }
__device__ __forceinline__ void unpack8(const v4u w, float (&f)[8]) {
    f[0] = bflo(w.x); f[1] = bfhi(w.x); f[2] = bflo(w.y); f[3] = bfhi(w.y); f[4] = bflo(w.z); f[5] = bfhi(w.z); f[6] = bflo(w.w); f[7] = bfhi(w.w);
}
__device__ __forceinline__ v4u pack8(const float (&f)[8]) { v4u o; o.x = pk2(f[0], f[1]); o.y = pk2(f[2], f[3]); o.z = pk2(f[4], f[5]); o.w = pk2(f[6], f[7]); return o; }
__device__ __forceinline__ float sigmoidf_(float x) { return 1.0f / (1.0f + __expf(-x)); }
__device__ __forceinline__ float siluf_(float x) { return x / (1.0f + __expf(-x)); }
__device__ __forceinline__ float softplusf_(float x) { return fmaxf(x, 0.f) + log1pf(__expf(-fabsf(x))); }
__device__ __forceinline__ float gelu_tanh(float x) { const float u = 1.5957691216f * (x + 0.044715f * x * x * x); return x / (1.0f + __expf(-u)); }
__device__ __forceinline__ float wave_sum(float v) {
#pragma unroll
    for (int o = 1; o < 64; o <<= 1) v += __shfl_xor(v, o);
    return v;
}
__device__ __forceinline__ float wave_max(float v) {
#pragma unroll
    for (int o = 1; o < 64; o <<= 1) v = fmaxf(v, __shfl_xor(v, o));
    return v;
}
__device__ __forceinline__ float row16_sum(float v) {
    v += __builtin_bit_cast(float, __builtin_amdgcn_update_dpp(0, __builtin_bit_cast(int, v), 0xB1, 0xf, 0xf, true));
    v += __builtin_bit_cast(float, __builtin_amdgcn_update_dpp(0, __builtin_bit_cast(int, v), 0x4E, 0xf, 0xf, true));
    v += __builtin_bit_cast(float, __builtin_amdgcn_update_dpp(0, __builtin_bit_cast(int, v), 0x141, 0xf, 0xf, true));
    v += __builtin_bit_cast(float, __builtin_amdgcn_update_dpp(0, __builtin_bit_cast(int, v), 0x140, 0xf, 0xf, true));
    return v;
}
#define LDS_WAIT() asm volatile("s_waitcnt lgkmcnt(0)" ::: "memory")
#define VM_WAIT() asm volatile("s_waitcnt vmcnt(0)" ::: "memory")
namespace pg8 {
#define PG8_LAS __attribute__((address_space(3)))
typedef unsigned short bf16_t;
typedef short bf16x8 __attribute__((ext_vector_type(8)));
typedef float f32x4 __attribute__((ext_vector_type(4)));
typedef unsigned u32x4 __attribute__((ext_vector_type(4)));
constexpr int BM = 256, BK = 64, HALF = 128, HTB = HALF * BK * 2  , STAGE_BYTES = 8 * HTB, NXCD = 8, WGM = 8;

__host__ __device__ __forceinline__ int lds_byte(int r, int c) { const int st = (r >> 4) * 2 + (c >> 5), rr = r & 15, cc = c & 31, ob = rr * 64 + cc * 2; return st * 1024 + (ob ^ (((ob >> 9) & 1) << 5)); }
__host__ __device__ __forceinline__ void stage_rc(int b, int& R, int& C) { const int st = b / 1024, sb = b % 1024, swz = sb ^ (((sb >> 9) & 1) << 5); R = (st >> 1) * 16 + swz / 64; C = (st & 1) * 32 + (swz % 64) / 2; }
__host__ __device__ __forceinline__ int perm32(int rho) { const int n = rho >> 4, i = rho & 15; return 8 * (i >> 2) + 4 * n + (i & 3); }

struct Unit { int pm, pn; };
struct Gemm { const bf16_t* A; const bf16_t* Bt; int M, N, K; };

struct StaticOrder {
    int nM, nN, nwg, G, c;
    __host__ __device__ void init(int M, int N, int G_, int c_) { nM = M / BM; nN = N / BM; nwg = nM * nN; G = G_; c = c_; }
    __host__ __device__ bool next(int i, Unit& u) const {
        const long L = (long)i * G + c; if (L >= nwg) return false;
        int wgid = (int)L; { const int q = nwg / NXCD, r = nwg % NXCD, xcd = wgid % NXCD, off = wgid / NXCD; wgid = (xcd < r ? xcd * (q + 1) : r * (q + 1) + (xcd - r) * q) + off; }
        const int nig = WGM * nN, gid = wgid / nig, fm = gid * WGM, gsz = (nM - fm) < WGM ? (nM - fm) : WGM;
        u.pm = fm + ((wgid % nig) % gsz); u.pn = (wgid % nig) / gsz; return true;
    }
    __device__ __forceinline__ void a_ready(const Unit&) const {}
    __device__ __forceinline__ void done(const Unit&) const {}
};
struct CountedOrder : StaticOrder {
    const unsigned* ready; unsigned need; unsigned* tmo;
    __device__ __forceinline__ void a_ready(const Unit& u) const {
        if (threadIdx.x < 64) {
            const unsigned long long t0 = __builtin_amdgcn_s_memrealtime(); unsigned polls = 0;
            while ((unsigned)__builtin_amdgcn_readfirstlane(__hip_atomic_load(ready + 64 * u.pm, __ATOMIC_RELAXED, __HIP_MEMORY_SCOPE_AGENT)) < need) {
                if ((++polls & 255u) == 0u && __builtin_amdgcn_readfirstlane(__hip_atomic_load(tmo, __ATOMIC_RELAXED, __HIP_MEMORY_SCOPE_AGENT)) != 0u) break;
                if (__builtin_amdgcn_s_memrealtime() - t0 > 2000000ull) {
                    if (threadIdx.x == 0) { unsigned expect = 0u; __hip_atomic_compare_exchange_strong(tmo + 1, &expect, 0x600u | (unsigned)(u.pm & 0xff), __ATOMIC_RELAXED, __ATOMIC_RELAXED, __HIP_MEMORY_SCOPE_AGENT); __hip_atomic_store(tmo, 1u, __ATOMIC_RELAXED, __HIP_MEMORY_SCOPE_AGENT); }
                    break; }
                __builtin_amdgcn_s_sleep(2); }
            __builtin_amdgcn_fence(__ATOMIC_ACQUIRE, "agent");
            asm volatile("s_waitcnt vmcnt(0)" ::: "memory");
        }
#if !defined(BROKEN_HOOK_NO_BARRIER)
        asm volatile("" ::: "memory"); __builtin_amdgcn_s_barrier(); asm volatile("" ::: "memory");
#endif
    }
};

__device__ __forceinline__ unsigned cvt_pk_bf16(float lo, float hi) { unsigned r; asm volatile("v_cvt_pk_bf16_f32 %0, %1, %2" : "=v"(r) : "v"(lo), "v"(hi)); return r; }
typedef float f32x2 __attribute__((ext_vector_type(2)));
__device__ __forceinline__ f32x2 gelu_pk(f32x2 v) {
    const f32x2 av = __builtin_elementwise_abs(v), d = av * 0.2316418882f + 1.0f;
    f32x2 t; t.x = __builtin_amdgcn_rcpf(d.x); t.y = __builtin_amdgcn_rcpf(d.y);
    f32x2 q = t * 0.5307027145f + (-0.7265760135f); q = q * t + 0.7107068705f; q = q * t + (-0.142248368f); q = q * t + 0.127414796f; q = q * t;
    const f32x2 s = (v * v) * (-0.72134752044f);
    f32x2 e; e.x = __builtin_amdgcn_exp2f(s.x); e.y = __builtin_amdgcn_exp2f(s.y);
    const f32x2 m = v * (q * e), r = v - m;
    f32x2 o; o.x = v.x < 0.f ? m.x : r.x; o.y = v.y < 0.f ? m.y : r.y; return o;
}

struct EpiF32 {
    static constexpr bool PERM = false, AFTER_DRAIN = false;
    float* C; int ldc; const float* bias;
    __device__ __forceinline__ void operator()(const f32x4 (&acc)[2][2][4][2], const Unit& u, int wr, int wc, int fr, int fq) const {
        const int row0 = u.pm * BM + wr * 64 + fr, col0 = u.pn * BM + wc * 32 + 4 * fq;
        f32x4 bv[2][2];
#pragma unroll
        for (int bj = 0; bj < 2; ++bj)
#pragma unroll
            for (int n = 0; n < 2; ++n) bv[bj][n] = bias ? *(const f32x4*)(bias + col0 + bj * HALF + n * 16) : (f32x4){0.f, 0.f, 0.f, 0.f};
#pragma unroll
        for (int ai = 0; ai < 2; ++ai)
#pragma unroll
            for (int m = 0; m < 4; ++m) { float* rowp = C + (size_t)(row0 + ai * HALF + m * 16) * ldc + col0;
#pragma unroll
                for (int bj = 0; bj < 2; ++bj)
#pragma unroll
                    for (int n = 0; n < 2; ++n) *(f32x4*)(rowp + bj * HALF + n * 16) = acc[ai][bj][m][n] + bv[bj][n]; }
    }
};
template <int ACT  > struct EpiBf16 {
    static constexpr bool PERM = true, AFTER_DRAIN = false;
    bf16_t* O; int ldc; const float* bias; int split_cols; size_t split_stride;
    __device__ __forceinline__ void operator()(const f32x4 (&acc)[2][2][4][2], const Unit& u, int wr, int wc, int fr, int fq) const {
        const int row0 = u.pm * BM + wr * 64 + fr; int colt = u.pn * BM; bf16_t* base = O;
        if (split_cols) { const int t = colt / split_cols; base += (size_t)t * split_stride; colt -= t * split_cols; }
        const int col0 = colt + wc * 32 + 8 * fq, bcol0 = u.pn * BM + wc * 32 + 8 * fq;
        f32x4 bv[2][2];
#pragma unroll
        for (int bj = 0; bj < 2; ++bj)
#pragma unroll
            for (int n = 0; n < 2; ++n) bv[bj][n] = bias ? *(const f32x4*)(bias + bcol0 + bj * HALF + 4 * n) : (f32x4){0.f, 0.f, 0.f, 0.f};
#pragma unroll
        for (int ai = 0; ai < 2; ++ai)
#pragma unroll
            for (int m = 0; m < 4; ++m) { bf16_t* rowp = base + (size_t)(row0 + ai * HALF + m * 16) * ldc + col0;
#pragma unroll
                for (int bj = 0; bj < 2; ++bj) { f32x4 v0 = acc[ai][bj][m][0] + bv[bj][0], v1 = acc[ai][bj][m][1] + bv[bj][1];
                    if (ACT == 1) { f32x2 a = gelu_pk((f32x2){v0[0], v0[1]}), b = gelu_pk((f32x2){v0[2], v0[3]}), c = gelu_pk((f32x2){v1[0], v1[1]}), d = gelu_pk((f32x2){v1[2], v1[3]});
                        v0 = (f32x4){a.x, a.y, b.x, b.y}; v1 = (f32x4){c.x, c.y, d.x, d.y}; }
                    if (ACT == 2) {
#pragma unroll
                        for (int j = 0; j < 4; ++j) { v0[j] = 0.5f * v0[j] * (1.0f + erff(v0[j] * 0.70710678f)); v1[j] = 0.5f * v1[j] * (1.0f + erff(v1[j] * 0.70710678f)); } }
                    u32x4 w; w.x = cvt_pk_bf16(v0[0], v0[1]); w.y = cvt_pk_bf16(v0[2], v0[3]); w.z = cvt_pk_bf16(v1[0], v1[1]); w.w = cvt_pk_bf16(v1[2], v1[3]);
                    *(u32x4*)(rowp + bj * HALF) = w; } }
    }
};
template <class Epi, class Sched, bool STAMP = false>
__device__ __forceinline__ void gemm_phase(PG8_LAS unsigned char* lds, const Gemm g, const Sched& S, const Epi& E, unsigned long long* stamps) {
    const int tid = threadIdx.x, wid = __builtin_amdgcn_readfirstlane(tid >> 6), lane = tid & 63, wr = wid >> 2, wc = wid & 3, fr = lane & 15, fq = lane >> 4;
    const int K = g.K, nt = K / BK;
    int ts_lo = 0, ts_hi = 0, nts = 0; const unsigned long long rt_entry = STAMP ? (unsigned long long)wall_clock64() : 0ull;
#define PG8_STAMP() do { if (STAMP && wid == 0 && nts < 64) { const unsigned long long _c = (unsigned long long)clock64(); \
        ts_lo = (lane == nts) ? (int)(unsigned)_c : ts_lo; ts_hi = (lane == nts) ? (int)(unsigned)(_c >> 32) : ts_hi; ++nts; } } while (0)
    PG8_STAMP();
    unsigned voffA[2], voffB[2];
#pragma unroll
    for (int i = 0; i < 2; ++i) { int R, C; stage_rc(tid * 16 + i * 8192, R, C); const int Rb = Epi::PERM ? ((R & ~31) + perm32(R & 31)) : R;
        voffA[i] = (unsigned)(R * K + C) * 2u; voffB[i] = (unsigned)(Rb * K + C) * 2u; }
    const size_t kstep = (size_t)(BK * 2);
    const size_t hstep = (size_t)HALF * K * 2;
    const size_t tstep = 2 * hstep;
    const unsigned ldsw = (unsigned)wid * 1024u;
    const int aoff = lds_byte(wr * 64 + fr, fq * 8), boff = lds_byte(wc * 32 + fr, fq * 8);
#define PG8_SA(b, h) (((b) * 2 + (h)) * HTB)
#define PG8_SB(b, h) ((4 + (b) * 2 + (h)) * HTB)
#define PG8_STAGE(bufoff, gbase, voff) do { _Pragma("unroll") for (int _i = 0; _i < 2; ++_i) \
        __builtin_amdgcn_global_load_lds((const unsigned*)((const char*)(gbase) + (voff)[_i]), (PG8_LAS unsigned*)(lds + (bufoff) + ldsw + _i * 8192), 16, 0, 0); } while (0)
#define PG8_LDA(dst, b, h) do { _Pragma("unroll") for (int m = 0; m < 4; ++m) _Pragma("unroll") for (int k = 0; k < 2; ++k) dst[m][k] = *(const PG8_LAS bf16x8*)(lds + PG8_SA(b, h) + aoff + m * 2048 + k * 1024); } while (0)
#define PG8_LDB(dst, b, h) do { _Pragma("unroll") for (int n = 0; n < 2; ++n) _Pragma("unroll") for (int k = 0; k < 2; ++k) dst[n][k] = *(const PG8_LAS bf16x8*)(lds + PG8_SB(b, h) + boff + n * 2048 + k * 1024); } while (0)
#define PG8_MMA(ai, bj, At, Bt) do { __builtin_amdgcn_s_setprio(1); _Pragma("unroll") for (int m = 0; m < 4; ++m) _Pragma("unroll") for (int n = 0; n < 2; ++n) _Pragma("unroll") for (int k = 0; k < 2; ++k) \
        acc[ai][bj][m][n] = __builtin_amdgcn_mfma_f32_16x16x32_bf16(Bt[n][k], At[m][k], acc[ai][bj][m][n], 0, 0, 0); __builtin_amdgcn_s_setprio(0); } while (0)
#define PG8_WAIT_V(n) asm volatile("s_waitcnt vmcnt(" #n ")" ::: "memory")
#define PG8_WAIT_L(n) asm volatile("s_waitcnt lgkmcnt(" #n ")" ::: "memory")
#define PG8_BAR __builtin_amdgcn_s_barrier()
#define PG8_SCHED __builtin_amdgcn_sched_barrier(0)
    Unit cur, nxt; int ui = 0;
    if (!S.next(0, cur)) return;
    f32x4 acc[2][2][4][2];
#pragma unroll
    for (int a = 0; a < 2; ++a)
#pragma unroll
        for (int b = 0; b < 2; ++b)
#pragma unroll
            for (int m = 0; m < 4; ++m)
#pragma unroll
                for (int n = 0; n < 2; ++n) acc[a][b][m][n] = (f32x4){0.f, 0.f, 0.f, 0.f};
    bf16x8 At[4][2], B0[2][2], B1[2][2];
    const char* cA = (const char*)g.A + (size_t)cur.pm * tstep; const char* cB = (const char*)g.Bt + (size_t)cur.pn * tstep;
    S.a_ready(cur);
    PG8_STAGE(PG8_SB(0, 0), cB, voffB); PG8_STAGE(PG8_SA(0, 0), cA, voffA); PG8_STAGE(PG8_SB(0, 1), cB + hstep, voffB); PG8_STAGE(PG8_SA(0, 1), cA + hstep, voffA);
    if (wr == 1) PG8_BAR;
    PG8_WAIT_V(4); PG8_BAR;
    PG8_STAGE(PG8_SB(1, 0), cB + kstep, voffB); PG8_STAGE(PG8_SA(1, 0), cA + kstep, voffA); PG8_STAGE(PG8_SB(1, 1), cB + hstep + kstep, voffB);
    PG8_WAIT_V(6); PG8_BAR;
    PG8_STAMP();
    for (;;) {
        const bool has_next = S.next(ui + 1, nxt);
        const char* nA = has_next ? (const char*)g.A + (size_t)nxt.pm * tstep : cA; const char* nB = has_next ? (const char*)g.Bt + (size_t)nxt.pn * tstep : cB;
        for (int t = 0; t < nt; t += 2) {
            const bool last = (t == nt - 2);
            const char* a1 = cA + (size_t)(t + 1) * kstep;
            const char* a2 = last ? nA : cA + (size_t)(t + 2) * kstep; const char* b2 = last ? nB : cB + (size_t)(t + 2) * kstep;
            const char* a3 = a2 + kstep; const char* b3 = b2 + kstep;
            if (last && has_next) S.a_ready(nxt);
            PG8_LDB(B0, 0, 0); PG8_SCHED; PG8_LDA(At, 0, 0); PG8_STAGE(PG8_SA(1, 1), a1 + hstep, voffA);
            PG8_WAIT_L(8); PG8_BAR; PG8_WAIT_L(0); PG8_MMA(0, 0, At, B0); PG8_BAR; PG8_SCHED;
            PG8_LDB(B1, 0, 1); PG8_STAGE(PG8_SB(0, 0), b2, voffB);
            PG8_BAR; PG8_WAIT_L(0); PG8_MMA(0, 1, At, B1); PG8_BAR;
            PG8_LDA(At, 0, 1); PG8_STAGE(PG8_SA(0, 0), a2, voffA);
            PG8_BAR; PG8_WAIT_L(0); PG8_MMA(1, 0, At, B0); PG8_BAR; PG8_SCHED;
            PG8_STAGE(PG8_SB(0, 1), b2 + hstep, voffB);
            PG8_WAIT_V(6); PG8_BAR; PG8_MMA(1, 1, At, B1); PG8_BAR;
            PG8_LDB(B0, 1, 0); PG8_SCHED; PG8_LDA(At, 1, 0); PG8_STAGE(PG8_SA(0, 1), a2 + hstep, voffA);
            PG8_WAIT_L(8); PG8_BAR; PG8_WAIT_L(0); PG8_MMA(0, 0, At, B0); PG8_BAR; PG8_SCHED;
            PG8_LDB(B1, 1, 1); PG8_STAGE(PG8_SB(1, 0), b3, voffB);
            PG8_BAR; PG8_WAIT_L(0); PG8_MMA(0, 1, At, B1); PG8_BAR;
            PG8_LDA(At, 1, 1); PG8_STAGE(PG8_SA(1, 0), a3, voffA);
            PG8_BAR; PG8_WAIT_L(0); PG8_MMA(1, 0, At, B0); PG8_BAR; PG8_SCHED;
            PG8_STAGE(PG8_SB(1, 1), b3 + hstep, voffB);
            PG8_WAIT_V(6); PG8_BAR; PG8_MMA(1, 1, At, B1); PG8_BAR;
        }
        PG8_STAMP();
        if constexpr (!Epi::AFTER_DRAIN) { E(acc, cur, wr, wc, fr, fq); S.done(cur); }
        PG8_STAMP();
        if (!has_next) break;
#pragma unroll
        for (int a = 0; a < 2; ++a)
#pragma unroll
            for (int b = 0; b < 2; ++b)
#pragma unroll
                for (int m = 0; m < 4; ++m)
#pragma unroll
                    for (int n = 0; n < 2; ++n) acc[a][b][m][n] = (f32x4){0.f, 0.f, 0.f, 0.f};
        cur = nxt; cA = nA; cB = nB; ++ui;
    }
    PG8_WAIT_V(0);
    if (wr == 0) PG8_BAR;
    PG8_BAR;
    if constexpr (Epi::AFTER_DRAIN) { E.fused(acc, cur, wr, wc, fr, fq, lds, wid, lane); S.done(cur); }
    PG8_STAMP();
    if (STAMP && wid == 0) { stamps[lane] = lane < nts ? (((unsigned long long)(unsigned)ts_hi << 32) | (unsigned)ts_lo) : 0ull;
        if (lane == 62) stamps[62] = rt_entry; if (lane == 63) stamps[63] = (unsigned long long)wall_clock64(); }
#undef PG8_STAMP
#undef PG8_SA
#undef PG8_SB
#undef PG8_STAGE
#undef PG8_LDA
#undef PG8_LDB
#undef PG8_MMA
#undef PG8_WAIT_V
#undef PG8_WAIT_L
#undef PG8_BAR
#undef PG8_SCHED
}
}
#define XB_TMO      128
#define XB_XCNT(j)  (256  + 64 * (j))
#define XB_XSUB(j)  (1280 + 64 * (j))
#define XB_XGEN(j)  (2304 + 64 * (j))
#define XB_TOP      3328
#define XB_TOPGEN   3392
#define XCD_BAR_WORDS 3456
#define XB_SPIN_CAP (1u << 18)

__device__ __forceinline__ unsigned xb_ld(unsigned* p)              { return __hip_atomic_load(p, __ATOMIC_RELAXED, __HIP_MEMORY_SCOPE_AGENT); }
__device__ __forceinline__ unsigned xb_add(unsigned* p, unsigned v) { return __hip_atomic_fetch_add(p, v, __ATOMIC_RELAXED, __HIP_MEMORY_SCOPE_AGENT); }
__device__ __forceinline__ unsigned xb_xcc_id() { return (unsigned)__builtin_amdgcn_s_getreg((3 << 11) | 20) & 0xFu; }
#define XB_SPIN(cond, bar) do { unsigned _sp = 0; while (cond) { __builtin_amdgcn_s_sleep(1); \
    if ((++_sp & 255u) == 0u) { if (xb_ld(&(bar)[XB_TMO])) break; if (_sp > XB_SPIN_CAP) { atomicAdd(&(bar)[XB_TMO], 1u); break; } } } } while (0)

struct XcdBarrier {
    unsigned* bar; unsigned x;
    volatile LAS unsigned* st;
};

__device__ __forceinline__ XcdBarrier xcd_barrier_post(unsigned* bar, volatile LAS unsigned* st) {
    XcdBarrier b; b.bar = bar; b.x = xb_xcc_id(); b.st = st;
    if (threadIdx.x == 0) (void)xb_add(&bar[XB_XCNT(b.x)], 1u);
    return b;
}
__device__ __forceinline__ void xcd_barrier_complete(unsigned* bar, unsigned x, unsigned& nloc, unsigned& nx) {
    const unsigned G = gridDim.x * gridDim.y * gridDim.z;
    unsigned sum, cnt, mine, sp = 0u;
    for (;;) {
        sum = 0u; cnt = 0u; mine = 0u;
#pragma unroll
        for (unsigned j = 0; j < 16; ++j) { const unsigned c = xb_ld(&bar[XB_XCNT(j)]); sum += c; cnt += (c > 0u) ? 1u : 0u; mine = (j == x) ? c : mine; }
        if (sum == G) break;
        __builtin_amdgcn_s_sleep(1);
        if ((++sp & 255u) == 0u) { if (xb_ld(&bar[XB_TMO])) break; if (sp > XB_SPIN_CAP) { atomicAdd(&bar[XB_TMO], 1u); break; } }
    }
    nloc = mine > 0u ? mine : 1u; nx = cnt > 0u ? cnt : 1u;
}

__device__ __forceinline__ void xcd_barrier(const XcdBarrier& b) {
    asm volatile("s_waitcnt vmcnt(0)" ::: "memory");
    __syncthreads();
    if (threadIdx.x == 0) {
        unsigned* bar = b.bar;
        __builtin_amdgcn_s_waitcnt(0);
        unsigned nloc = b.st[0], nx = b.st[1];
        if (nloc == 0u) { xcd_barrier_complete(bar, b.x, nloc, nx); b.st[0] = nloc; b.st[1] = nx; }
        const unsigned old = xb_add(&bar[XB_XSUB(b.x)], 1u);
        const unsigned gen = old / nloc;
        if (old + 1u == (gen + 1u) * nloc) {
            __builtin_amdgcn_fence(__ATOMIC_RELEASE, "agent");
            asm volatile("s_waitcnt vmcnt(0)" ::: "memory");
            const unsigned og = xb_add(&bar[XB_TOP], 1u);
            const unsigned tg = og / nx;
            if (og + 1u == (tg + 1u) * nx) xb_add(&bar[XB_TOPGEN], 1u);
            else XB_SPIN(xb_ld(&bar[XB_TOPGEN]) == tg, bar);
            __builtin_amdgcn_fence(__ATOMIC_ACQUIRE, "agent");
            xb_add(&bar[XB_XGEN(b.x)], 1u);
            asm volatile("s_waitcnt vmcnt(0)" ::: "memory");
        } else {
            XB_SPIN(xb_ld(&bar[XB_XGEN(b.x)]) == gen, bar);
            __builtin_amdgcn_fence(__ATOMIC_ACQUIRE, "agent");
            asm volatile("s_waitcnt vmcnt(0)" ::: "memory");
        }
    }
    __syncthreads();
}

struct Args { const float* in[34]; float* out; unsigned char* ws; int ph_lo, ph_hi; };
struct Frame { LAS unsigned char* lds; int tid, lane, wave, G, bid; };

#define MFMA16(a, b, c) __builtin_amdgcn_mfma_f32_16x16x32_bf16((a), (b), (c), 0, 0, 0)

__device__ __forceinline__ void tr_item(const float* W, int ldw, int scol0, int K, bf16* WT, int drow0, LAS float* scr, int kb, int nb, int lane) {
    const int k0 = 64 * kb, n0 = 32 * nb;
#pragma unroll 8
    for (int i = 0; i < 32; ++i) { const int kk = 2 * i + (lane >> 5); scr[kk * 33 + (lane & 31)] = W[(size_t)(k0 + kk) * ldw + scol0 + n0 + (lane & 31)]; }
    LDS_WAIT(); asm volatile("" ::: "memory");
    const int c = lane & 7;
#pragma unroll
    for (int j = 0; j < 4; ++j) { const int n = (lane >> 3) + 8 * j; const LAS float* s = scr + (8 * c) * 33 + n;
        v4u o; o.x = pk2(s[0 * 33], s[1 * 33]); o.y = pk2(s[2 * 33], s[3 * 33]); o.z = pk2(s[4 * 33], s[5 * 33]); o.w = pk2(s[6 * 33], s[7 * 33]);
        *(v4u*)(WT + (size_t)(drow0 + n0 + n) * K + k0 + 8 * c) = o; }
    LDS_WAIT(); asm volatile("" ::: "memory");
}
__device__ __forceinline__ void cvt_stream(const float* src, bf16* dst, size_t n8, size_t gtid, size_t gsize) {
    for (size_t i = gtid; i < n8; i += gsize) { const v4f a = *(const v4f*)(src + 8 * i), b = *(const v4f*)(src + 8 * i + 4);
        v4u o; o.x = pk2(a.x, a.y); o.y = pk2(a.z, a.w); o.z = pk2(b.x, b.y); o.w = pk2(b.z, b.w); *(v4u*)(dst + 8 * i) = o; }
}
__device__ __forceinline__ void p0_prologue(const Args& a, Frame& F) {
    unsigned char* ws = a.ws;
    LAS float* scr = (LAS float*)(F.lds + F.wave * 16384);
    const int gw = F.bid * NWAVES + F.wave, NGW = F.G * NWAVES;
    constexpr int I_E1 = 64 * 256, I_E2 = 64 * 128, I_AB = 64, I_OE = 64 * 128, I_IO = 64 * 224, I_OO = 48 * 128, I_WQ = 64 * 64, I_GL = 16 * 32, I_RG = 256, I_V = 256 * 128;
    constexpr int NITEMS = I_E1 + I_E2 + I_AB + I_OE + I_IO + I_OO + 2 * I_WQ + I_GL + I_RG + 2 * I_V;
    for (int it = gw; it < NITEMS; it += NGW) {
        int r = it;
        if (r < I_E1) { tr_item(a.in[1], EVEN_IN_SRC, 0, DM, (bf16*)(ws + WS_WINE), 0, scr, r / 256, r % 256, F.lane); continue; } r -= I_E1;
        if (r < I_E2) { tr_item(a.in[1], EVEN_IN_SRC, 8224, DM, (bf16*)(ws + WS_WINE), 8192, scr, r / 128, r % 128, F.lane); continue; } r -= I_E2;
        if (r < I_AB) { tr_item(a.in[1], EVEN_IN_SRC, 8192, DM, (bf16*)(ws + WS_WAB), 0, scr, r, 0, F.lane); continue; } r -= I_AB;
        if (r < I_OE) { tr_item(a.in[13], DM, 0, DM, (bf16*)(ws + WS_WOUTE), 0, scr, r / 128, r % 128, F.lane); continue; } r -= I_OE;
        if (r < I_IO) { tr_item(a.in[14], ODD_IN, 0, DM, (bf16*)(ws + WS_WINO), 0, scr, r / 224, r % 224, F.lane); continue; } r -= I_IO;
        if (r < I_OO) { tr_item(a.in[25], DM, 0, ODD_MIX, (bf16*)(ws + WS_WOUTO), 0, scr, r / 128, r % 128, F.lane); continue; } r -= I_OO;
        if (r < I_WQ) { tr_item(a.in[28], PQ, 0, DM, (bf16*)(ws + WS_WQ0), 0, scr, r / 64, r % 64, F.lane); continue; } r -= I_WQ;
        if (r < I_WQ) { tr_item(a.in[28] + (size_t)DM * PQ, PQ, 0, DM, (bf16*)(ws + WS_WQ1), 0, scr, r / 64, r % 64, F.lane); continue; } r -= I_WQ;
        if (r < I_GL) { tr_item(a.in[23], S5W, 0, S5W, (bf16*)(ws + WS_GLU), 0, scr, r / 32, r % 32, F.lane); continue; } r -= I_GL;
        if (r < I_RG) { const int n = r >> 4, which = (r >> 3) & 1, kb = (r >> 2) & 1, nb = r & 3;
            tr_item((which ? a.in[10] : a.in[8]) + (size_t)n * RGB * RGB, RGB, 0, RGB, (bf16*)(ws + WS_RGW) + (size_t)n * 256 * RGB, which * 128, scr, kb, nb, F.lane); continue; } r -= I_RG;
        if (r < I_V) { tr_item(a.in[31], DM, 0, PE, (bf16*)(ws + WS_VT0), 0, scr, r / 128, r % 128, F.lane); continue; } r -= I_V;
        tr_item(a.in[31] + (size_t)PE * DM, DM, 0, PE, (bf16*)(ws + WS_VT1), 0, scr, r / 128, r % 128, F.lane);
    }
    const size_t gtid = (size_t)F.bid * NTHR + F.tid, gsize = (size_t)F.G * NTHR;
    cvt_stream(a.in[0], (bf16*)(ws + WS_XB0), (size_t)NTOK * DM / 8, gtid, gsize);
    cvt_stream(a.in[30], (bf16*)(ws + WS_U0), (size_t)PE * DM / 8, gtid, gsize);
    cvt_stream(a.in[30] + (size_t)PE * DM, (bf16*)(ws + WS_U1), (size_t)PE * DM / 8, gtid, gsize);
}

__device__ __forceinline__ void gdn_prep_phase(const Args& a, Frame& F) {
    const bf16* proj = (const bf16*)(a.ws + WS_HB);
    float* qkvn = (float*)(a.ws + WS_WB);
    const float* cw = a.in[2];
    const int gw = F.bid * NWAVES + F.wave, NGW = F.G * NWAVES;
    for (int it = gw; it < 12 * 512; it += NGW) {
        const int tg = it / 12, j = it % 12, c0 = j * 512 + F.lane * 8, t0 = tg * 16;
        float w[4][8];
#pragma unroll
        for (int k = 0; k < 4; ++k) { const v4f w0 = *(const v4f*)(cw + k * 6144 + c0), w1 = *(const v4f*)(cw + k * 6144 + c0 + 4);
            w[k][0] = w0.x; w[k][1] = w0.y; w[k][2] = w0.z; w[k][3] = w0.w; w[k][4] = w1.x; w[k][5] = w1.y; w[k][6] = w1.z; w[k][7] = w1.w; }
        float xm3[8], xm2[8], xm1[8], xc[8];
        if ((t0 & (SEQ - 1)) == 0) {
#pragma unroll
            for (int e = 0; e < 8; ++e) { xm3[e] = 0.f; xm2[e] = 0.f; xm1[e] = 0.f; }
        } else {
            unpack8(*(const v4u*)(proj + (size_t)(t0 - 3) * EVEN_IN + c0), xm3);
            unpack8(*(const v4u*)(proj + (size_t)(t0 - 2) * EVEN_IN + c0), xm2);
            unpack8(*(const v4u*)(proj + (size_t)(t0 - 1) * EVEN_IN + c0), xm1);
        }
        float* dst = qkvn + (size_t)(j >> 2) * NTOK * GW + (size_t)(j & 3) * 512 + F.lane * 8;
        for (int i = 0; i < 16; ++i) {
            const int t = t0 + i;
            unpack8(*(const v4u*)(proj + (size_t)t * EVEN_IN + c0), xc);
            float y[8]; float ss = 0.f;
#pragma unroll
            for (int e = 0; e < 8; ++e) { float v = w[0][e] * xm3[e] + w[1][e] * xm2[e] + w[2][e] * xm1[e] + w[3][e] * xc[e]; v = siluf_(v); y[e] = v; ss += v * v; }
            if (j < 8) {
                ss = row16_sum(ss);
                float r = rsqrtf(ss + RMS_EPS); if (j < 4) r *= 0.08838834764831845f;
#pragma unroll
                for (int e = 0; e < 8; ++e) y[e] *= r;
            }
            *(v4f*)(dst + (size_t)t * GW) = (v4f){y[0], y[1], y[2], y[3]};
            *(v4f*)(dst + (size_t)t * GW + 4) = (v4f){y[4], y[5], y[6], y[7]};
#pragma unroll
            for (int e = 0; e < 8; ++e) { xm3[e] = xm2[e]; xm2[e] = xm1[e]; xm1[e] = xc[e]; }
        }
    }
}

__device__ __forceinline__ void ab_proj_phase(const Args& a, Frame& F) {
    const bf16* xb = (const bf16*)(a.ws + WS_XB0);
    const bf16* wab = (const bf16*)(a.ws + WS_WAB);
    float* beta = (float*)(a.ws + WS_BETA); float* eg = (float*)(a.ws + WS_EG);
    LAS float* red = (LAS float*)F.lds;
    const int m = F.lane & 15, q = F.lane >> 4;
    for (int blk = F.bid; blk < NTOK / 32; blk += F.G) {
        const int r0 = blk * 32;
        v4f acc[2][2];
#pragma unroll
        for (int i = 0; i < 2; ++i)
#pragma unroll
            for (int j = 0; j < 2; ++j) acc[i][j] = (v4f){0.f, 0.f, 0.f, 0.f};
        for (int ks = 0; ks < 16; ++ks) {
            const int k = F.wave * 512 + ks * 32 + 8 * q;
            v8s af[2], bfr[2];
#pragma unroll
            for (int i = 0; i < 2; ++i) { af[i] = *(const v8s*)(xb + (size_t)(r0 + 16 * i + m) * DM + k); bfr[i] = *(const v8s*)(wab + (size_t)(16 * i + m) * DM + k); }
#pragma unroll
            for (int i = 0; i < 2; ++i)
#pragma unroll
                for (int j = 0; j < 2; ++j) acc[i][j] = MFMA16(bfr[j], af[i], acc[i][j]);
        }
#pragma unroll
        for (int i = 0; i < 2; ++i)
#pragma unroll
            for (int j = 0; j < 2; ++j) *(LAS v4f*)(red + ((F.wave * 4 + i * 2 + j) * 64 + F.lane) * 4) = acc[i][j];
        __syncthreads();
        for (int o = F.tid; o < 1024; o += NTHR) {
            float s = 0.f;
#pragma unroll
            for (int w = 0; w < 8; ++w) s += red[w * 1024 + o];
            const int tile = o >> 8, ln = (o >> 2) & 63, r = o & 3, i = tile >> 1, j = tile & 1;
            const int row = r0 + 16 * i + (ln & 15), col = 16 * j + 4 * (ln >> 4) + r;
            if (col < 16) { const float g = -__expf(a.in[3][col]) * softplusf_(s + a.in[4][col]); eg[(size_t)row * 16 + col] = __expf(g); }
            else beta[(size_t)row * 16 + (col - 16)] = sigmoidf_(s);
        }
        __syncthreads();
    }
}

__device__ __forceinline__ void rg_gates_phase(const Args& a, Frame& F) {
    const bf16* proj = (const bf16*)(a.ws + WS_HB);
    const bf16* rgw = (const bf16*)(a.ws + WS_RGW);
    float* Aout = (float*)(a.ws + WS_A); float* Bout = (float*)(a.ws + WS_B);
    const float* convw = a.in[6]; const float* convb = a.in[7]; const float* ba = a.in[9]; const float* bx = a.in[11]; const float* lam = a.in[12];
    LAS float* xr = (LAS float*)F.lds;
    for (int u = F.bid; u < 2048; u += F.G) {
        const int tt = u >> 4, n = u & 15, t0 = tt * 64;
        {   const int tl = F.tid >> 3, cg = (F.tid & 7) * 16, t = t0 + tl, ts = t & (SEQ - 1);
#pragma unroll
            for (int hh = 0; hh < 2; ++hh) {
                const int c = n * 128 + cg + hh * 8;
                float acc[8];
                { const v4f b0 = *(const v4f*)(convb + c), b1 = *(const v4f*)(convb + c + 4); acc[0] = b0.x; acc[1] = b0.y; acc[2] = b0.z; acc[3] = b0.w; acc[4] = b1.x; acc[5] = b1.y; acc[6] = b1.z; acc[7] = b1.w; }
#pragma unroll
                for (int k = 0; k < 4; ++k) {
                    if (ts + k - 3 >= 0) {
                        float x[8]; unpack8(*(const v4u*)(proj + (size_t)(t + k - 3) * EVEN_IN + PE_RGIN + c), x);
                        const v4f w0 = *(const v4f*)(convw + k * RGW + c), w1 = *(const v4f*)(convw + k * RGW + c + 4);
                        acc[0] += w0.x * x[0]; acc[1] += w0.y * x[1]; acc[2] += w0.z * x[2]; acc[3] += w0.w * x[3];
                        acc[4] += w1.x * x[4]; acc[5] += w1.y * x[5]; acc[6] += w1.z * x[6]; acc[7] += w1.w * x[7];
                    }
                }
                *(LAS v4f*)(xr + tl * 132 + cg + hh * 8) = (v4f){acc[0], acc[1], acc[2], acc[3]};
                *(LAS v4f*)(xr + tl * 132 + cg + hh * 8 + 4) = (v4f){acc[4], acc[5], acc[6], acc[7]};
            }
        }
        __syncthreads();
        {   const int rt = F.wave & 3, ch = F.wave >> 2, m = F.lane & 15, q = F.lane >> 4;
            v8s Af[4];
#pragma unroll
            for (int ks = 0; ks < 4; ++ks) { const v4f x0 = *(const LAS v4f*)(xr + (16 * rt + m) * 132 + 32 * ks + 8 * q), x1 = *(const LAS v4f*)(xr + (16 * rt + m) * 132 + 32 * ks + 8 * q + 4);
                v4u p; p.x = pk2(x0.x, x0.y); p.y = pk2(x0.z, x0.w); p.z = pk2(x1.x, x1.y); p.w = pk2(x1.z, x1.w); Af[ks] = __builtin_bit_cast(v8s, p); }
#pragma unroll
            for (int jj = 0; jj < 4; ++jj) {
                const int jt = 4 * ch + jj;
                v4f accr = (v4f){0.f, 0.f, 0.f, 0.f}, acci = (v4f){0.f, 0.f, 0.f, 0.f};
#pragma unroll
                for (int ks = 0; ks < 4; ++ks) {
                    const v8s Br = *(const v8s*)(rgw + ((size_t)(n * 256 + 16 * jt + m) * RGB + 32 * ks + 8 * q));
                    const v8s Bi = *(const v8s*)(rgw + ((size_t)(n * 256 + 128 + 16 * jt + m) * RGB + 32 * ks + 8 * q));
                    accr = MFMA16(Br, Af[ks], accr); acci = MFMA16(Bi, Af[ks], acci);
                }
                const int cc = 16 * jt + 4 * q, C = n * 128 + cc, row = 16 * rt + m;
                const v4f xv = *(const LAS v4f*)(xr + row * 132 + cc);
                const v4f bav = *(const v4f*)(ba + C), bxv = *(const v4f*)(bx + C), lmv = *(const v4f*)(lam + C);
                v4f av, bv;
#pragma unroll
                for (int r = 0; r < 4; ++r) {
                    const float rr = sigmoidf_(accr[r] + bav[r]), ii = sigmoidf_(acci[r] + bxv[r]);
                    const float la = -8.0f * rr * softplusf_(-lmv[r]);
                    av[r] = __expf(la); bv[r] = sqrtf(fmaxf(-expm1f(2.0f * la), 0.f)) * (ii * xv[r]);
                }
                *(v4f*)(Aout + (size_t)(t0 + row) * RGW + C) = av;
                *(v4f*)(Bout + (size_t)(t0 + row) * RGW + C) = bv;
            }
        }
        __syncthreads();
    }
}

__device__ __forceinline__ void gdn_rec_phase(const Args& a, Frame& F) {
    const float* qn = (const float*)(a.ws + WS_WB);
    const float* kn = qn + (size_t)NTOK * GW;
    const float* vn = kn + (size_t)NTOK * GW;
    float* og = (float*)(a.ws + WS_WB + 192 * MiB);
    const float* beta = (const float*)(a.ws + WS_BETA); const float* eg = (const float*)(a.ws + WS_EG);
    constexpr int TC = 32, BUF = TC * 128 * 2 + TC * 32 + TC * 2;
    LAS float* base = (LAS float*)F.lds;
    const int sub = F.lane & 15, col = F.wave * 4 + (F.lane >> 4);
    const int lr = F.tid >> 4, lc = (F.tid & 15) * 8, vr = (F.tid >> 3) & 31, vc = (F.tid & 7) * 4;
    for (int item = F.bid; item < 256; item += F.G) {
        const int bh = item >> 2, cg = item & 3, b = bh >> 4, h = bh & 15;
        const size_t row0 = (size_t)b * SEQ;
        v4f pk0, pk1, pq0, pq1, pv; float pe = 0.f, pb = 0.f;
#define GDN_LOAD(c) do { const size_t r_ = row0 + (size_t)(c) * TC; \
            pk0 = *(const v4f*)(kn + (r_ + lr) * GW + h * HD + lc); pk1 = *(const v4f*)(kn + (r_ + lr) * GW + h * HD + lc + 4); \
            pq0 = *(const v4f*)(qn + (r_ + lr) * GW + h * HD + lc); pq1 = *(const v4f*)(qn + (r_ + lr) * GW + h * HD + lc + 4); \
            if (F.tid < 256) pv = *(const v4f*)(vn + (r_ + vr) * GW + h * HD + cg * 32 + vc); \
            if (F.tid < TC) { pe = eg[(r_ + F.tid) * 16 + h]; pb = beta[(r_ + F.tid) * 16 + h]; } } while (0)
#define GDN_STORE(bi) do { LAS float* B_ = base + (bi) * BUF; \
            *(LAS v4f*)(B_ + lr * 128 + lc) = pk0; *(LAS v4f*)(B_ + lr * 128 + lc + 4) = pk1; \
            *(LAS v4f*)(B_ + TC * 128 + lr * 128 + lc) = pq0; *(LAS v4f*)(B_ + TC * 128 + lr * 128 + lc + 4) = pq1; \
            if (F.tid < 256) *(LAS v4f*)(B_ + TC * 256 + vr * 32 + vc) = pv; \
            if (F.tid < TC) { B_[TC * 256 + TC * 32 + 2 * F.tid] = pe; B_[TC * 256 + TC * 32 + 2 * F.tid + 1] = pb; } } while (0)
        __syncthreads();
        GDN_LOAD(0); GDN_STORE(0);
        __syncthreads();
        v4f s0 = (v4f){0.f, 0.f, 0.f, 0.f}, s1 = (v4f){0.f, 0.f, 0.f, 0.f};
        constexpr int NCH = SEQ / TC;
        for (int c = 0; c < NCH; ++c) {
            if (c + 1 < NCH) GDN_LOAD(c + 1);
            const LAS float* B_ = base + (c & 1) * BUF;
            LAS float* os = base + 2 * BUF + (c & 1) * (TC * 32);
#pragma unroll 4
            for (int t = 0; t < TC; ++t) {
                const v4f k0 = *(const LAS v4f*)(B_ + t * 128 + 4 * sub), k1 = *(const LAS v4f*)(B_ + t * 128 + 64 + 4 * sub);
                const v4f q0 = *(const LAS v4f*)(B_ + TC * 128 + t * 128 + 4 * sub), q1 = *(const LAS v4f*)(B_ + TC * 128 + t * 128 + 64 + 4 * sub);
                const float v = B_[TC * 256 + t * 32 + col];
                const float e = B_[TC * 256 + TC * 32 + 2 * t], bt = B_[TC * 256 + TC * 32 + 2 * t + 1];
                float d1 = (k0.x * s0.x + k0.y * s0.y) + (k0.z * s0.z + k0.w * s0.w) + (k1.x * s1.x + k1.y * s1.y) + (k1.z * s1.z + k1.w * s1.w);
                d1 = row16_sum(d1);
                const float vnew = bt * (v - e * d1);
                s0 = s0 * e + k0 * vnew; s1 = s1 * e + k1 * vnew;
                float d2 = (q0.x * s0.x + q0.y * s0.y) + (q0.z * s0.z + q0.w * s0.w) + (q1.x * s1.x + q1.y * s1.y) + (q1.z * s1.z + q1.w * s1.w);
                d2 = row16_sum(d2);
                if (sub == 0) os[t * 32 + col] = d2;
            }
            if (c + 1 < NCH) GDN_STORE((c + 1) & 1);
            __syncthreads();
            {
                const int r = F.tid >> 4, cc = (F.tid & 15) * 2;
                const v2f ov = *(const LAS v2f*)(os + r * 32 + cc);
                *(v2f*)(og + (row0 + (size_t)c * TC + r) * GW + h * HD + cg * 32 + cc) = ov;
            }
        }
#undef GDN_LOAD
#undef GDN_STORE
    }
}

__device__ __forceinline__ void gdn_gate_phase(const Args& a, Frame& F) {
    const float* og = (const float*)(a.ws + WS_WB + 192 * MiB);
    const bf16* proj = (const bf16*)(a.ws + WS_HB);
    bf16* mixed = (bf16*)(a.ws + WS_MIXED);
    const float* nw = a.in[5];
    const int gw = F.bid * NWAVES + F.wave, NGW = F.G * NWAVES;
    const int cl = (F.lane & 15) * 8;
    const v4f n0 = *(const v4f*)(nw + cl), n1 = *(const v4f*)(nw + cl + 4);
    for (int t = gw; t < NTOK; t += NGW) {
#pragma unroll
        for (int j = 0; j < 4; ++j) {
            const int c = j * 512 + F.lane * 8;
            const v4f o0 = *(const v4f*)(og + (size_t)t * GW + c), o1 = *(const v4f*)(og + (size_t)t * GW + c + 4);
            float z[8]; unpack8(*(const v4u*)(proj + (size_t)t * EVEN_IN + PE_Z + c), z);
            float ss = (o0.x * o0.x + o0.y * o0.y) + (o0.z * o0.z + o0.w * o0.w) + (o1.x * o1.x + o1.y * o1.y) + (o1.z * o1.z + o1.w * o1.w);
            ss = row16_sum(ss);
            const float r = rsqrtf(ss * (1.0f / 128.0f) + RMS_EPS);
            float y[8];
            y[0] = o0.x * r * n0.x * siluf_(z[0]); y[1] = o0.y * r * n0.y * siluf_(z[1]); y[2] = o0.z * r * n0.z * siluf_(z[2]); y[3] = o0.w * r * n0.w * siluf_(z[3]);
            y[4] = o1.x * r * n1.x * siluf_(z[4]); y[5] = o1.y * r * n1.y * siluf_(z[5]); y[6] = o1.z * r * n1.z * siluf_(z[6]); y[7] = o1.w * r * n1.w * siluf_(z[7]);
            *(v4u*)(mixed + (size_t)t * DM + c) = pack8(y);
        }
    }
}

__device__ __forceinline__ void rg_scan_phase(const Args& a, Frame& F) {
    const float* Ain = (const float*)(a.ws + WS_A); const float* Bin = (const float*)(a.ws + WS_B);
    const bf16* proj = (const bf16*)(a.ws + WS_HB);
    bf16* mixed = (bf16*)(a.ws + WS_MIXED);
    LAS float* sA = (LAS float*)F.lds; LAS float* sH = sA + 16 * 32;
    const int ch = F.lane & 31, seg = F.wave * 2 + (F.lane >> 5);
    for (int item = F.bid; item < 256; item += F.G) {
        const int b = item >> 6, c = (item & 63) * 32 + ch;
        const size_t r0 = (size_t)b * SEQ + (size_t)seg * 128;
        float Ap = 1.f, Hh = 0.f;
#pragma unroll 8
        for (int t = 0; t < 128; ++t) { const float av = Ain[(r0 + t) * RGW + c], bv = Bin[(r0 + t) * RGW + c]; Hh = av * Hh + bv; Ap *= av; }
        __syncthreads();
        sA[seg * 32 + ch] = Ap; sH[seg * 32 + ch] = Hh;
        __syncthreads();
        float hin = 0.f;
        for (int s = 0; s < seg; ++s) hin = sA[s * 32 + ch] * hin + sH[s * 32 + ch];
        float hcur = hin;
#pragma unroll 8
        for (int t = 0; t < 128; ++t) {
            const float av = Ain[(r0 + t) * RGW + c], bv = Bin[(r0 + t) * RGW + c];
            hcur = av * hcur + bv;
            const float g = bf2f(proj[(r0 + t) * EVEN_IN + PE_RGGATE + c]);
            const unsigned p = pk2(hcur * gelu_tanh(g), 0.f);
            mixed[(r0 + t) * DM + GW + c] = (bf16)(p & 0xffffu);
        }
    }
}

__device__ __forceinline__ void ln_phase(Frame& F, const float* res, const bf16* mixb, const float* g, const float* bb, float* outf, bf16* outb) {
    const int gw = F.bid * NWAVES + F.wave, NGW = F.G * NWAVES;
    for (int row = gw; row < NTOK; row += NGW) {
        const float* rr = res + (size_t)row * DM; const bf16* mr = mixb + (size_t)row * DM;
        v4f y[16]; float s = 0.f;
#pragma unroll
        for (int j = 0; j < 16; ++j) {
            const v4f x = *(const v4f*)(rr + (64 * j + F.lane) * 4); const v2u mw = *(const v2u*)(mr + (64 * j + F.lane) * 4);
            y[j] = (v4f){DN_ALPHA * x.x + bflo(mw.x), DN_ALPHA * x.y + bfhi(mw.x), DN_ALPHA * x.z + bflo(mw.y), DN_ALPHA * x.w + bfhi(mw.y)};
            s += (y[j].x + y[j].y) + (y[j].z + y[j].w);
        }
        const float mean = wave_sum(s) * (1.0f / DM); float s2 = 0.f;
#pragma unroll
        for (int j = 0; j < 16; ++j) { y[j] = y[j] - mean; s2 += (y[j].x * y[j].x + y[j].y * y[j].y) + (y[j].z * y[j].z + y[j].w * y[j].w); }
        const float rstd = rsqrtf(wave_sum(s2) * (1.0f / DM) + LN_EPS);
#pragma unroll
        for (int j = 0; j < 16; ++j) {
            const int c = (64 * j + F.lane) * 4;
            const v4f gv = *(const v4f*)(g + c), bv = *(const v4f*)(bb + c);
            const v4f o = y[j] * rstd * gv + bv;
            *(v4f*)(outf + (size_t)row * DM + c) = o;
            if (outb) { v2u w; w.x = pk2(o.x, o.y); w.y = pk2(o.z, o.w); *(v2u*)(outb + (size_t)row * DM + c) = w; }
        }
    }
}

__device__ __forceinline__ void top16_of128(float va, float vb, int lane, float& outv, int& outi) {
    outv = 0.f; outi = 0;
#pragma unroll 1
    for (int r = 0; r < 16; ++r) {
        const float wm = wave_max(fmaxf(va, vb));
        const unsigned long long ba = __ballot(va == wm);
        int widx;
        if (ba) { const int wl = __ffsll((long long)ba) - 1; widx = wl; if (lane == wl) va = -INFINITY; }
        else { const unsigned long long bb = __ballot(vb == wm); const int wl = __ffsll((long long)bb) - 1; widx = wl + 64; if (lane == wl) vb = -INFINITY; }
        if (lane == r) { outv = wm; outi = widx; }
    }
}
__device__ __forceinline__ void peer_topk_phase(Frame& F, const float* q, const float* keys, int* idx, float* gate) {
    LAS float* keyS = (LAS float*)F.lds;
    LAS float* qS = keyS + 128 * 132;
    LAS float* sc = qS + 32 * 132;
    for (int u = F.bid; u < 2048; u += F.G) {
        const int tile = u >> 3, h = u & 7, t0 = tile * 32;
        for (int p = 0; p < 2; ++p) {
            __syncthreads();
            const float* kp = keys + (size_t)(h * 2 + p) * PNK * PHALF;
#pragma unroll
            for (int i = 0; i < 8; ++i) { const int f4 = F.tid + NTHR * i, row = f4 >> 5, c4 = f4 & 31; *(LAS v4f*)(keyS + row * 132 + 4 * c4) = *(const v4f*)(kp + row * 128 + 4 * c4); }
#pragma unroll
            for (int i = 0; i < 2; ++i) { const int f4 = F.tid + NTHR * i, row = f4 >> 5, c4 = f4 & 31; *(LAS v4f*)(qS + row * 132 + 4 * c4) = *(const v4f*)(q + (size_t)(t0 + row) * PQ + h * 256 + p * 128 + 4 * c4); }
            __syncthreads();
            float acc[4][2];
#pragma unroll
            for (int i = 0; i < 4; ++i) { acc[i][0] = 0.f; acc[i][1] = 0.f; }
#pragma unroll 4
            for (int d4 = 0; d4 < 32; ++d4) {
                const v4f k0 = *(const LAS v4f*)(keyS + F.lane * 132 + 4 * d4), k1 = *(const LAS v4f*)(keyS + (F.lane + 64) * 132 + 4 * d4);
#pragma unroll
                for (int i = 0; i < 4; ++i) { const v4f qv = *(const LAS v4f*)(qS + (4 * F.wave + i) * 132 + 4 * d4);
                    acc[i][0] += (qv.x * k0.x + qv.y * k0.y) + (qv.z * k0.z + qv.w * k0.w);
                    acc[i][1] += (qv.x * k1.x + qv.y * k1.y) + (qv.z * k1.z + qv.w * k1.w); }
            }
#pragma unroll
            for (int i = 0; i < 4; ++i) { sc[(4 * F.wave + i) * 256 + p * 128 + F.lane] = acc[i][0]; sc[(4 * F.wave + i) * 256 + p * 128 + 64 + F.lane] = acc[i][1]; }
        }
        LDS_WAIT(); asm volatile("" ::: "memory");
        int ci, cj; { const int l = F.lane;
            if (l < 16) { ci = 0; cj = l; } else if (l < 24) { ci = 1; cj = l - 16; } else if (l < 29) { ci = 2; cj = l - 24; } else if (l < 33) { ci = 3; cj = l - 29; }
            else if (l < 36) { ci = 4; cj = l - 33; } else if (l < 42) { ci = 5 + ((l - 36) >> 1); cj = (l - 36) & 1; } else { ci = 8 + (l - 42); cj = 0; } }
        const bool cvalid = F.lane < 50; if (!cvalid) { ci = 0; cj = 0; }
#pragma unroll 1
        for (int i = 0; i < 4; ++i) {
            const int tok = 4 * F.wave + i;
            float v1, v2; int i1, i2;
            top16_of128(sc[tok * 256 + F.lane], sc[tok * 256 + 64 + F.lane], F.lane, v1, i1);
            top16_of128(sc[tok * 256 + 128 + F.lane], sc[tok * 256 + 192 + F.lane], F.lane, v2, i2);
            float cv = __shfl(v1, ci) + __shfl(v2, cj); if (!cvalid) cv = -INFINITY;
            const int cpos = ci * 16 + cj;
            float osc = 0.f; int opos = 0;
#pragma unroll 1
            for (int r = 0; r < 16; ++r) {
                const float wm = wave_max(cv);
                const unsigned long long bm = __ballot(cv == wm);
                int wl = __ffsll((long long)bm) - 1;
                if (__popcll(bm) > 1) {
                    int pp = (cv == wm) ? cpos : 0x7fffffff;
#pragma unroll
                    for (int o = 1; o < 64; o <<= 1) pp = min(pp, __shfl_xor(pp, o));
                    wl = __ffsll((long long)__ballot(cv == wm && cpos == pp)) - 1;
                }
                const int wpos = __shfl(cpos, wl);
                if (F.lane == wl) cv = -INFINITY;
                if (F.lane == r) { osc = wm; opos = wpos; }
            }
            const float mx = __shfl(osc, 0);
            float e = (F.lane < 16) ? __expf(osc - mx) : 0.f;
            const float den = row16_sum(e);
            const int e1 = __shfl(i1, opos >> 4), e2 = __shfl(i2, opos & 15);
            if (F.lane < 16) { const size_t o = (size_t)(t0 + tok) * 128 + h * 16 + F.lane; idx[o] = e1 * PNK + e2; gate[o] = e / den; }
        }
    }
}

__device__ __forceinline__ void peer_sparse_phase(Frame& F, const int* idx, const float* gate, const bf16* Hb, bf16* Wb) {
    const int gw = F.bid * NWAVES + F.wave, NGW = F.G * NWAVES;
    for (int t = gw; t < NTOK; t += NGW) {
        const int e0 = idx[(size_t)t * 128 + F.lane], e1 = idx[(size_t)t * 128 + 64 + F.lane];
        const float g0 = gate[(size_t)t * 128 + F.lane], g1 = gate[(size_t)t * 128 + 64 + F.lane];
        const float h0 = bf2f(Hb[(size_t)t * PE + e0]), h1 = bf2f(Hb[(size_t)t * PE + e1]);
        v4u* wrow = (v4u*)(Wb + (size_t)t * PE);
        const v4u z = (v4u){0u, 0u, 0u, 0u};
#pragma unroll 8
        for (int j = 0; j < 32; ++j) wrow[64 * j + F.lane] = z;
        float tot0 = 0.f, tot1 = 0.f; bool first0 = true, first1 = true;
#pragma unroll 8
        for (int j = 0; j < 64; ++j) {
            const int ea = __shfl(e0, j), eb = __shfl(e1, j); const float ga = __shfl(g0, j), gb = __shfl(g1, j);
            if (ea == e0) { tot0 += ga; if (j < F.lane) first0 = false; }
            if (eb == e0) { tot0 += gb; }
            if (ea == e1) { tot1 += ga; first1 = false; }
            if (eb == e1) { tot1 += gb; if (j < F.lane) first1 = false; }
        }
        VM_WAIT();
        if (first0) { const unsigned p = pk2(tot0 * gelu_tanh(h0), 0.f); Wb[(size_t)t * PE + e0] = (bf16)(p & 0xffffu); }
        if (first1) { const unsigned p = pk2(tot1 * gelu_tanh(h1), 0.f); Wb[(size_t)t * PE + e1] = (bf16)(p & 0xffffu); }
    }
}

__device__ __forceinline__ void sb_attn_phase(const Args& a, Frame& F) {
    const bf16* proj = (const bf16*)(a.ws + WS_HB);
    bf16* mixed = (bf16*)(a.ws + WS_MIXED);
    LAS bf16* Qs = (LAS bf16*)F.lds;
    LAS bf16* Ks = Qs + 128 * 136;
    LAS bf16* Vt = Ks + 64 * 136;
    LAS float* wmaxs = (LAS float*)(Vt + 128 * 72);
    const int m = F.lane & 15, q = F.lane >> 4;
    for (int item = F.bid; item < 1024; item += F.G) {
        const int qb = item & 15, hd = (item >> 4) & 15, b = item >> 8;
        const int t0 = qb * 128; const size_t row0 = (size_t)b * SEQ;
        __syncthreads();
        {   const int r = F.tid >> 2, c = (F.tid & 3) * 32;
#pragma unroll
            for (int i = 0; i < 4; ++i) *(LAS v4u*)(Qs + r * 136 + c + 8 * i) = *(const v4u*)(proj + (row0 + t0 + r) * ODD_IN + hd * HD + c + 8 * i); }
        __syncthreads();
        v8s Qf[4];
#pragma unroll
        for (int ks = 0; ks < 4; ++ks) Qf[ks] = *(const LAS v8s*)(Qs + (16 * F.wave + m) * 136 + 32 * ks + 8 * q);
        v4f O[8];
#pragma unroll
        for (int dt = 0; dt < 8; ++dt) O[dt] = (v4f){0.f, 0.f, 0.f, 0.f};
        float R = 0.f;
        const int tq = t0 + 16 * F.wave + m;
        for (int kb = (t0 >> 6) + 1; kb >= 0; --kb) {
            const int s0 = kb * 64;
            __syncthreads();
            {   const int r = F.tid >> 3, c = (F.tid & 7) * 16;
                const v4u k0 = *(const v4u*)(proj + (row0 + s0 + r) * ODD_IN + SBW + hd * HD + c), k1 = *(const v4u*)(proj + (row0 + s0 + r) * ODD_IN + SBW + hd * HD + c + 8);
                const v4u v0 = *(const v4u*)(proj + (row0 + s0 + r) * ODD_IN + 2 * SBW + hd * HD + c), v1 = *(const v4u*)(proj + (row0 + s0 + r) * ODD_IN + 2 * SBW + hd * HD + c + 8);
                *(LAS v4u*)(Ks + r * 136 + c) = k0; *(LAS v4u*)(Ks + r * 136 + c + 8) = k1;
                const unsigned vw[8] = {v0.x, v0.y, v0.z, v0.w, v1.x, v1.y, v1.z, v1.w};
#pragma unroll
                for (int i = 0; i < 8; ++i) { Vt[(c + 2 * i) * 72 + r] = (bf16)(vw[i] & 0xffffu); Vt[(c + 2 * i + 1) * 72 + r] = (bf16)(vw[i] >> 16); }
            }
            __syncthreads();
            v4f S[4];
#pragma unroll
            for (int jt = 0; jt < 4; ++jt) { S[jt] = (v4f){0.f, 0.f, 0.f, 0.f};
#pragma unroll
                for (int ks = 0; ks < 4; ++ks) { const v8s Kf = *(const LAS v8s*)(Ks + (16 * jt + m) * 136 + 32 * ks + 8 * q); S[jt] = MFMA16(Kf, Qf[ks], S[jt]); } }
            float l[4][4], G[4];
#pragma unroll
            for (int jt = 0; jt < 4; ++jt) { G[jt] = 0.f;
#pragma unroll
                for (int r = 0; r < 4; ++r) { const float z = S[jt][r] * 0.08838834764831845f; S[jt][r] = z;
                    const bool mk = (s0 + 16 * jt + 4 * q + r) < tq;
                    const float lv = mk ? -softplusf_(z) : 0.f; l[jt][r] = lv; G[jt] += lv; } }
            float tg[4], TOT[4];
#pragma unroll
            for (int jt = 0; jt < 4; ++jt) {
                const float g1 = __shfl_xor(G[jt], 16), g2 = __shfl_xor(G[jt], 32), g3 = __shfl_xor(G[jt], 48);
                TOT[jt] = (G[jt] + g1) + (g2 + g3);
                tg[jt] = (((q ^ 1) > q) ? g1 : 0.f) + (((q ^ 2) > q) ? g2 : 0.f) + (((q ^ 3) > q) ? g3 : 0.f);
            }
            float after = 0.f;
            v4u Pw[2];
#pragma unroll
            for (int jt = 3; jt >= 0; --jt) {
                float tail = R + after + tg[jt];
                float w[4];
#pragma unroll
                for (int r = 3; r >= 0; --r) {
                    const bool mk = (s0 + 16 * jt + 4 * q + r) < tq;
                    w[r] = mk ? __expf(S[jt][r] + l[jt][r] + tail) : 0.f;
                    tail += l[jt][r];
                }
                after += TOT[jt];
                const unsigned lo = pk2(w[0], w[1]), hi = pk2(w[2], w[3]);
                if (jt & 1) { Pw[jt >> 1].z = lo; Pw[jt >> 1].w = hi; } else { Pw[jt >> 1].x = lo; Pw[jt >> 1].y = hi; }
            }
            R += after;
#pragma unroll
            for (int kp = 0; kp < 2; ++kp) {
                const v8s Pf = __builtin_bit_cast(v8s, Pw[kp]);
#pragma unroll
                for (int dt = 0; dt < 8; ++dt) {
                    const v2u a0 = *(const LAS v2u*)(Vt + (16 * dt + m) * 72 + 32 * kp + 4 * q), a1 = *(const LAS v2u*)(Vt + (16 * dt + m) * 72 + 32 * kp + 16 + 4 * q);
                    const v4u av = (v4u){a0.x, a0.y, a1.x, a1.y};
                    O[dt] = MFMA16(__builtin_bit_cast(v8s, av), Pf, O[dt]);
                }
            }
            const float wm = wave_max(R);
            if (F.lane == 0) wmaxs[F.wave] = wm;
            __syncthreads();
            float bm = wmaxs[0];
#pragma unroll
            for (int w = 1; w < 8; ++w) bm = fmaxf(bm, wmaxs[w]);
            if (bm < -100.f) break;
        }
#pragma unroll
        for (int dt = 0; dt < 8; ++dt) { v2u w; w.x = pk2(O[dt][0], O[dt][1]); w.y = pk2(O[dt][2], O[dt][3]);
            *(v2u*)(mixed + (row0 + tq) * ODD_MIX + hd * HD + 16 * dt + 4 * q) = w; }
    }
}

__device__ __forceinline__ void s5_phase(const Args& a, Frame& F) {
    const bf16* proj = (const bf16*)(a.ws + WS_HB);
    bf16* yg = (bf16*)(a.ws + WS_YG);
    LAS float* us = (LAS float*)F.lds;
    LAS float* hre = us + 64 * 16;
    LAS float* him = hre + 64 * 65;
    LAS float* Cre = him + 64 * 65;
    LAS float* Cim = Cre + 16 * 65;
    for (int item = F.bid; item < 256; item += F.G) {
        const int b = item >> 6, g = item & 63; const size_t row0 = (size_t)b * SEQ;
        const int n = F.lane;
        const float dt = __expf(a.in[17][g]);
        const float lr = fminf(a.in[15][g * 64 + n], -1e-4f), li = a.in[16][g * 64 + n];
        const float mag = expf(lr * dt), ab_re = mag * cosf(li * dt), ab_im = mag * sinf(li * dt);
        const float den = lr * lr + li * li, nr = ab_re - 1.0f, ni = ab_im;
        const float cr = (nr * lr + ni * li) / den, ci = (ni * lr - nr * li) / den;
        float bbr[16], bbi[16];
#pragma unroll
        for (int c = 0; c < 16; ++c) { const float br = a.in[18][((size_t)g * 64 + n) * 16 + c], bi = a.in[19][((size_t)g * 64 + n) * 16 + c]; bbr[c] = cr * br - ci * bi; bbi[c] = cr * bi + ci * br; }
        __syncthreads();
        for (int o = F.tid; o < 1024; o += NTHR) { const int c = o >> 6, nn = o & 63; Cre[c * 65 + nn] = a.in[20][((size_t)g * 16 + c) * 64 + nn]; Cim[c * 65 + nn] = a.in[21][((size_t)g * 16 + c) * 64 + nn]; }
        const int yc = F.tid & 15;
        const float Dc = a.in[22][g * 16 + yc];
        float h_re = 0.f, h_im = 0.f;
        for (int ch = 0; ch < SEQ / 64; ++ch) {
            const size_t r0 = row0 + (size_t)ch * 64;
            __syncthreads();
            if (F.tid < 128) { const int r = F.tid >> 1, c8 = (F.tid & 1) * 8; float x[8]; unpack8(*(const v4u*)(proj + (r0 + r) * ODD_IN + 3 * SBW + g * 16 + c8), x);
#pragma unroll
                for (int e = 0; e < 8; ++e) us[r * 16 + c8 + e] = x[e]; }
            __syncthreads();
#pragma unroll
            for (int i = 0; i < 8; ++i) { const int t = F.wave * 8 + i; float sr = 0.f, si = 0.f;
#pragma unroll
                for (int c = 0; c < 16; ++c) { const float uv = us[t * 16 + c]; sr += uv * bbr[c]; si += uv * bbi[c]; }
                hre[t * 65 + n] = sr; him[t * 65 + n] = si; }
            __syncthreads();
            if (F.wave == 0) {
#pragma unroll 8
                for (int t = 0; t < 64; ++t) { const float br = hre[t * 65 + n], bi = him[t * 65 + n];
                    const float nre = ab_re * h_re - ab_im * h_im + br, nim = ab_re * h_im + ab_im * h_re + bi; h_re = nre; h_im = nim;
                    hre[t * 65 + n] = nre; him[t * 65 + n] = nim; }
            }
            __syncthreads();
#pragma unroll
            for (int i = 0; i < 2; ++i) { const int t = (F.tid >> 4) + 32 * i; float y = 0.f;
#pragma unroll 8
                for (int nn = 0; nn < 64; ++nn) y += hre[t * 65 + nn] * Cre[yc * 65 + nn] - him[t * 65 + nn] * Cim[yc * 65 + nn];
                y += Dc * us[t * 16 + yc];
                const unsigned p = pk2(gelu_tanh(y), 0.f);
                yg[(r0 + t) * S5W + g * 16 + yc] = (bf16)(p & 0xffffu); }
        }
    }
}

namespace pg8 {
struct EpiGlu {
    static constexpr bool PERM = true, AFTER_DRAIN = false;
    bf16_t* O; int ldo; int ocol0; const bf16_t* Y; int ldy; const float* bias;
    __device__ __forceinline__ void operator()(const f32x4 (&acc)[2][2][4][2], const Unit& u, int wr, int wc, int fr, int fq) const {
        const int row0 = u.pm * BM + wr * 64 + fr, col0 = u.pn * BM + wc * 32 + 8 * fq;
#pragma unroll
        for (int ai = 0; ai < 2; ++ai)
#pragma unroll
            for (int m = 0; m < 4; ++m) { const int row = row0 + ai * HALF + m * 16;
#pragma unroll
                for (int bj = 0; bj < 2; ++bj) { const int col = col0 + bj * HALF;
                    const f32x4 b0 = *(const f32x4*)(bias + col), b1 = *(const f32x4*)(bias + col + 4);
                    const f32x4 v0 = acc[ai][bj][m][0] + b0, v1 = acc[ai][bj][m][1] + b1;
                    const u32x4 yw = *(const u32x4*)(Y + (size_t)row * ldy + col);
                    float y[8]; unpack8(yw, y);
                    u32x4 w; w.x = pk2(y[0] * sigmoidf_(v0[0]), y[1] * sigmoidf_(v0[1])); w.y = pk2(y[2] * sigmoidf_(v0[2]), y[3] * sigmoidf_(v0[3]));
                    w.z = pk2(y[4] * sigmoidf_(v1[0]), y[5] * sigmoidf_(v1[1])); w.w = pk2(y[6] * sigmoidf_(v1[2]), y[7] * sigmoidf_(v1[3]));
                    *(u32x4*)(O + (size_t)row * ldo + ocol0 + col) = w; } }
    }
};
}

template <class Epi>
__device__ __forceinline__ void gemm(Frame& F, const bf16* A, const bf16* Bt, int M, int N, int K, const Epi& E) {
    pg8::Gemm g{A, Bt, M, N, K}; pg8::StaticOrder S; S.init(M, N, F.G, F.bid);
    pg8::gemm_phase<Epi, pg8::StaticOrder, false>(F.lds, g, S, E, nullptr);
}

#define PEER_LAYER(PB, L, HBF, RESF, OUTF, OUTB)                                                                                                              \
    if (IN(PB)) { gemm(F, (const bf16*)(HBF), (const bf16*)(ws + ((L) ? WS_WQ1 : WS_WQ0)), NTOK, PQ, DM, pg8::EpiF32{(float*)(ws + WS_Q), PQ, nullptr}); SEAM(PB); }     \
    if (IN(PB + 1)) { peer_topk_phase(F, (const float*)(ws + WS_Q), a.in[29] + (size_t)(L) * PH * 2 * PNK * PHALF, (int*)(ws + WS_IDX), (float*)(ws + WS_GATE));      \
        __syncthreads();                                                                                                                                          \
        gemm(F, (const bf16*)(HBF), (const bf16*)(ws + ((L) ? WS_U1 : WS_U0)), NTOK, PE, DM, pg8::EpiBf16<0>{(bf16*)(ws + WS_HB), PE, nullptr, 0, 0}); SEAM(PB + 1); }    \
    if (IN(PB + 2)) { peer_sparse_phase(F, (const int*)(ws + WS_IDX), (const float*)(ws + WS_GATE), (const bf16*)(ws + WS_HB), (bf16*)(ws + WS_WB)); SEAM(PB + 2); }   \
    if (IN(PB + 3)) { gemm(F, (const bf16*)(ws + WS_WB), (const bf16*)(ws + ((L) ? WS_VT1 : WS_VT0)), NTOK, DM, PE, pg8::EpiBf16<0>{(bf16*)(ws + WS_MIX), DM, nullptr, 0, 0}); SEAM(PB + 3); } \
    if (IN(PB + 4)) { ln_phase(F, (RESF), (const bf16*)(ws + WS_MIX), a.in[32] + (L) * DM, a.in[33] + (L) * DM, (OUTF), (OUTB)); SEAM(PB + 4); }

constexpr int N_PHASES = 22;

__global__ void __launch_bounds__(NTHR, 2) fwd_kernel(Args a) {
    extern __shared__ __attribute__((aligned(16))) unsigned char lds_raw[];
    Frame F; F.lds = (LAS unsigned char*)lds_raw; F.tid = threadIdx.x; F.lane = F.tid & 63; F.wave = __builtin_amdgcn_readfirstlane(F.tid >> 6); F.G = gridDim.x; F.bid = blockIdx.x;
    unsigned char* ws = a.ws;
    volatile LAS unsigned* MISC = (volatile LAS unsigned*)(F.lds + MISC_OFF);
    if (F.tid < 32) MISC[F.tid] = 0u;
    __syncthreads();
    const bool one_launch = (a.ph_hi - a.ph_lo) > 1;
    XcdBarrier bar; bar.bar = (unsigned*)(ws + WS_CTL) + CW_BAR; bar.x = 0; bar.st = nullptr;
    if (one_launch) bar = xcd_barrier_post((unsigned*)(ws + WS_CTL) + CW_BAR, MISC + 8);
    const int lo = a.ph_lo, hi = a.ph_hi;
#define IN(k) (lo <= (k) && (k) < hi)
#define SEAM(k) do { if (IN((k) + 1)) xcd_barrier(bar); } while (0)

    if (IN(0)) { p0_prologue(a, F); SEAM(0); }
    if (IN(1)) { gemm(F, (const bf16*)(ws + WS_XB0), (const bf16*)(ws + WS_WINE), NTOK, EVEN_IN, DM, pg8::EpiBf16<0>{(bf16*)(ws + WS_HB), EVEN_IN, nullptr, 0, 0}); SEAM(1); }
    if (IN(2)) { gdn_prep_phase(a, F); ab_proj_phase(a, F); rg_gates_phase(a, F); SEAM(2); }
    if (IN(3)) { gdn_rec_phase(a, F); SEAM(3); }
    if (IN(4)) { gdn_gate_phase(a, F); rg_scan_phase(a, F); SEAM(4); }
    if (IN(5)) { gemm(F, (const bf16*)(ws + WS_MIXED), (const bf16*)(ws + WS_WOUTE), NTOK, DM, DM, pg8::EpiBf16<0>{(bf16*)(ws + WS_MIX), DM, nullptr, 0, 0}); SEAM(5); }
    if (IN(6)) { ln_phase(F, a.in[0], (const bf16*)(ws + WS_MIX), a.in[26], a.in[27], (float*)(ws + WS_RES), (bf16*)(ws + WS_XB1)); SEAM(6); }
    PEER_LAYER(7, 0, ws + WS_XB1, (const float*)(ws + WS_RES), a.out, (bf16*)(ws + WS_XB0))
    if (IN(12)) { gemm(F, (const bf16*)(ws + WS_XB0), (const bf16*)(ws + WS_WINO), NTOK, ODD_IN, DM, pg8::EpiBf16<0>{(bf16*)(ws + WS_HB), ODD_IN, nullptr, 0, 0}); SEAM(12); }
    if (IN(13)) { sb_attn_phase(a, F); s5_phase(a, F); SEAM(13); }
    if (IN(14)) { gemm(F, (const bf16*)(ws + WS_YG), (const bf16*)(ws + WS_GLU), NTOK, S5W, S5W, pg8::EpiGlu{(bf16*)(ws + WS_MIXED), ODD_MIX, SBW, (const bf16*)(ws + WS_YG), S5W, a.in[24]}); SEAM(14); }
    if (IN(15)) { gemm(F, (const bf16*)(ws + WS_MIXED), (const bf16*)(ws + WS_WOUTO), NTOK, DM, ODD_MIX, pg8::EpiBf16<0>{(bf16*)(ws + WS_MIX), DM, nullptr, 0, 0}); SEAM(15); }
    if (IN(16)) { ln_phase(F, a.out, (const bf16*)(ws + WS_MIX), a.in[26] + DM, a.in[27] + DM, (float*)(ws + WS_RES), (bf16*)(ws + WS_XB1)); SEAM(16); }
    PEER_LAYER(17, 1, ws + WS_XB1, (const float*)(ws + WS_RES), a.out, (bf16*)nullptr)
#undef IN
#undef SEAM
}

#ifndef MK_ONE_LAUNCH
#define MK_ONE_LAUNCH 0
#endif
extern "C" void kernel_launch(void* const* d_in, const int* in_sizes, int n_in, void* d_out, int out_size, void* d_ws, size_t ws_size, hipStream_t stream) {
    static int grid = 0;
    if (grid == 0) {
        if (n_in != 34 || in_sizes[0] != NTOK * DM || out_size != NTOK * DM || ws_size < WS_END) { fprintf(stderr, "kernel_launch: unexpected shapes (n_in %d, in0 %d, out %d, ws %zu < %zu); nothing launched\n", n_in, n_in > 0 ? in_sizes[0] : -1, out_size, ws_size, (size_t)WS_END); grid = -1; return; }
        int dev = 0, cus = 0, per_cu = 0;
        if (hipGetDevice(&dev) != hipSuccess || hipDeviceGetAttribute(&cus, hipDeviceAttributeMultiprocessorCount, dev) != hipSuccess) { grid = -1; return; }
        if (hipFuncSetAttribute((const void*)fwd_kernel, hipFuncAttributeMaxDynamicSharedMemorySize, LDS_BYTES) != hipSuccess) { fprintf(stderr, "kernel_launch: hipFuncSetAttribute failed\n"); grid = -1; return; }
        if (hipOccupancyMaxActiveBlocksPerMultiprocessor(&per_cu, (const void*)fwd_kernel, NTHR, LDS_BYTES) != hipSuccess || per_cu < 1) { fprintf(stderr, "kernel_launch: occupancy query says %d blocks per CU\n", per_cu); }
        (void)hipGetLastError();
        grid = cus;
    }
    if (grid < 0) return;
    (void)hipMemsetAsync((char*)d_ws + WS_CTL, 0, CTL_ZERO_BYTES, stream);
    Args a{};
    for (int i = 0; i < 34; ++i) a.in[i] = (const float*)d_in[i];
    a.out = (float*)d_out; a.ws = (unsigned char*)d_ws;
#if MK_ONE_LAUNCH
    a.ph_lo = 0; a.ph_hi = N_PHASES;
    hipLaunchKernelGGL(fwd_kernel, dim3(grid), dim3(NTHR), LDS_BYTES, stream, a);
#else
    for (int p = 0; p < N_PHASES; ++p) { a.ph_lo = p; a.ph_hi = p + 1; hipLaunchKernelGGL(fwd_kernel, dim3(grid), dim3(NTHR), LDS_BYTES, stream, a); }
#endif
}
```

```cpp
#include <hip/hip_runtime.h>
#include <cstdio>
#include <cstdint>

#define GAS __attribute__((address_space(1)))
#define LAS __attribute__((address_space(3)))
typedef unsigned short bf16;
typedef unsigned v4u __attribute__((ext_vector_type(4)));
typedef unsigned v2u __attribute__((ext_vector_type(2)));
typedef float v4f __attribute__((ext_vector_type(4)));
typedef float v2f __attribute__((ext_vector_type(2)));
typedef short v8s __attribute__((ext_vector_type(8)));

constexpr int NB = 4, SEQ = 2048, DM = 4096, NTOK = NB * SEQ;
constexpr int GW = 2048, GH = 16, HD = 128;
constexpr int RGW = 2048, RGB = 128, RGN = 16;
constexpr int EVEN_IN_SRC = 12320;
constexpr int EVEN_IN = 12288;
constexpr int PE_Z = 6144, PE_RGIN = 8192, PE_RGGATE = 10240;
constexpr int ODD_IN = 7168;
constexpr int SBW = 2048, S5W = 1024, S5G = 64, S5N = 64, S5C = 16;
constexpr int ODD_MIX = 3072;
constexpr int PH = 8, PNK = 128, PHALF = 128, PTOPK = 16, PQ = 2048, PE = 16384;
constexpr float DN_ALPHA = 1.41421356237f;
constexpr float LN_EPS = 1e-5f, RMS_EPS = 1e-6f;

constexpr size_t MiB = 1u << 20;
constexpr size_t WS_CTL = 0, CTL_ZERO_BYTES = 1 * MiB;
constexpr size_t WS_WINE = 1 * MiB;
constexpr size_t WS_WAB = 97 * MiB;
constexpr size_t WS_WOUTE = 98 * MiB;
constexpr size_t WS_WINO = 130 * MiB;
constexpr size_t WS_WOUTO = 186 * MiB;
constexpr size_t WS_WQ0 = 210 * MiB;
constexpr size_t WS_WQ1 = 226 * MiB;
constexpr size_t WS_GLU = 242 * MiB;
constexpr size_t WS_RGW = 244 * MiB;
constexpr size_t WS_U0 = 246 * MiB;
constexpr size_t WS_U1 = 374 * MiB;
constexpr size_t WS_VT0 = 502 * MiB;
constexpr size_t WS_VT1 = 630 * MiB;
constexpr size_t WS_HB = 758 * MiB;
constexpr size_t WS_WB = 1014 * MiB;
constexpr size_t WS_XB0 = 1270 * MiB;
constexpr size_t WS_XB1 = 1334 * MiB;
constexpr size_t WS_RES = 1398 * MiB;
constexpr size_t WS_MIX = 1526 * MiB;
constexpr size_t WS_MIXED = 1590 * MiB;
constexpr size_t WS_Q = 1654 * MiB;
constexpr size_t WS_IDX = 1718 * MiB;
constexpr size_t WS_GATE = 1722 * MiB;
constexpr size_t WS_A = 1726 * MiB;
constexpr size_t WS_B = 1790 * MiB;
constexpr size_t WS_BETA = 1854 * MiB;
constexpr size_t WS_EG = 1855 * MiB;
constexpr size_t WS_YG = 1856 * MiB;
constexpr size_t WS_X8_0 = 1872 * MiB;
constexpr size_t WS_X8_1 = 1904 * MiB;
constexpr size_t WS_KH = 1936 * MiB;
constexpr size_t WS_KL = 1937 * MiB;
constexpr size_t WS_END = 1938 * MiB;
constexpr size_t WS_U8_0 = WS_U0, WS_U8_1 = WS_U0 + 64 * MiB;
constexpr size_t WS_VT8_0 = WS_VT0, WS_VT8_1 = WS_VT0 + 64 * MiB;
constexpr float U8_SCALE = 64.f, V8_SCALE = 8.f, W8_SCALE = 32.f, WIN8_SCALE = 64.f, WOUT8_SCALE = 128.f, MIX8_SCALE = 4.f;
constexpr int E8_1 = 0x7f7f7f7f, E8_U = 0x79797979  , E8_V = 0x7c7c7c7c  , E8_W = 0x7a7a7a7a  , E8_WIN = 0x79797979  , E8_WOUT = 0x78787878  , E8_MIX = 0x7d7d7d7d  ;
#ifndef FP8_WQ
#define FP8_WQ 0
#endif
#ifndef FP8_OUT
#define FP8_OUT 1
#endif
#ifndef FP8_INE
#define FP8_INE 1
#endif
#ifndef FP8_INO
#define FP8_INO 1
#endif
constexpr int CW_BAR = 4096;

constexpr int RING_BYTES = 131072;
constexpr int MISC_OFF = 147456 - 256;
constexpr int LDS_BYTES = 147456;
constexpr int NWAVES = 8, NTHR = 512;

typedef __bf16 v2bf __attribute__((ext_vector_type(2)));
__device__ __forceinline__ unsigned pk2(float lo, float hi) { const v2f f = {lo, hi}; return __builtin_bit_cast(unsigned, __builtin_convertvector(f, v2bf)); }
__device__ __forceinline__ float bflo(unsigned w) { return __uint_as_float(w << 16); }
__device__ __forceinline__ float bfhi(unsigned w) { return __uint_as_float(w & 0xffff0000u); }
__device__ __forceinline__ float bf2f(bf16 h) { return __uint_as_float(((unsigned)h) << 16); }
__device__ __forceinline__ void unpack8(const v4u w, float (&f)[8]) {
    f[0] = bflo(w.x); f[1] = bfhi(w.x); f[2] = bflo(w.y); f[3] = bfhi(w.y); f[4] = bflo(w.z); f[5] = bfhi(w.z); f[6] = bflo(w.w); f[7] = bfhi(w.w);
}
__device__ __forceinline__ v4u pack8(const float (&f)[8]) { v4u o; o.x = pk2(f[0], f[1]); o.y = pk2(f[2], f[3]); o.z = pk2(f[4], f[5]); o.w = pk2(f[6], f[7]); return o; }
__device__ __forceinline__ float sigmoidf_(float x) { return __builtin_amdgcn_rcpf(1.0f + __expf(-x)); }
__device__ __forceinline__ float siluf_(float x) { return x * __builtin_amdgcn_rcpf(1.0f + __expf(-x)); }
__device__ __forceinline__ float softplusf_(float x) { return fmaxf(x, 0.f) + log1pf(__expf(-fabsf(x))); }
__device__ __forceinline__ float gelu_tanh(float x) { const float u = 1.5957691216f * (x + 0.044715f * x * x * x); return x * __builtin_amdgcn_rcpf(1.0f + __expf(-u)); }
__device__ __forceinline__ float wave_sum(float v) {
#pragma unroll
    for (int o = 1; o < 64; o <<= 1) v += __shfl_xor(v, o);
    return v;
}
__device__ __forceinline__ float wave_max(float v) {
#pragma unroll
    for (int o = 1; o < 64; o <<= 1) v = fmaxf(v, __shfl_xor(v, o));
    return v;
}
__device__ __forceinline__ float row16_sum(float v) {
    v += __builtin_bit_cast(float, __builtin_amdgcn_update_dpp(0, __builtin_bit_cast(int, v), 0xB1, 0xf, 0xf, true));
    v += __builtin_bit_cast(float, __builtin_amdgcn_update_dpp(0, __builtin_bit_cast(int, v), 0x4E, 0xf, 0xf, true));
    v += __builtin_bit_cast(float, __builtin_amdgcn_update_dpp(0, __builtin_bit_cast(int, v), 0x141, 0xf, 0xf, true));
    v += __builtin_bit_cast(float, __builtin_amdgcn_update_dpp(0, __builtin_bit_cast(int, v), 0x140, 0xf, 0xf, true));
    return v;
}
__device__ __forceinline__ unsigned pk4_fp8(float a, float b, float c, float d) { int w = 0; w = __builtin_amdgcn_cvt_pk_fp8_f32(a, b, w, false); w = __builtin_amdgcn_cvt_pk_fp8_f32(c, d, w, true); return (unsigned)w; }
__device__ __forceinline__ float clamp448(float x) { return fminf(fmaxf(x, -448.f), 448.f); }
#define LDS_BARRIER() asm volatile("s_waitcnt lgkmcnt(0)\n\ts_barrier" ::: "memory")
__device__ __forceinline__ size_t tl_off(size_t t, int c, int ntn) {
    return ((t >> 8) * (size_t)ntn + (size_t)(c >> 8)) * 131072 + (size_t)((((t >> 6) & 1) * 4 + ((c >> 6) & 3)) * 16384) + (size_t)((((((t >> 7) & 1) * 4 + ((t >> 4) & 3)) * 2) + ((c >> 5) & 1)) * 1024)
         + (size_t)((((c >> 3) & 3) * 16 + (t & 15)) * 16) + (size_t)((c & 7) * 2);
}
#define LDS_WAIT() asm volatile("s_waitcnt lgkmcnt(0)" ::: "memory")
#define VM_WAIT() asm volatile("s_waitcnt vmcnt(0)" ::: "memory")
namespace pg8 {
#define PG8_LAS __attribute__((address_space(3)))
typedef unsigned short bf16_t;
typedef short bf16x8 __attribute__((ext_vector_type(8)));
typedef float f32x4 __attribute__((ext_vector_type(4)));
typedef unsigned u32x4 __attribute__((ext_vector_type(4)));
constexpr int BM = 256, BK = 64, HALF = 128, HTB = HALF * BK * 2  , STAGE_BYTES = 8 * HTB, NXCD = 8, WGM = 8;

__host__ __device__ __forceinline__ int lds_byte(int r, int c) { const int st = (r >> 4) * 2 + (c >> 5), rr = r & 15, cc = c & 31, ob = rr * 64 + cc * 2; return st * 1024 + (ob ^ (((ob >> 9) & 1) << 5)); }
__host__ __device__ __forceinline__ void stage_rc(int b, int& R, int& C) { const int st = b / 1024, sb = b % 1024, swz = sb ^ (((sb >> 9) & 1) << 5); R = (st >> 1) * 16 + swz / 64; C = (st & 1) * 32 + (swz % 64) / 2; }
__host__ __device__ __forceinline__ int perm32(int rho) { const int n = rho >> 4, i = rho & 15; return 8 * (i >> 2) + 4 * n + (i & 3); }

struct Unit { int pm, pn; };
struct Gemm { const bf16_t* A; const bf16_t* Bt; int M, N, K; };
typedef int i32x8 __attribute__((ext_vector_type(8)));
typedef int i32x4 __attribute__((ext_vector_type(4)));
__device__ __forceinline__ i32x8 pg8_cat(bf16x8 lo, bf16x8 hi) { const i32x4 a = __builtin_bit_cast(i32x4, lo), b = __builtin_bit_cast(i32x4, hi); return __builtin_shufflevector(a, b, 0, 1, 2, 3, 4, 5, 6, 7); }

struct StaticOrder {
    int nM, nN, nwg, G, c;
    __host__ __device__ void init(int M, int N, int G_, int c_) { nM = M / BM; nN = N / BM; nwg = nM * nN; G = G_; c = c_; }
    __host__ __device__ bool next(int i, Unit& u) const {
        const long L = (long)i * G + c; if (L >= nwg) return false;
        int wgid = (int)L; { const int q = nwg / NXCD, r = nwg % NXCD, xcd = wgid % NXCD, off = wgid / NXCD; wgid = (xcd < r ? xcd * (q + 1) : r * (q + 1) + (xcd - r) * q) + off; }
        const int nig = WGM * nN, gid = wgid / nig, fm = gid * WGM, gsz = (nM - fm) < WGM ? (nM - fm) : WGM;
        u.pm = fm + ((wgid % nig) % gsz); u.pn = (wgid % nig) / gsz; return true;
    }
    __device__ __forceinline__ void a_ready(const Unit&) const {}
    __device__ __forceinline__ void done(const Unit&) const {}
};
struct CountedOrder : StaticOrder {
    const unsigned* ready; unsigned need; unsigned* tmo;
    __device__ __forceinline__ void a_ready(const Unit& u) const {
        if (threadIdx.x < 64) {
            const unsigned long long t0 = __builtin_amdgcn_s_memrealtime(); unsigned polls = 0;
            while ((unsigned)__builtin_amdgcn_readfirstlane(__hip_atomic_load(ready + 64 * u.pm, __ATOMIC_RELAXED, __HIP_MEMORY_SCOPE_AGENT)) < need) {
                if ((++polls & 255u) == 0u && __builtin_amdgcn_readfirstlane(__hip_atomic_load(tmo, __ATOMIC_RELAXED, __HIP_MEMORY_SCOPE_AGENT)) != 0u) break;
                if (__builtin_amdgcn_s_memrealtime() - t0 > 2000000ull) {
                    if (threadIdx.x == 0) { unsigned expect = 0u; __hip_atomic_compare_exchange_strong(tmo + 1, &expect, 0x600u | (unsigned)(u.pm & 0xff), __ATOMIC_RELAXED, __ATOMIC_RELAXED, __HIP_MEMORY_SCOPE_AGENT); __hip_atomic_store(tmo, 1u, __ATOMIC_RELAXED, __HIP_MEMORY_SCOPE_AGENT); }
                    break; }
                __builtin_amdgcn_s_sleep(2); }
            __builtin_amdgcn_fence(__ATOMIC_ACQUIRE, "agent");
            asm volatile("s_waitcnt vmcnt(0)" ::: "memory");
        }
#if !defined(BROKEN_HOOK_NO_BARRIER)
        asm volatile("" ::: "memory"); __builtin_amdgcn_s_barrier(); asm volatile("" ::: "memory");
#endif
    }
};

__device__ __forceinline__ unsigned cvt_pk_bf16(float lo, float hi) { unsigned r; asm volatile("v_cvt_pk_bf16_f32 %0, %1, %2" : "=v"(r) : "v"(lo), "v"(hi)); return r; }
typedef float f32x2 __attribute__((ext_vector_type(2)));
__device__ __forceinline__ f32x2 gelu_pk(f32x2 v) {
    const f32x2 av = __builtin_elementwise_abs(v), d = av * 0.2316418882f + 1.0f;
    f32x2 t; t.x = __builtin_amdgcn_rcpf(d.x); t.y = __builtin_amdgcn_rcpf(d.y);
    f32x2 q = t * 0.5307027145f + (-0.7265760135f); q = q * t + 0.7107068705f; q = q * t + (-0.142248368f); q = q * t + 0.127414796f; q = q * t;
    const f32x2 s = (v * v) * (-0.72134752044f);
    f32x2 e; e.x = __builtin_amdgcn_exp2f(s.x); e.y = __builtin_amdgcn_exp2f(s.y);
    const f32x2 m = v * (q * e), r = v - m;
    f32x2 o; o.x = v.x < 0.f ? m.x : r.x; o.y = v.y < 0.f ? m.y : r.y; return o;
}

struct EpiF32 {
    static constexpr bool PERM = false, AFTER_DRAIN = false;
    float* C; int ldc; const float* bias;
    __device__ __forceinline__ void operator()(const f32x4 (&acc)[2][2][4][2], const Unit& u, int wr, int wc, int fr, int fq) const {
        const int row0 = u.pm * BM + wr * 64 + fr, col0 = u.pn * BM + wc * 32 + 4 * fq;
        f32x4 bv[2][2];
#pragma unroll
        for (int bj = 0; bj < 2; ++bj)
#pragma unroll
            for (int n = 0; n < 2; ++n) bv[bj][n] = bias ? *(const f32x4*)(bias + col0 + bj * HALF + n * 16) : (f32x4){0.f, 0.f, 0.f, 0.f};
#pragma unroll
        for (int ai = 0; ai < 2; ++ai)
#pragma unroll
            for (int m = 0; m < 4; ++m) { float* rowp = C + (size_t)(row0 + ai * HALF + m * 16) * ldc + col0;
#pragma unroll
                for (int bj = 0; bj < 2; ++bj)
#pragma unroll
                    for (int n = 0; n < 2; ++n) *(f32x4*)(rowp + bj * HALF + n * 16) = acc[ai][bj][m][n] + bv[bj][n]; }
    }
};
template <int ACT  > struct EpiBf16 {
    static constexpr bool PERM = true, AFTER_DRAIN = false;
    bf16_t* O; int ldc; const float* bias; int split_cols; size_t split_stride;
    __device__ __forceinline__ void operator()(const f32x4 (&acc)[2][2][4][2], const Unit& u, int wr, int wc, int fr, int fq) const {
        const int row0 = u.pm * BM + wr * 64 + fr; int colt = u.pn * BM; bf16_t* base = O;
        if (split_cols) { const int t = colt / split_cols; base += (size_t)t * split_stride; colt -= t * split_cols; }
        const int col0 = colt + wc * 64 + 8 * fq, bcol0 = u.pn * BM + wc * 64 + 8 * fq;
        f32x4 bv[2][2];
#pragma unroll
        for (int bj = 0; bj < 2; ++bj)
#pragma unroll
            for (int n = 0; n < 2; ++n) bv[bj][n] = bias ? *(const f32x4*)(bias + bcol0 + bj * 32 + 4 * n) : (f32x4){0.f, 0.f, 0.f, 0.f};
#pragma unroll
        for (int ai = 0; ai < 2; ++ai)
#pragma unroll
            for (int m = 0; m < 4; ++m) { bf16_t* rowp = base + (size_t)(row0 + ai * HALF + m * 16) * ldc + col0;
#pragma unroll
                for (int bj = 0; bj < 2; ++bj) { f32x4 v0 = acc[ai][bj][m][0] + bv[bj][0], v1 = acc[ai][bj][m][1] + bv[bj][1];
                    if (ACT == 1) { f32x2 a = gelu_pk((f32x2){v0[0], v0[1]}), b = gelu_pk((f32x2){v0[2], v0[3]}), c = gelu_pk((f32x2){v1[0], v1[1]}), d = gelu_pk((f32x2){v1[2], v1[3]});
                        v0 = (f32x4){a.x, a.y, b.x, b.y}; v1 = (f32x4){c.x, c.y, d.x, d.y}; }
                    if (ACT == 2) {
#pragma unroll
                        for (int j = 0; j < 4; ++j) { v0[j] = 0.5f * v0[j] * (1.0f + erff(v0[j] * 0.70710678f)); v1[j] = 0.5f * v1[j] * (1.0f + erff(v1[j] * 0.70710678f)); } }
                    u32x4 w; w.x = cvt_pk_bf16(v0[0], v0[1]); w.y = cvt_pk_bf16(v0[2], v0[3]); w.z = cvt_pk_bf16(v1[0], v1[1]); w.w = cvt_pk_bf16(v1[2], v1[3]);
#ifdef NT_STORES
                    __builtin_nontemporal_store(w, (u32x4*)(rowp + bj * 32)); } }
#else
                    *(u32x4*)(rowp + bj * 32) = w; } }
#endif
    }
};
template <class Epi, class Sched, bool STAMP = false, bool FP8 = false, int SW = 0x7f7f7f7f, int SX = 0x7f7f7f7f>
__device__ __forceinline__ void gemm_phase(PG8_LAS unsigned char* lds, const Gemm g, const Sched& S, const Epi& E, unsigned long long* stamps) {
    const int tid = threadIdx.x, wid = __builtin_amdgcn_readfirstlane(tid >> 6), lane = tid & 63, wr = wid >> 2, wc = wid & 3, fr = lane & 15, fq = lane >> 4;
    const int K = g.K, nt = K / BK;
    int ts_lo = 0, ts_hi = 0, nts = 0; const unsigned long long rt_entry = STAMP ? (unsigned long long)wall_clock64() : 0ull;
#define PG8_STAMP() do { if (STAMP && wid == 0 && nts < 64) { const unsigned long long _c = (unsigned long long)clock64(); \
        ts_lo = (lane == nts) ? (int)(unsigned)_c : ts_lo; ts_hi = (lane == nts) ? (int)(unsigned)(_c >> 32) : ts_hi; ++nts; } } while (0)
    PG8_STAMP();
    unsigned voffA[2], voffB[2];
#pragma unroll
    for (int i = 0; i < 2; ++i) { int R, C; stage_rc(tid * 16 + i * 8192, R, C); const int Rb = Epi::PERM ? (64 * (R >> 5) + perm32(R & 31)) : R;
        voffA[i] = (unsigned)(R * K + C) * 2u; voffB[i] = (unsigned)(Rb * K + C) * 2u; }
    const size_t kstep = (size_t)(BK * 2);
    const size_t hstep = (size_t)HALF * K * 2;
    const size_t hstepB = Epi::PERM ? (size_t)32 * K * 2 : hstep;
    const size_t tstep = 2 * hstep;
    const unsigned ldsw = (unsigned)wid * 1024u;
    const int aoff = lds_byte(wr * 64 + fr, fq * 8), boff = lds_byte(wc * 32 + fr, fq * 8);
#define PG8_SA(b, h) (((b) * 2 + (h)) * HTB)
#define PG8_SB(b, h) ((4 + (b) * 2 + (h)) * HTB)
#define PG8_STAGE(bufoff, gbase, voff) do { _Pragma("unroll") for (int _i = 0; _i < 2; ++_i) \
        __builtin_amdgcn_global_load_lds((const unsigned*)((const char*)(gbase) + (voff)[_i]), (PG8_LAS unsigned*)(lds + (bufoff) + ldsw + _i * 8192), 16, 0, 0); } while (0)
#define PG8_LDA(dst, b, h) do { _Pragma("unroll") for (int m = 0; m < 4; ++m) _Pragma("unroll") for (int k = 0; k < 2; ++k) dst[m][k] = *(const PG8_LAS bf16x8*)(lds + PG8_SA(b, h) + aoff + m * 2048 + k * 1024); } while (0)
#define PG8_LDB(dst, b, h) do { _Pragma("unroll") for (int n = 0; n < 2; ++n) _Pragma("unroll") for (int k = 0; k < 2; ++k) dst[n][k] = *(const PG8_LAS bf16x8*)(lds + PG8_SB(b, h) + boff + n * 2048 + k * 1024); } while (0)
#define PG8_MMA(ai, bj, At, Bt) do { __builtin_amdgcn_s_setprio(1); _Pragma("unroll") for (int m = 0; m < 4; ++m) _Pragma("unroll") for (int n = 0; n < 2; ++n) { \
        if constexpr (FP8) { asm volatile("v_mfma_scale_f32_16x16x128_f8f6f4 %0, %1, %2, %0, %3, %4 op_sel_hi:[0,0,0]" : "+v"(acc[ai][bj][m][n]) : "v"(pg8_cat(Bt[n][0], Bt[n][1])), "v"(pg8_cat(At[m][0], At[m][1])), "v"(SW), "v"(SX)); } \
        else { _Pragma("unroll") for (int k = 0; k < 2; ++k) acc[ai][bj][m][n] = __builtin_amdgcn_mfma_f32_16x16x32_bf16(Bt[n][k], At[m][k], acc[ai][bj][m][n], 0, 0, 0); } } __builtin_amdgcn_s_setprio(0); } while (0)
#define PG8_WAIT_V(n) asm volatile("s_waitcnt vmcnt(" #n ")" ::: "memory")
#define PG8_WAIT_L(n) asm volatile("s_waitcnt lgkmcnt(" #n ")" ::: "memory")
#define PG8_BAR __builtin_amdgcn_s_barrier()
#define PG8_SCHED __builtin_amdgcn_sched_barrier(0)
    Unit cur, nxt; int ui = 0;
    if (!S.next(0, cur)) return;
    f32x4 acc[2][2][4][2];
#pragma unroll
    for (int a = 0; a < 2; ++a)
#pragma unroll
        for (int b = 0; b < 2; ++b)
#pragma unroll
            for (int m = 0; m < 4; ++m)
#pragma unroll
                for (int n = 0; n < 2; ++n) acc[a][b][m][n] = (f32x4){0.f, 0.f, 0.f, 0.f};
    bf16x8 At[4][2], B0[2][2], B1[2][2];
    const char* cA = (const char*)g.A + (size_t)cur.pm * tstep; const char* cB = (const char*)g.Bt + (size_t)cur.pn * tstep;
    S.a_ready(cur);
    PG8_STAGE(PG8_SB(0, 0), cB, voffB); PG8_STAGE(PG8_SA(0, 0), cA, voffA); PG8_STAGE(PG8_SB(0, 1), cB + hstepB, voffB); PG8_STAGE(PG8_SA(0, 1), cA + hstep, voffA);
    if (wr == 1) PG8_BAR;
    PG8_WAIT_V(4); PG8_BAR;
    PG8_STAGE(PG8_SB(1, 0), cB + kstep, voffB); PG8_STAGE(PG8_SA(1, 0), cA + kstep, voffA); PG8_STAGE(PG8_SB(1, 1), cB + hstepB + kstep, voffB);
    PG8_WAIT_V(6); PG8_BAR;
    PG8_STAMP();
    for (;;) {
        const bool has_next = S.next(ui + 1, nxt);
        const char* nA = has_next ? (const char*)g.A + (size_t)nxt.pm * tstep : cA; const char* nB = has_next ? (const char*)g.Bt + (size_t)nxt.pn * tstep : cB;
        for (int t = 0; t < nt; t += 2) {
            const bool last = (t == nt - 2);
            const char* a1 = cA + (size_t)(t + 1) * kstep;
            const char* a2 = last ? nA : cA + (size_t)(t + 2) * kstep; const char* b2 = last ? nB : cB + (size_t)(t + 2) * kstep;
            const char* a3 = a2 + kstep; const char* b3 = b2 + kstep;
            if (last && has_next) S.a_ready(nxt);
            PG8_LDB(B0, 0, 0); PG8_SCHED; PG8_LDA(At, 0, 0); PG8_STAGE(PG8_SA(1, 1), a1 + hstep, voffA);
            PG8_WAIT_L(8); PG8_BAR; PG8_WAIT_L(0); PG8_MMA(0, 0, At, B0); PG8_BAR; PG8_SCHED;
            PG8_LDB(B1, 0, 1); PG8_STAGE(PG8_SB(0, 0), b2, voffB);
            PG8_BAR; PG8_WAIT_L(0); PG8_MMA(0, 1, At, B1); PG8_BAR;
            PG8_LDA(At, 0, 1); PG8_STAGE(PG8_SA(0, 0), a2, voffA);
            PG8_BAR; PG8_WAIT_L(0); PG8_MMA(1, 0, At, B0); PG8_BAR; PG8_SCHED;
            PG8_STAGE(PG8_SB(0, 1), b2 + hstepB, voffB);
            PG8_WAIT_V(6); PG8_BAR; PG8_MMA(1, 1, At, B1); PG8_BAR;
            PG8_LDB(B0, 1, 0); PG8_SCHED; PG8_LDA(At, 1, 0); PG8_STAGE(PG8_SA(0, 1), a2 + hstep, voffA);
            PG8_WAIT_L(8); PG8_BAR; PG8_WAIT_L(0); PG8_MMA(0, 0, At, B0); PG8_BAR; PG8_SCHED;
            PG8_LDB(B1, 1, 1); PG8_STAGE(PG8_SB(1, 0), b3, voffB);
            PG8_BAR; PG8_WAIT_L(0); PG8_MMA(0, 1, At, B1); PG8_BAR;
            PG8_LDA(At, 1, 1); PG8_STAGE(PG8_SA(1, 0), a3, voffA);
            PG8_BAR; PG8_WAIT_L(0); PG8_MMA(1, 0, At, B0); PG8_BAR; PG8_SCHED;
            PG8_STAGE(PG8_SB(1, 1), b3 + hstepB, voffB);
            PG8_WAIT_V(6); PG8_BAR; PG8_MMA(1, 1, At, B1); PG8_BAR;
        }
        PG8_STAMP();
        if constexpr (FP8) asm volatile("s_nop 15\n\ts_nop 15" ::: "memory");
        if constexpr (!Epi::AFTER_DRAIN) { E(acc, cur, wr, wc, fr, fq); S.done(cur); }
        PG8_STAMP();
        if (!has_next) break;
#pragma unroll
        for (int a = 0; a < 2; ++a)
#pragma unroll
            for (int b = 0; b < 2; ++b)
#pragma unroll
                for (int m = 0; m < 4; ++m)
#pragma unroll
                    for (int n = 0; n < 2; ++n) acc[a][b][m][n] = (f32x4){0.f, 0.f, 0.f, 0.f};
        cur = nxt; cA = nA; cB = nB; ++ui;
    }
    PG8_WAIT_V(0);
    if (wr == 0) PG8_BAR;
    PG8_BAR;
    if constexpr (Epi::AFTER_DRAIN) { E.fused(acc, cur, wr, wc, fr, fq, lds, wid, lane); S.done(cur); }
    PG8_STAMP();
    if (STAMP && wid == 0) { stamps[lane] = lane < nts ? (((unsigned long long)(unsigned)ts_hi << 32) | (unsigned)ts_lo) : 0ull;
        if (lane == 62) stamps[62] = rt_entry; if (lane == 63) stamps[63] = (unsigned long long)wall_clock64(); }
#undef PG8_STAMP
#undef PG8_SA
#undef PG8_SB
#undef PG8_STAGE
#undef PG8_LDA
#undef PG8_LDB
#undef PG8_MMA
#undef PG8_WAIT_V
#undef PG8_WAIT_L
#undef PG8_BAR
#undef PG8_SCHED
}
}
#define XB_TMO      128
#define XB_XCNT(j)  (256  + 64 * (j))
#define XB_XSUB(j)  (1280 + 64 * (j))
#define XB_XGEN(j)  (2304 + 64 * (j))
#define XB_TOP      3328
#define XB_TOPGEN   3392
#define XCD_BAR_WORDS 3456
#define XB_SPIN_CAP (1u << 18)

__device__ __forceinline__ unsigned xb_ld(unsigned* p)              { return __hip_atomic_load(p, __ATOMIC_RELAXED, __HIP_MEMORY_SCOPE_AGENT); }
__device__ __forceinline__ unsigned xb_add(unsigned* p, unsigned v) { return __hip_atomic_fetch_add(p, v, __ATOMIC_RELAXED, __HIP_MEMORY_SCOPE_AGENT); }
__device__ __forceinline__ unsigned xb_xcc_id() { return (unsigned)__builtin_amdgcn_s_getreg((3 << 11) | 20) & 0xFu; }
#define XB_SPIN(cond, bar) do { unsigned _sp = 0; while (cond) { __builtin_amdgcn_s_sleep(1); \
    if ((++_sp & 255u) == 0u) { if (xb_ld(&(bar)[XB_TMO])) break; if (_sp > XB_SPIN_CAP) { atomicAdd(&(bar)[XB_TMO], 1u); break; } } } } while (0)

struct XcdBarrier {
    unsigned* bar; unsigned x;
    volatile LAS unsigned* st;
};

__device__ __forceinline__ XcdBarrier xcd_barrier_post(unsigned* bar, volatile LAS unsigned* st) {
    XcdBarrier b; b.bar = bar; b.x = xb_xcc_id(); b.st = st;
    if (threadIdx.x == 0) (void)xb_add(&bar[XB_XCNT(b.x)], 1u);
    return b;
}
__device__ __forceinline__ void xcd_barrier_complete(unsigned* bar, unsigned x, unsigned& nloc, unsigned& nx) {
    const unsigned G = gridDim.x * gridDim.y * gridDim.z;
    unsigned sum, cnt, mine, sp = 0u;
    for (;;) {
        sum = 0u; cnt = 0u; mine = 0u;
#pragma unroll
        for (unsigned j = 0; j < 16; ++j) { const unsigned c = xb_ld(&bar[XB_XCNT(j)]); sum += c; cnt += (c > 0u) ? 1u : 0u; mine = (j == x) ? c : mine; }
        if (sum == G) break;
        __builtin_amdgcn_s_sleep(1);
        if ((++sp & 255u) == 0u) { if (xb_ld(&bar[XB_TMO])) break; if (sp > XB_SPIN_CAP) { atomicAdd(&bar[XB_TMO], 1u); break; } }
    }
    nloc = mine > 0u ? mine : 1u; nx = cnt > 0u ? cnt : 1u;
}

__device__ __forceinline__ void xcd_barrier(const XcdBarrier& b) {
    asm volatile("s_waitcnt vmcnt(0)" ::: "memory");
    __syncthreads();
    if (threadIdx.x == 0) {
        unsigned* bar = b.bar;
        __builtin_amdgcn_s_waitcnt(0);
        unsigned nloc = b.st[0], nx = b.st[1];
        if (nloc == 0u) { xcd_barrier_complete(bar, b.x, nloc, nx); b.st[0] = nloc; b.st[1] = nx; }
        const unsigned old = xb_add(&bar[XB_XSUB(b.x)], 1u);
        const unsigned gen = old / nloc;
        if (old + 1u == (gen + 1u) * nloc) {
            __builtin_amdgcn_fence(__ATOMIC_RELEASE, "agent");
            asm volatile("s_waitcnt vmcnt(0)" ::: "memory");
            const unsigned og = xb_add(&bar[XB_TOP], 1u);
            const unsigned tg = og / nx;
            if (og + 1u == (tg + 1u) * nx) xb_add(&bar[XB_TOPGEN], 1u);
            else XB_SPIN(xb_ld(&bar[XB_TOPGEN]) == tg, bar);
            __builtin_amdgcn_fence(__ATOMIC_ACQUIRE, "agent");
            xb_add(&bar[XB_XGEN(b.x)], 1u);
            asm volatile("s_waitcnt vmcnt(0)" ::: "memory");
        } else {
            XB_SPIN(xb_ld(&bar[XB_XGEN(b.x)]) == gen, bar);
            __builtin_amdgcn_fence(__ATOMIC_ACQUIRE, "agent");
            asm volatile("s_waitcnt vmcnt(0)" ::: "memory");
        }
    }
    __syncthreads();
}

struct Args { const float* in[34]; float* out; unsigned char* ws; int ph_lo, ph_hi; };
struct Frame { LAS unsigned char* lds; int tid, lane, wave, G, bid; };

#define MFMA16(a, b, c) __builtin_amdgcn_mfma_f32_16x16x32_bf16((a), (b), (c), 0, 0, 0)

struct TrDesc { const float* src; unsigned char* dst; int ldw, K, fp8, nvalid; float sc; };
__device__ __forceinline__ void tr_load(const TrDesc& d, int lane, v4f (&v)[16]) {
    const unsigned long long sp = (unsigned long long)d.src;
    unsigned long long pa = ((unsigned long long)(unsigned)__builtin_amdgcn_readfirstlane((int)(sp >> 32)) << 32) | (unsigned)__builtin_amdgcn_readfirstlane((int)sp);
    const int ldw = __builtin_amdgcn_readfirstlane(d.ldw);
    if (__builtin_amdgcn_readfirstlane(d.fp8)) {
        const unsigned long long step = (unsigned long long)(8 * ldw) * 4ull; const size_t lo = (size_t)(lane >> 3) * ldw + 4 * (lane & 7);
#pragma unroll
        for (int i = 0; i < 16; ++i) { asm volatile("" : "+s"(pa)); v[i] = *(const v4f*)((const float*)pa + lo); pa += step; }
    } else {
        const unsigned long long step = (unsigned long long)(4 * ldw) * 4ull; const size_t lo = (size_t)(lane >> 4) * ldw + 4 * (lane & 15);
#pragma unroll
        for (int i = 0; i < 16; ++i) { asm volatile("" : "+s"(pa)); v[i] = *(const v4f*)((const float*)pa + lo); pa += step; }
    }
}
__device__ __forceinline__ void tr_store(const TrDesc& d, int lane, const v4f (&v)[16], LAS float* scr) {
    if (d.fp8) {
        { LAS float* w = scr + (lane >> 3) * 33 + 4 * (lane & 7);
#pragma unroll
          for (int i = 0; i < 16; ++i) { w[(8 * i) * 33 + 0] = v[i].x; w[(8 * i) * 33 + 1] = v[i].y; w[(8 * i) * 33 + 2] = v[i].z; w[(8 * i) * 33 + 3] = v[i].w; } }
        LDS_WAIT(); asm volatile("" ::: "memory");
        const int c = lane & 7; const float sc = d.sc;
#pragma unroll
        for (int j = 0; j < 4; ++j) { const int n = (lane >> 3) + 8 * j; const LAS float* s = scr + (16 * c) * 33 + n;
            v4u o; o.x = pk4_fp8(s[0 * 33] * sc, s[1 * 33] * sc, s[2 * 33] * sc, s[3 * 33] * sc); o.y = pk4_fp8(s[4 * 33] * sc, s[5 * 33] * sc, s[6 * 33] * sc, s[7 * 33] * sc);
            o.z = pk4_fp8(s[8 * 33] * sc, s[9 * 33] * sc, s[10 * 33] * sc, s[11 * 33] * sc); o.w = pk4_fp8(s[12 * 33] * sc, s[13 * 33] * sc, s[14 * 33] * sc, s[15 * 33] * sc);
            *(v4u*)(d.dst + (size_t)n * d.K + 16 * c) = o; }
    } else {
        { LAS float* w = scr + (lane >> 4) * 65 + 4 * (lane & 15);
#pragma unroll
          for (int i = 0; i < 16; ++i) { w[(4 * i) * 65 + 0] = v[i].x; w[(4 * i) * 65 + 1] = v[i].y; w[(4 * i) * 65 + 2] = v[i].z; w[(4 * i) * 65 + 3] = v[i].w; } }
        LDS_WAIT(); asm volatile("" ::: "memory");
        const int c = lane & 7;
#pragma unroll
        for (int j = 0; j < 8; ++j) { const int n = (lane >> 3) + 8 * j; const LAS float* s = scr + (8 * c) * 65 + n;
            v4u o; o.x = pk2(s[0 * 65], s[1 * 65]); o.y = pk2(s[2 * 65], s[3 * 65]); o.z = pk2(s[4 * 65], s[5 * 65]); o.w = pk2(s[6 * 65], s[7 * 65]);
            if (n < d.nvalid) *(v4u*)(d.dst + ((size_t)n * d.K + 8 * c) * 2) = o; }
    }
    LDS_WAIT(); asm volatile("" ::: "memory");
}
constexpr int I_E1 = 64 * 128, I_E2 = 64 * 64, I_AB = 64, I_OE = 64 * 64, I_IO = 64 * 112, I_OO = 48 * 64, I_WQ = 64 * 32, I_GL = 16 * 16, I_RG = 128, I_V = 256 * 64;
constexpr int TR_N0 = I_E1 + I_E2 + I_AB, TR_N1 = I_OE + I_WQ + I_GL + I_RG + I_V, TR_N2 = I_IO + I_OO + I_WQ + I_V;
__device__ __forceinline__ TrDesc tr_decode(const Args& a, const int part, int r) {
    unsigned char* ws = a.ws; TrDesc d;
#define TR_MK(W_, ldw_, scol0_, K_, dst_, fp8_, drow0_, r_, nblk64_, sc_, nv_) do { const int r__ = (r_), nbk__ = (fp8_) ? (nblk64_) * 2 : (nblk64_), kb__ = r__ / nbk__, nb__ = r__ % nbk__, kt__ = (fp8_) ? 128 : 64, nt__ = (fp8_) ? 32 : 64; \
        d.src = (W_) + (size_t)(kt__ * kb__) * (ldw_) + (scol0_) + nt__ * nb__; d.ldw = (ldw_); d.K = (K_); d.fp8 = (fp8_); d.sc = (sc_); d.nvalid = (nv_); \
        d.dst = (unsigned char*)(dst_) + ((size_t)((drow0_) + nt__ * nb__) * (K_) + kt__ * kb__) * ((fp8_) ? 1 : 2); return d; } while (0)
    if (part == 0) {
        if (r < I_E1) TR_MK(a.in[1], EVEN_IN_SRC, 0, DM, ws + WS_WINE, FP8_INE, 0, r, 128, WIN8_SCALE, 64); r -= I_E1;
        if (r < I_E2) TR_MK(a.in[1], EVEN_IN_SRC, 8224, DM, ws + WS_WINE, FP8_INE, 8192, r, 64, WIN8_SCALE, 64); r -= I_E2;
        TR_MK(a.in[1], EVEN_IN_SRC, 8192, DM, ws + WS_WAB, 0, 0, r, 1, 1.f, 32);
    } else if (part == 1) {
        if (r < I_OE) TR_MK(a.in[13], DM, 0, DM, ws + WS_WOUTE, FP8_OUT, 0, r, 64, WOUT8_SCALE, 64); r -= I_OE;
        if (r < I_WQ) TR_MK(a.in[28], PQ, 0, DM, ws + WS_WQ0, FP8_WQ, 0, r, 32, WIN8_SCALE, 64); r -= I_WQ;
        if (r < I_GL) TR_MK(a.in[23], S5W, 0, S5W, ws + WS_GLU, 0, 0, r, 16, 1.f, 64); r -= I_GL;
        if (r < I_RG) { const int n = r >> 3, which = (r >> 2) & 1; TR_MK((which ? a.in[10] : a.in[8]) + (size_t)n * RGB * RGB, RGB, 0, RGB, ws + WS_RGW + (size_t)n * 256 * RGB * 2, 0, which * 128, r & 3, 2, 1.f, 64); } r -= I_RG;
        TR_MK(a.in[31], DM, 0, PE, ws + WS_VT8_0, 1, 0, r, 64, V8_SCALE, 64);
    } else {
        if (r < I_IO) TR_MK(a.in[14], ODD_IN, 0, DM, ws + WS_WINO, FP8_INO, 0, r, 112, WIN8_SCALE, 64); r -= I_IO;
        if (r < I_OO) TR_MK(a.in[25], DM, 0, ODD_MIX, ws + WS_WOUTO, FP8_OUT, 0, r, 64, WOUT8_SCALE, 64); r -= I_OO;
        if (r < I_WQ) TR_MK(a.in[28] + (size_t)DM * PQ, PQ, 0, DM, ws + WS_WQ1, FP8_WQ, 0, r, 32, WIN8_SCALE, 64); r -= I_WQ;
        TR_MK(a.in[31] + (size_t)PE * DM, DM, 0, PE, ws + WS_VT8_1, 1, 0, r, 64, V8_SCALE, 64);
    }
#undef TR_MK
}
__device__ __forceinline__ void p0_prologue(const Args& a, Frame& F, const int part) {
    unsigned char* ws = a.ws;
    LAS float* scr = (LAS float*)(F.lds + F.wave * 16896);
    const int gw = F.bid * NWAVES + F.wave, NGW = F.G * NWAVES;
#ifndef REP_TR
#define REP_TR 1
#endif
#ifndef REP_ST
#define REP_ST 1
#endif
    _Pragma("unroll 1") for (int rp_ = 0; rp_ < REP_TR; ++rp_)
    {   const int it_hi = part == 0 ? TR_N0 : (part == 1 ? TR_N1 : TR_N2);
        v4f v[16], nv[16]; TrDesc d = tr_decode(a, part, gw < it_hi ? gw : 0), nd = d;
        if (gw < it_hi) tr_load(d, F.lane, v);
        for (int it = gw; it < it_hi; it += NGW) {
            const bool more = it + NGW < it_hi;
            if (more) { nd = tr_decode(a, part, it + NGW); tr_load(nd, F.lane, nv); }
            tr_store(d, F.lane, v, scr);
            d = nd;
#pragma unroll
            for (int i = 0; i < 16; ++i) v[i] = nv[i];
        }
    }
    const size_t gtid = (size_t)F.bid * NTHR + F.tid, gsize = (size_t)F.G * NTHR;
    _Pragma("unroll 1") for (int rp_ = 0; rp_ < REP_ST; ++rp_) {
    if (part == 0)
    {
        const float* xs = a.in[0]; bf16* xb = (bf16*)(ws + WS_XB0); unsigned char* x8 = ws + WS_X8_0;
        const size_t n16 = (size_t)NTOK * DM / 16;
        for (size_t i = gtid; i < n16; i += 2 * gsize) {
            v4f f[2][4];
#pragma unroll
            for (int u = 0; u < 2; ++u) { const size_t ii = i + u * gsize; if (ii < n16) {
#pragma unroll
                for (int j = 0; j < 4; ++j) f[u][j] = *(const v4f*)(xs + 16 * ii + 4 * j); } }
#pragma unroll
            for (int u = 0; u < 2; ++u) { const size_t ii = i + u * gsize; if (ii < n16) {
                v4u o0, o1; o0.x = pk2(f[u][0].x, f[u][0].y); o0.y = pk2(f[u][0].z, f[u][0].w); o0.z = pk2(f[u][1].x, f[u][1].y); o0.w = pk2(f[u][1].z, f[u][1].w);
                o1.x = pk2(f[u][2].x, f[u][2].y); o1.y = pk2(f[u][2].z, f[u][2].w); o1.z = pk2(f[u][3].x, f[u][3].y); o1.w = pk2(f[u][3].z, f[u][3].w);
                *(v4u*)(xb + 16 * ii) = o0; *(v4u*)(xb + 16 * ii + 8) = o1;
                if (FP8_INE) { v4u o; o.x = pk4_fp8(f[u][0].x, f[u][0].y, f[u][0].z, f[u][0].w); o.y = pk4_fp8(f[u][1].x, f[u][1].y, f[u][1].z, f[u][1].w); o.z = pk4_fp8(f[u][2].x, f[u][2].y, f[u][2].z, f[u][2].w); o.w = pk4_fp8(f[u][3].x, f[u][3].y, f[u][3].z, f[u][3].w);
                    *(v4u*)(x8 + 16 * ii) = o; } } }
        }
    }
    if (part == 1)
    {
        const float* ks = a.in[29]; bf16* kh = (bf16*)(ws + WS_KH); bf16* kl = (bf16*)(ws + WS_KL);
        for (size_t i = gtid; i < (size_t)2 * PH * 2 * PNK * PHALF / 8; i += gsize) { const v4f x = *(const v4f*)(ks + 8 * i), y = *(const v4f*)(ks + 8 * i + 4);
            v4u h; h.x = pk2(x.x, x.y); h.y = pk2(x.z, x.w); h.z = pk2(y.x, y.y); h.w = pk2(y.z, y.w);
            v4u l; l.x = pk2(x.x - bflo(h.x), x.y - bfhi(h.x)); l.y = pk2(x.z - bflo(h.y), x.w - bfhi(h.y)); l.z = pk2(y.x - bflo(h.z), y.y - bfhi(h.z)); l.w = pk2(y.z - bflo(h.w), y.w - bfhi(h.w));
            const size_t blk = i >> 11; const int n = (int)(i >> 4) & 127, d8 = (int)i & 15; const size_t j = (blk << 11) + (size_t)((((n >> 4) * 4 + (d8 >> 2)) * 64) + (d8 & 3) * 16 + (n & 15));
            *(v4u*)(kh + 8 * j) = h; *(v4u*)(kl + 8 * j) = l; }
    }
    if (part >= 1)
    {
        const float* us = a.in[30] + (size_t)(part - 1) * PE * DM; unsigned char* u8 = ws + (part == 1 ? WS_U8_0 : WS_U8_1);
        const size_t n16 = (size_t)PE * DM / 16; const float sc = U8_SCALE;
        for (size_t i = gtid; i < n16; i += 4 * gsize) {
            v4f f[4][4];
#pragma unroll
            for (int u = 0; u < 4; ++u) { const size_t ii = i + u * gsize; if (ii < n16) {
#pragma unroll
                for (int j = 0; j < 4; ++j) f[u][j] = *(const v4f*)(us + 16 * ii + 4 * j); } }
#pragma unroll
            for (int u = 0; u < 4; ++u) { const size_t ii = i + u * gsize; if (ii < n16) {
                v4u o; o.x = pk4_fp8(f[u][0].x * sc, f[u][0].y * sc, f[u][0].z * sc, f[u][0].w * sc); o.y = pk4_fp8(f[u][1].x * sc, f[u][1].y * sc, f[u][1].z * sc, f[u][1].w * sc);
                o.z = pk4_fp8(f[u][2].x * sc, f[u][2].y * sc, f[u][2].z * sc, f[u][2].w * sc); o.w = pk4_fp8(f[u][3].x * sc, f[u][3].y * sc, f[u][3].z * sc, f[u][3].w * sc);
                *(v4u*)(u8 + 16 * ii) = o; } }
        }
    }
    }
}

__device__ __forceinline__ void gdn_prep_phase(const Args& a, Frame& F) {
    const bf16* proj = (const bf16*)(a.ws + WS_HB);
    bf16* qkvn = (bf16*)(a.ws + WS_WB);
    const float* cw = a.in[2];
    const int gw = F.bid * NWAVES + F.wave, NGW = F.G * NWAVES;
    for (int it = gw; it < 12 * 512; it += NGW) {
        const int tg = it / 12, j = it % 12, c0 = j * 512 + F.lane * 8, t0 = tg * 16;
        float w[4][8];
#pragma unroll
        for (int k = 0; k < 4; ++k) { const v4f w0 = *(const v4f*)(cw + k * 6144 + c0), w1 = *(const v4f*)(cw + k * 6144 + c0 + 4);
            w[k][0] = w0.x; w[k][1] = w0.y; w[k][2] = w0.z; w[k][3] = w0.w; w[k][4] = w1.x; w[k][5] = w1.y; w[k][6] = w1.z; w[k][7] = w1.w; }
        float xm3[8], xm2[8], xm1[8], xc[8];
        if ((t0 & (SEQ - 1)) == 0) {
#pragma unroll
            for (int e = 0; e < 8; ++e) { xm3[e] = 0.f; xm2[e] = 0.f; xm1[e] = 0.f; }
        } else {
            unpack8(*(const v4u*)(proj + (size_t)(t0 - 3) * EVEN_IN + c0), xm3);
            unpack8(*(const v4u*)(proj + (size_t)(t0 - 2) * EVEN_IN + c0), xm2);
            unpack8(*(const v4u*)(proj + (size_t)(t0 - 1) * EVEN_IN + c0), xm1);
        }
        bf16* dst = qkvn + (size_t)(j >> 2) * NTOK * GW + (size_t)(j & 3) * 512 + F.lane * 8;
        v4u rw[16];
#pragma unroll
        for (int i = 0; i < 16; ++i) rw[i] = *(const v4u*)(proj + (size_t)(t0 + i) * EVEN_IN + c0);
#pragma unroll
        for (int i = 0; i < 16; ++i) {
            const int t = t0 + i;
            unpack8(rw[i], xc);
            float y[8]; float ss = 0.f;
#pragma unroll
            for (int e = 0; e < 8; ++e) { float v = w[0][e] * xm3[e] + w[1][e] * xm2[e] + w[2][e] * xm1[e] + w[3][e] * xc[e]; v = siluf_(v); y[e] = v; ss += v * v; }
            if (j < 8) {
                ss = row16_sum(ss);
                float r = rsqrtf(ss + RMS_EPS); if (j < 4) r *= 0.08838834764831845f;
#pragma unroll
                for (int e = 0; e < 8; ++e) y[e] *= r;
            }
            *(v4u*)(dst + (size_t)t * GW) = pack8(y);
#pragma unroll
            for (int e = 0; e < 8; ++e) { xm3[e] = xm2[e]; xm2[e] = xm1[e]; xm1[e] = xc[e]; }
        }
    }
}

__device__ __forceinline__ void ab_proj_phase(const Args& a, Frame& F) {
    const bf16* xb = (const bf16*)(a.ws + WS_XB0);
    const bf16* wab = (const bf16*)(a.ws + WS_WAB);
    float* beta = (float*)(a.ws + WS_BETA); float* eg = (float*)(a.ws + WS_EG);
    LAS float* red = (LAS float*)F.lds;
    const int m = F.lane & 15, q = F.lane >> 4;
    for (int blk = F.bid; blk < NTOK / 32; blk += F.G) {
        const int r0 = blk * 32;
        v4f acc[2][2];
#pragma unroll
        for (int i = 0; i < 2; ++i)
#pragma unroll
            for (int j = 0; j < 2; ++j) acc[i][j] = (v4f){0.f, 0.f, 0.f, 0.f};
        for (int ks = 0; ks < 16; ++ks) {
            const int k = F.wave * 512 + ks * 32 + 8 * q;
            v8s af[2], bfr[2];
#pragma unroll
            for (int i = 0; i < 2; ++i) { af[i] = *(const v8s*)(xb + (size_t)(r0 + 16 * i + m) * DM + k); bfr[i] = *(const v8s*)(wab + (size_t)(16 * i + m) * DM + k); }
#pragma unroll
            for (int i = 0; i < 2; ++i)
#pragma unroll
                for (int j = 0; j < 2; ++j) acc[i][j] = MFMA16(bfr[j], af[i], acc[i][j]);
        }
#pragma unroll
        for (int i = 0; i < 2; ++i)
#pragma unroll
            for (int j = 0; j < 2; ++j) *(LAS v4f*)(red + ((F.wave * 4 + i * 2 + j) * 64 + F.lane) * 4) = acc[i][j];
        __syncthreads();
        for (int o = F.tid; o < 1024; o += NTHR) {
            float s = 0.f;
#pragma unroll
            for (int w = 0; w < 8; ++w) s += red[w * 1024 + o];
            const int tile = o >> 8, ln = (o >> 2) & 63, r = o & 3, i = tile >> 1, j = tile & 1;
            const int row = r0 + 16 * i + (ln & 15), col = 16 * j + 4 * (ln >> 4) + r;
            if (col < 16) { const float g = -__expf(a.in[3][col]) * softplusf_(s + a.in[4][col]); eg[(size_t)row * 16 + col] = g; }
            else beta[(size_t)row * 16 + (col - 16)] = sigmoidf_(s);
        }
        __syncthreads();
    }
}

__device__ __forceinline__ void rg_gates_phase(const Args& a, Frame& F) {
    const bf16* proj = (const bf16*)(a.ws + WS_HB);
    const bf16* rgw = (const bf16*)(a.ws + WS_RGW);
    unsigned* ABout = (unsigned*)(a.ws + WS_A);
    const float* convw = a.in[6]; const float* convb = a.in[7]; const float* ba = a.in[9]; const float* bx = a.in[11]; const float* lam = a.in[12];
    LAS float* xr = (LAS float*)F.lds;
    LAS bf16* Bw = (LAS bf16*)(F.lds + 33792);
    LAS float* cw = (LAS float*)(F.lds + 33792 + 69632);
    const int rt = F.wave & 3, ch = F.wave >> 2, m = F.lane & 15, q = F.lane >> 4;
    const int tl = F.tid >> 3, cg = (F.tid & 7) * 16;
    int cur_n = -1;
    float kba[4][4], kbx[4][4], ksp[4][4];
    v4u raw[4][2];
#define RG_LOAD(u_) do { const int t_ = ((u_) >> 4) * 64 + tl, ts_ = t_ & (SEQ - 1), n_ = (u_) & 15; \
        _Pragma("unroll") for (int k = 0; k < 4; ++k) { const bool ok_ = ts_ + k - 3 >= 0; const bf16* p_ = proj + (size_t)(t_ + (ok_ ? k - 3 : 0)) * EVEN_IN + PE_RGIN + n_ * 128 + cg; \
            raw[k][0] = *(const v4u*)p_; raw[k][1] = *(const v4u*)(p_ + 8); if (!ok_) { raw[k][0] = (v4u){0u, 0u, 0u, 0u}; raw[k][1] = (v4u){0u, 0u, 0u, 0u}; } } } while (0)
    if (F.bid < 2048) RG_LOAD(F.bid);
    for (int u = F.bid; u < 2048; u += F.G) {
        const int tt = u >> 4, n = u & 15, t0 = tt * 64;
        __syncthreads();
        if (n != cur_n) {
            cur_n = n;
#pragma unroll
            for (int i = 0; i < 8; ++i) { const int f = F.tid + NTHR * i, row = f >> 4, c8 = (f & 15) * 8; *(LAS v4u*)(Bw + row * 136 + c8) = *(const v4u*)(rgw + ((size_t)n * 256 + row) * RGB + c8); }
            for (int o = F.tid; o < 640; o += NTHR) { const int k = o >> 7, c = o & 127; cw[o] = (k < 4) ? convw[k * RGW + n * 128 + c] : convb[n * 128 + c]; }
#pragma unroll
            for (int jj = 0; jj < 4; ++jj) { const int C = n * 128 + 16 * (4 * ch + jj) + 4 * q;
                const v4f b0 = *(const v4f*)(ba + C), b1 = *(const v4f*)(bx + C), lm = *(const v4f*)(lam + C);
#pragma unroll
                for (int r = 0; r < 4; ++r) { kba[jj][r] = b0[r]; kbx[jj][r] = b1[r]; ksp[jj][r] = 8.0f * softplusf_(-lm[r]); } }
            __syncthreads();
        }
        {
#pragma unroll
            for (int hh = 0; hh < 2; ++hh) {
                float acc[8];
                { const v4f b0 = *(const LAS v4f*)(cw + 512 + cg + hh * 8), b1 = *(const LAS v4f*)(cw + 512 + cg + hh * 8 + 4); acc[0] = b0.x; acc[1] = b0.y; acc[2] = b0.z; acc[3] = b0.w; acc[4] = b1.x; acc[5] = b1.y; acc[6] = b1.z; acc[7] = b1.w; }
#pragma unroll
                for (int k = 0; k < 4; ++k) { float x[8]; unpack8(raw[k][hh], x);
                    const v4f w0 = *(const LAS v4f*)(cw + k * 128 + cg + hh * 8), w1 = *(const LAS v4f*)(cw + k * 128 + cg + hh * 8 + 4);
                    acc[0] += w0.x * x[0]; acc[1] += w0.y * x[1]; acc[2] += w0.z * x[2]; acc[3] += w0.w * x[3]; acc[4] += w1.x * x[4]; acc[5] += w1.y * x[5]; acc[6] += w1.z * x[6]; acc[7] += w1.w * x[7]; }
                *(LAS v4f*)(xr + tl * 132 + cg + hh * 8) = (v4f){acc[0], acc[1], acc[2], acc[3]};
                *(LAS v4f*)(xr + tl * 132 + cg + hh * 8 + 4) = (v4f){acc[4], acc[5], acc[6], acc[7]};
            }
        }
        LDS_BARRIER();
        if (u + F.G < 2048) RG_LOAD(u + F.G);
        {   v8s Af[4];
#pragma unroll
            for (int ks = 0; ks < 4; ++ks) { const v4f x0 = *(const LAS v4f*)(xr + (16 * rt + m) * 132 + 32 * ks + 8 * q), x1 = *(const LAS v4f*)(xr + (16 * rt + m) * 132 + 32 * ks + 8 * q + 4);
                v4u p; p.x = pk2(x0.x, x0.y); p.y = pk2(x0.z, x0.w); p.z = pk2(x1.x, x1.y); p.w = pk2(x1.z, x1.w); Af[ks] = __builtin_bit_cast(v8s, p); }
#pragma unroll
            for (int jj = 0; jj < 4; ++jj) {
                const int jt = 4 * ch + jj;
                v4f accr = (v4f){0.f, 0.f, 0.f, 0.f}, acci = (v4f){0.f, 0.f, 0.f, 0.f};
#pragma unroll
                for (int ks = 0; ks < 4; ++ks) {
                    const v8s Br = *(const LAS v8s*)(Bw + (16 * jt + m) * 136 + 32 * ks + 8 * q);
                    const v8s Bi = *(const LAS v8s*)(Bw + (128 + 16 * jt + m) * 136 + 32 * ks + 8 * q);
                    accr = MFMA16(Br, Af[ks], accr); acci = MFMA16(Bi, Af[ks], acci);
                }
                const int cc = 16 * jt + 4 * q, C = n * 128 + cc, row = 16 * rt + m;
                const v4f xv = *(const LAS v4f*)(xr + row * 132 + cc);
                v4u pk;
#pragma unroll
                for (int r = 0; r < 4; ++r) {
                    const float rr = sigmoidf_(accr[r] + kba[jj][r]), ii = sigmoidf_(acci[r] + kbx[jj][r]);
                    const float la = -rr * ksp[jj][r], x2 = 2.0f * la;
                    const float om = (x2 > -0.125f) ? -x2 * (1.0f + x2 * (0.5f + x2 * (0.16666667f + x2 * (0.041666668f + x2 * 0.0083333333f)))) : 1.0f - __expf(x2);
                    pk[r] = pk2(la, __builtin_amdgcn_sqrtf(fmaxf(om, 0.f)) * (ii * xv[r]));
                }
                *(v4u*)(ABout + (size_t)(t0 + row) * RGW + C) = pk;
            }
        }
    }
#undef RG_LOAD
}

constexpr size_t GDN_O = WS_WB + 96 * MiB, GDN_UT = WS_WB + 160 * MiB, GDN_W = WS_RES, GDN_QD = WS_RES + 32 * MiB, GDN_KT = WS_RES + 64 * MiB, GDN_AQK = WS_RES + 96 * MiB, GDN_GL = WS_RES + 112 * MiB;

__device__ __forceinline__ void gdn_chunk_prep_phase(const Args& a, Frame& F) {
    const bf16* qb = (const bf16*)(a.ws + WS_WB); const bf16* kb = qb + (size_t)NTOK * GW; const bf16* vb = kb + (size_t)NTOK * GW;
    const float* G = (const float*)(a.ws + WS_EG); const float* beta = (const float*)(a.ws + WS_BETA);
    float* UT = (float*)(a.ws + GDN_UT); bf16* Wg = (bf16*)(a.ws + GDN_W); bf16* QD = (bf16*)(a.ws + GDN_QD); bf16* KT = (bf16*)(a.ws + GDN_KT); bf16* AQK = (bf16*)(a.ws + GDN_AQK); float* GL = (float*)(a.ws + GDN_GL);
    const int half = F.wave >> 2, wv = F.wave & 3, ht = F.tid & 255, m = F.lane & 15, q = F.lane >> 4;
    constexpr int HALF_BYTES = 3 * 17408 + 17408 + 1024;
    LAS unsigned char* hb = F.lds + half * HALF_BYTES;
    LAS bf16* Kt = (LAS bf16*)hb;
    LAS bf16* Qt = Kt + 64 * 136;
    LAS bf16* Vt = Qt + 64 * 136;
    LAS float* Mm = (LAS float*)(hb + 3 * 17408);
    LAS float* gcs = (LAS float*)(hb + 4 * 17408);
    v4u pK[4], pQ[4], pV[4]; float pg = 0.f, pbt = 0.f;
    const int lr_ = ht >> 4, lsg_ = (ht & 15) * 8;
#define CA_PREFETCH(it_) do { const int c_ = (it_) & 31, h_ = ((it_) >> 5) & 15, b_ = (it_) >> 9; const size_t r0_ = (size_t)b_ * SEQ + (size_t)c_ * 64; const size_t go_ = (r0_ + lr_) * GW + h_ * HD + lsg_; \
        _Pragma("unroll") for (int i = 0; i < 4; ++i) { pK[i] = *(const v4u*)(kb + go_ + (size_t)16 * i * GW); pQ[i] = *(const v4u*)(qb + go_ + (size_t)16 * i * GW); pV[i] = *(const v4u*)(vb + go_ + (size_t)16 * i * GW); } \
        if (wv == 0) { pg = G[(r0_ + F.lane) * 16 + h_]; pbt = beta[(r0_ + F.lane) * 16 + h_]; } } while (0)
    if (F.bid * 2 < 2048) CA_PREFETCH(F.bid * 2 + half);
    for (int it0 = F.bid * 2; it0 < 2048; it0 += F.G * 2) {
        const int it = it0 + half, sl = (it & 31) * 64 + (it >> 5);
        LDS_BARRIER();
        {
#pragma unroll
            for (int i = 0; i < 4; ++i) { *(LAS v4u*)(Kt + (16 * i + lr_) * 136 + lsg_) = pK[i]; *(LAS v4u*)(Qt + (16 * i + lr_) * 136 + lsg_) = pQ[i]; *(LAS v4u*)(Vt + (16 * i + lr_) * 136 + lsg_) = pV[i]; }
            if (wv == 0) {
                float gv = pg;
#pragma unroll
                for (int o = 1; o < 64; o <<= 1) { const float t = __shfl_up(gv, o); if (F.lane >= o) gv += t; }
                gcs[F.lane] = gv; gcs[64 + F.lane] = pbt; gcs[128 + F.lane] = __expf(gv);
                if (F.lane == 63) GL[sl] = __expf(gv);
            }
        }
        LDS_BARRIER();
        {
            const int i = 16 * wv + m; const float gci = gcs[i], bi = gcs[64 + i];
            v8s Ki[4], Qi[4];
#pragma unroll
            for (int ks = 0; ks < 4; ++ks) { Ki[ks] = *(const LAS v8s*)(Kt + i * 136 + 32 * ks + 8 * q); Qi[ks] = *(const LAS v8s*)(Qt + i * 136 + 32 * ks + 8 * q); }
            for (int jt = 0; jt < 4; ++jt) {
                v4f mk = (v4f){0.f, 0.f, 0.f, 0.f}, ak = (v4f){0.f, 0.f, 0.f, 0.f};
                if (jt <= wv) {
                    v4f kk = (v4f){0.f, 0.f, 0.f, 0.f}, qk = (v4f){0.f, 0.f, 0.f, 0.f};
#pragma unroll
                    for (int ks = 0; ks < 4; ++ks) { const v8s Kj = *(const LAS v8s*)(Kt + (16 * jt + m) * 136 + 32 * ks + 8 * q); kk = MFMA16(Kj, Ki[ks], kk); qk = MFMA16(Kj, Qi[ks], qk); }
                    const v4f gj = *(const LAS v4f*)(gcs + 16 * jt + 4 * q);
#pragma unroll
                    for (int r = 0; r < 4; ++r) { const int j = 16 * jt + 4 * q + r; const float gm = __expf(gci - gj[r]);
                        mk[r] = (j < i) ? bi * kk[r] * gm : 0.f; ak[r] = (j <= i) ? qk[r] * gm : 0.f; }
                }
                *(LAS v4f*)(Mm + i * 68 + 16 * jt + 4 * q) = mk;
                v2u w; w.x = pk2(ak[0], ak[1]); w.y = pk2(ak[2], ak[3]);
                *(v2u*)(AQK + (size_t)sl * 4096 + (((wv * 2 + (jt >> 1)) * 64 + ((jt & 1) * 2 + (q >> 1)) * 16 + m) * 8 + 4 * (q & 1))) = w;
            }
        }
        {
            const int r = ht >> 2, sg = (ht & 3) * 32; const float eq = gcs[128 + r];
#pragma unroll
            for (int i = 0; i < 4; ++i) { float x[8]; unpack8(*(const LAS v4u*)(Qt + r * 136 + sg + 8 * i), x);
#pragma unroll
                for (int e = 0; e < 8; ++e) x[e] *= eq;
                *(v4u*)(QD + (size_t)sl * 8192 + ((((r >> 4) * 4 + (ht & 3)) * 64 + i * 16 + (r & 15)) * 8)) = pack8(x); }
            const int d = ht >> 1, tb = (ht & 1) * 32; const float gl = gcs[63];
#pragma unroll
            for (int i = 0; i < 4; ++i) { float x[8];
#pragma unroll
                for (int e = 0; e < 8; ++e) { const int t = tb + 8 * i + e; const v4f g4 = *(const LAS v4f*)(gcs + tb + 8 * i + (e & 4)); x[e] = bf2f(Kt[t * 136 + d]) * __expf(gl - g4[e & 3]); }
                *(v4u*)(KT + (size_t)sl * 8192 + ((((d >> 4) * 2 + (ht & 1)) * 64 + i * 16 + (d & 15)) * 8)) = pack8(x); }
        }
        if (it0 + F.G * 2 < 2048) CA_PREFETCH(it0 + F.G * 2 + half);
        LDS_BARRIER();
        LAS bf16* T1t = Qt;
        LAS bf16* T2t = (LAS bf16*)Mm;
        if (wv == 0) {
            const int cc = F.lane; int ccv = cc;
            float X[64];
#ifndef REP_SUB
#define REP_SUB 1
#endif
#pragma unroll 1
            for (int rs_ = 0; rs_ < REP_SUB; ++rs_)
#pragma unroll
            for (int i = 0; i < 64; ++i) {
                float acc0 = 0.f, acc1 = 0.f;
#pragma unroll
                for (int j4 = 0; j4 < (i + 3) / 4; ++j4) { const v4f mv = *(const LAS v4f*)(Mm + i * 68 + 4 * j4);
                    if (4 * j4 + 0 < i) acc0 += mv.x * X[4 * j4 + 0];
                    if (4 * j4 + 1 < i) acc1 += mv.y * X[4 * j4 + 1];
                    if (4 * j4 + 2 < i) acc0 += mv.z * X[4 * j4 + 2];
                    if (4 * j4 + 3 < i) acc1 += mv.w * X[4 * j4 + 3]; }
                X[i] = ((i == ccv) ? 1.f : 0.f) - (acc0 + acc1);
                asm volatile("" : "+v"(X[i]), "+v"(ccv) :: "memory");
            }
            const float s1 = gcs[64 + cc], s2 = s1 * gcs[128 + cc];
            LDS_WAIT(); asm volatile("" ::: "memory");
#pragma unroll
            for (int i = 0; i < 64; ++i) { T1t[i * 72 + cc] = (bf16)(pk2(X[i] * s1, 0.f) & 0xffffu); T2t[i * 72 + cc] = (bf16)(pk2(X[i] * s2, 0.f) & 0xffffu); }
        }
        LDS_BARRIER();
        {
#pragma unroll
            for (int dd = 0; dd < 2; ++dd) { const int dt = 2 * wv + dd;
                v8s Vf[2], Kf[2];
#pragma unroll
                for (int ks = 0; ks < 2; ++ks) { const LAS bf16* vp = Vt + (32 * ks + 8 * q) * 136 + 16 * dt + m; const LAS bf16* kp = Kt + (32 * ks + 8 * q) * 136 + 16 * dt + m;
                    v4u vv, kk;
                    vv.x = (unsigned)vp[0 * 136] | ((unsigned)vp[1 * 136] << 16); vv.y = (unsigned)vp[2 * 136] | ((unsigned)vp[3 * 136] << 16); vv.z = (unsigned)vp[4 * 136] | ((unsigned)vp[5 * 136] << 16); vv.w = (unsigned)vp[6 * 136] | ((unsigned)vp[7 * 136] << 16);
                    kk.x = (unsigned)kp[0 * 136] | ((unsigned)kp[1 * 136] << 16); kk.y = (unsigned)kp[2 * 136] | ((unsigned)kp[3 * 136] << 16); kk.z = (unsigned)kp[4 * 136] | ((unsigned)kp[5 * 136] << 16); kk.w = (unsigned)kp[6 * 136] | ((unsigned)kp[7 * 136] << 16);
                    Vf[ks] = __builtin_bit_cast(v8s, vv); Kf[ks] = __builtin_bit_cast(v8s, kk); }
#pragma unroll
                for (int ti = 0; ti < 4; ++ti) {
                    v4f du = (v4f){0.f, 0.f, 0.f, 0.f}, dw = (v4f){0.f, 0.f, 0.f, 0.f};
#pragma unroll
                    for (int ks = 0; ks < 2; ++ks) { const v8s t1 = *(const LAS v8s*)(T1t + (16 * ti + m) * 72 + 32 * ks + 8 * q), t2 = *(const LAS v8s*)(T2t + (16 * ti + m) * 72 + 32 * ks + 8 * q);
                        du = MFMA16(t1, Vf[ks], du); dw = MFMA16(Kf[ks], t2, dw); }
                    *(v4f*)(UT + (size_t)sl * 8192 + ((dt * 4 + ti) * 64 + F.lane) * 4) = du;
                    v2u ww; ww.x = pk2(dw[0], dw[1]); ww.y = pk2(dw[2], dw[3]);
                    *(v2u*)(Wg + (size_t)sl * 8192 + (((ti * 4 + (dt >> 1)) * 64 + ((dt & 1) * 2 + (q >> 1)) * 16 + m) * 8 + 4 * (q & 1))) = ww;
                }
            }
        }
    }
#undef CA_PREFETCH
}

__device__ __forceinline__ void gdn_chunk_rec_phase(const Args& a, Frame& F) {
    const float* UT = (const float*)(a.ws + GDN_UT); const bf16* Wg = (const bf16*)(a.ws + GDN_W); const bf16* QD = (const bf16*)(a.ws + GDN_QD); const bf16* KT = (const bf16*)(a.ws + GDN_KT);
    const bf16* AQK = (const bf16*)(a.ws + GDN_AQK); const float* GL = (const float*)(a.ws + GDN_GL);
    float* og = (float*)(a.ws + GDN_O);
    LAS bf16* ST = (LAS bf16*)F.lds;
    LAS bf16* VNT = ST + 2 * 64 * 136;
    const int m = F.lane & 15, q = F.lane >> 4, tt = F.wave >> 1, nta = F.wave & 1;
    for (int item = F.bid; item < 128; item += F.G) {
        const int bh = (item & 7) * 8 + (item >> 4), cg = (item >> 3) & 1, b = bh >> 4, h = bh & 15;
        const size_t row0 = (size_t)b * SEQ;
        __syncthreads();
        for (int o = F.tid; o < 64 * 136 / 2; o += NTHR) ((LAS unsigned*)ST)[o] = 0u;
        v4f S[4] = {(v4f){0.f, 0.f, 0.f, 0.f}, (v4f){0.f, 0.f, 0.f, 0.f}, (v4f){0.f, 0.f, 0.f, 0.f}, (v4f){0.f, 0.f, 0.f, 0.f}};
        v8s Wf[2][4], QDf[2][4], AQf[2][2], KTf[2][2]; v4f UTv[2][2]; float egl[2];
#define GDN_PFA(ci, s_) do { const size_t it_ = (size_t)(ci) * 64 + bh; \
            _Pragma("unroll") for (int ks = 0; ks < 4; ++ks) Wf[s_][ks] = *(const v8s*)(Wg + it_ * 8192 + ((tt * 4 + ks) * 64 + F.lane) * 8); \
            _Pragma("unroll") for (int j = 0; j < 2; ++j) UTv[s_][j] = *(const v4f*)(UT + it_ * 8192 + (((cg * 4 + nta * 2 + j) * 4 + tt) * 64 + F.lane) * 4); } while (0)
#define GDN_PFQ(ci, s_) do { const size_t it_ = (size_t)(ci) * 64 + bh; \
            _Pragma("unroll") for (int ks = 0; ks < 4; ++ks) QDf[s_][ks] = *(const v8s*)(QD + it_ * 8192 + ((tt * 4 + ks) * 64 + F.lane) * 8); \
            _Pragma("unroll") for (int ks = 0; ks < 2; ++ks) AQf[s_][ks] = *(const v8s*)(AQK + it_ * 4096 + ((tt * 2 + ks) * 64 + F.lane) * 8); } while (0)
#define GDN_PFK(ci, s_) do { const size_t it_ = (size_t)(ci) * 64 + bh; \
            _Pragma("unroll") for (int ks = 0; ks < 2; ++ks) KTf[s_][ks] = *(const v8s*)(KT + it_ * 8192 + ((F.wave * 2 + ks) * 64 + F.lane) * 8); \
            egl[s_] = GL[it_]; } while (0)
#define GDN_STEP(c, s_) do { \
            const LAS bf16* STc = ST + ((c) & 1) * 64 * 136; LAS bf16* STn = ST + (((c) + 1) & 1) * 64 * 136; \
            v8s STf[2][4]; \
            _Pragma("unroll") for (int j = 0; j < 2; ++j) _Pragma("unroll") for (int ks = 0; ks < 4; ++ks) STf[j][ks] = *(const LAS v8s*)(STc + (32 * nta + 16 * j + m) * 136 + 32 * ks + 8 * q); \
            _Pragma("unroll") for (int j = 0; j < 2; ++j) { v4f P = (v4f){0.f, 0.f, 0.f, 0.f}; \
                _Pragma("unroll") for (int ks = 0; ks < 4; ++ks) P = MFMA16(Wf[s_][ks], STf[j][ks], P); \
                const v4f vn = UTv[s_][j] - P; v2u w; w.x = pk2(vn[0], vn[1]); w.y = pk2(vn[2], vn[3]); *(LAS v2u*)(VNT + (32 * nta + 16 * j + m) * 72 + 16 * tt + 4 * q) = w; } \
            GDN_PFA(((c) + 2 < 32 ? (c) + 2 : 31), s_); \
            LDS_BARRIER(); \
            _Pragma("unroll") for (int j = 0; j < 2; ++j) { v4f O = (v4f){0.f, 0.f, 0.f, 0.f}; \
                _Pragma("unroll") for (int ks = 0; ks < 4; ++ks) O = MFMA16(STf[j][ks], QDf[s_][ks], O); \
                _Pragma("unroll") for (int ks = 0; ks < 2; ++ks) { const v8s vf = *(const LAS v8s*)(VNT + (32 * nta + 16 * j + m) * 72 + 32 * ks + 8 * q); O = MFMA16(vf, AQf[s_][ks], O); } \
                *(v4f*)(og + (row0 + (size_t)(c) * 64 + 16 * tt + m) * GW + h * HD + cg * 64 + 32 * nta + 16 * j + 4 * q) = O; } \
            GDN_PFQ(((c) + 2 < 32 ? (c) + 2 : 31), s_); \
            { v8s vf[4][2]; \
                _Pragma("unroll") for (int nt = 0; nt < 4; ++nt) _Pragma("unroll") for (int ks = 0; ks < 2; ++ks) vf[nt][ks] = *(const LAS v8s*)(VNT + (16 * nt + m) * 72 + 32 * ks + 8 * q); \
                _Pragma("unroll") for (int nt = 0; nt < 4; ++nt) { \
                    S[nt] = S[nt] * egl[s_]; \
                    _Pragma("unroll") for (int ks = 0; ks < 2; ++ks) S[nt] = MFMA16(KTf[s_][ks], vf[nt][ks], S[nt]); } \
                _Pragma("unroll") for (int nt = 0; nt < 4; ++nt) { v2u w; w.x = pk2(S[nt][0], S[nt][1]); w.y = pk2(S[nt][2], S[nt][3]); \
                    *(LAS v2u*)(STn + (16 * nt + m) * 136 + 16 * F.wave + 4 * q) = w; } } \
            GDN_PFK(((c) + 2 < 32 ? (c) + 2 : 31), s_); \
            LDS_BARRIER(); } while (0)
        GDN_PFA(0, 0); GDN_PFQ(0, 0); GDN_PFK(0, 0); GDN_PFA(1, 1); GDN_PFQ(1, 1); GDN_PFK(1, 1);
        __syncthreads();
        for (int c = 0; c < 32; c += 2) { GDN_STEP(c, 0); GDN_STEP(c + 1, 1); }
#undef GDN_PFQ
#undef GDN_PFK
#undef GDN_STEP
#undef GDN_PFA
#undef GDN_PFB
    }
}

__device__ __forceinline__ void gdn_gate_phase(const Args& a, Frame& F) {
    const float* og = (const float*)(a.ws + GDN_O);
    const bf16* proj = (const bf16*)(a.ws + WS_HB);
    unsigned char* mixed = a.ws + WS_MIXED;
    const float* nw = a.in[5];
    const int gw = F.bid * NWAVES + F.wave, NGW = F.G * NWAVES;
    const int cl = (F.lane & 15) * 8;
    const v4f n0 = *(const v4f*)(nw + cl), n1 = *(const v4f*)(nw + cl + 4);
    for (int t = gw; t < NTOK; t += NGW) {
#pragma unroll
        for (int j = 0; j < 4; ++j) {
            const int c = j * 512 + F.lane * 8;
            const v4f o0 = *(const v4f*)(og + (size_t)t * GW + c), o1 = *(const v4f*)(og + (size_t)t * GW + c + 4);
            float z[8]; unpack8(*(const v4u*)(proj + (size_t)t * EVEN_IN + PE_Z + c), z);
            float ss = (o0.x * o0.x + o0.y * o0.y) + (o0.z * o0.z + o0.w * o0.w) + (o1.x * o1.x + o1.y * o1.y) + (o1.z * o1.z + o1.w * o1.w);
            ss = row16_sum(ss);
            const float r = rsqrtf(ss * (1.0f / 128.0f) + RMS_EPS);
            float y[8];
            y[0] = o0.x * r * n0.x * siluf_(z[0]); y[1] = o0.y * r * n0.y * siluf_(z[1]); y[2] = o0.z * r * n0.z * siluf_(z[2]); y[3] = o0.w * r * n0.w * siluf_(z[3]);
            y[4] = o1.x * r * n1.x * siluf_(z[4]); y[5] = o1.y * r * n1.y * siluf_(z[5]); y[6] = o1.z * r * n1.z * siluf_(z[6]); y[7] = o1.w * r * n1.w * siluf_(z[7]);
#if FP8_OUT
            { v2u w; w.x = pk4_fp8(MIX8_SCALE * y[0], MIX8_SCALE * y[1], MIX8_SCALE * y[2], MIX8_SCALE * y[3]); w.y = pk4_fp8(MIX8_SCALE * y[4], MIX8_SCALE * y[5], MIX8_SCALE * y[6], MIX8_SCALE * y[7]); *(v2u*)(mixed + (size_t)t * DM + c) = w; }
#else
            *(v4u*)((bf16*)mixed + (size_t)t * DM + c) = pack8(y);
#endif
        }
    }
}

__device__ __forceinline__ void rg_scan_phase(const Args& a, Frame& F) {
    const unsigned* ABin = (const unsigned*)(a.ws + WS_A);
    const bf16* proj = (const bf16*)(a.ws + WS_HB);
    unsigned char* mixed = a.ws + WS_MIXED;
    LAS float* sA = (LAS float*)F.lds; LAS float* sH = sA + 64 * 32;
    const int c4 = (F.lane & 7) * 4, seg = F.wave * 8 + (F.lane >> 3);
    for (int item = F.bid; item < 256; item += F.G) {
        const int b = item >> 6, c = (item & 63) * 32 + c4;
        const size_t r0 = (size_t)b * SEQ + (size_t)seg * 32;
        float Ap[4] = {1.f, 1.f, 1.f, 1.f}, Hh[4] = {0.f, 0.f, 0.f, 0.f};
#pragma unroll 8
        for (int t = 0; t < 32; ++t) { const v4u w = *(const v4u*)(ABin + (r0 + t) * RGW + c);
#pragma unroll
            for (int e = 0; e < 4; ++e) { const float av = __expf(bflo(w[e])), bv = bfhi(w[e]); Hh[e] = av * Hh[e] + bv; Ap[e] *= av; } }
        __syncthreads();
        *(LAS v4f*)(sA + seg * 32 + c4) = (v4f){Ap[0], Ap[1], Ap[2], Ap[3]}; *(LAS v4f*)(sH + seg * 32 + c4) = (v4f){Hh[0], Hh[1], Hh[2], Hh[3]};
        __syncthreads();
        v4f hin = (v4f){0.f, 0.f, 0.f, 0.f};
        for (int s = 0; s < seg; ++s) hin = *(const LAS v4f*)(sA + s * 32 + c4) * hin + *(const LAS v4f*)(sH + s * 32 + c4);
        float hcur[4] = {hin.x, hin.y, hin.z, hin.w};
#pragma unroll 8
        for (int t = 0; t < 32; ++t) {
            const v4u w = *(const v4u*)(ABin + (r0 + t) * RGW + c);
            const v2u gw2 = *(const v2u*)(proj + (r0 + t) * EVEN_IN + PE_RGGATE + c);
            const float g[4] = {bflo(gw2.x), bfhi(gw2.x), bflo(gw2.y), bfhi(gw2.y)};
            float o[4];
#pragma unroll
            for (int e = 0; e < 4; ++e) { const float av = __expf(bflo(w[e])), bv = bfhi(w[e]); hcur[e] = av * hcur[e] + bv; o[e] = hcur[e] * gelu_tanh(g[e]); }
#if FP8_OUT
            *(unsigned*)(mixed + (r0 + t) * DM + GW + c) = pk4_fp8(clamp448(MIX8_SCALE * o[0]), clamp448(MIX8_SCALE * o[1]), clamp448(MIX8_SCALE * o[2]), clamp448(MIX8_SCALE * o[3]));
#else
            { v2u ow; ow.x = pk2(o[0], o[1]); ow.y = pk2(o[2], o[3]); *(v2u*)((bf16*)mixed + (r0 + t) * DM + GW + c) = ow; }
#endif
        }
    }
}

__device__ __forceinline__ void ln_phase(Frame& F, const bf16* res, const bf16* mixb, const float* g, const float* bb, float* outf, bf16* outb, unsigned char* out8) {
    const int gw = F.bid * NWAVES + F.wave, NGW = F.G * NWAVES;
    for (int row = gw; row < NTOK; row += NGW) {
        const bf16* rr = res + (size_t)row * DM; const bf16* mr = mixb + (size_t)row * DM;
        float y[8][8]; float s = 0.f;
#pragma unroll
        for (int j = 0; j < 8; ++j) {
            float x[8], mv[8]; unpack8(*(const v4u*)(rr + (64 * j + F.lane) * 8), x); unpack8(*(const v4u*)(mr + (64 * j + F.lane) * 8), mv);
#pragma unroll
            for (int e = 0; e < 8; ++e) { y[j][e] = DN_ALPHA * x[e] + mv[e]; s += y[j][e]; }
        }
        const float mean = wave_sum(s) * (1.0f / DM); float s2 = 0.f;
#pragma unroll
        for (int j = 0; j < 8; ++j)
#pragma unroll
            for (int e = 0; e < 8; ++e) { y[j][e] -= mean; s2 += y[j][e] * y[j][e]; }
        const float rstd = rsqrtf(wave_sum(s2) * (1.0f / DM) + LN_EPS);
#pragma unroll
        for (int j = 0; j < 8; ++j) {
            const int c = (64 * j + F.lane) * 8;
            const v4f g0 = *(const v4f*)(g + c), g1 = *(const v4f*)(g + c + 4), b0 = *(const v4f*)(bb + c), b1 = *(const v4f*)(bb + c + 4);
            float o[8];
            o[0] = y[j][0] * rstd * g0.x + b0.x; o[1] = y[j][1] * rstd * g0.y + b0.y; o[2] = y[j][2] * rstd * g0.z + b0.z; o[3] = y[j][3] * rstd * g0.w + b0.w;
            o[4] = y[j][4] * rstd * g1.x + b1.x; o[5] = y[j][5] * rstd * g1.y + b1.y; o[6] = y[j][6] * rstd * g1.z + b1.z; o[7] = y[j][7] * rstd * g1.w + b1.w;
            if (outf) { *(v4f*)(outf + (size_t)row * DM + c) = (v4f){o[0], o[1], o[2], o[3]}; *(v4f*)(outf + (size_t)row * DM + c + 4) = (v4f){o[4], o[5], o[6], o[7]}; }
            if (outb) *(v4u*)(outb + (size_t)row * DM + c) = pack8(o);
            if (out8) { v2u w; w.x = pk4_fp8(clamp448(o[0]), clamp448(o[1]), clamp448(o[2]), clamp448(o[3])); w.y = pk4_fp8(clamp448(o[4]), clamp448(o[5]), clamp448(o[6]), clamp448(o[7])); *(v2u*)(out8 + (size_t)row * DM + c) = w; }
        }
    }
}

__device__ __forceinline__ unsigned ordkey(float f) { const unsigned u = __float_as_uint(f); return (u & 0x80000000u) ? ~u : (u | 0x80000000u); }
__device__ __forceinline__ void split8(const v4f a, const v4f b, v8s& hi, v8s& lo) {
    v4u h; h.x = pk2(a.x, a.y); h.y = pk2(a.z, a.w); h.z = pk2(b.x, b.y); h.w = pk2(b.z, b.w);
    v4u l; l.x = pk2(a.x - bflo(h.x), a.y - bfhi(h.x)); l.y = pk2(a.z - bflo(h.y), a.w - bfhi(h.y)); l.z = pk2(b.x - bflo(h.z), b.y - bfhi(h.z)); l.w = pk2(b.z - bflo(h.w), b.w - bfhi(h.w));
    hi = __builtin_bit_cast(v8s, h); lo = __builtin_bit_cast(v8s, l);
}
__device__ __forceinline__ void peer_topk_phase(Frame& F, const bf16* q, const bf16* kh, const bf16* kl, int* idx, float* gate, unsigned char* Wz) {
    LAS float* sc = (LAS float*)F.lds;
    const int m = F.lane & 15, kq = F.lane >> 4;
    for (int u = F.bid; u < NTOK / 16; u += F.G) {
        const int t0 = u * 16;
        __syncthreads();
#ifndef REP_SC
#define REP_SC 1
#endif
#pragma unroll 1
        for (int hpi = 0; hpi < 2 * REP_SC; ++hpi) {
            const int hp = 2 * F.wave + (hpi & 1);
            v8s Qh[4];
#pragma unroll
            for (int ks = 0; ks < 4; ++ks) Qh[ks] = *(const v8s*)((const unsigned char*)q + tl_off((size_t)(t0 + m), hp * 128 + 32 * ks + 8 * kq, PQ / 256));
            v8s Kh[3][4];
#define TK_LOAD(kt_, s_) do { _Pragma("unroll") for (int ks = 0; ks < 4; ++ks) { const size_t off = (size_t)hp * 16384 + (((kt_) * 4 + ks) * 64 + F.lane) * 8; Kh[s_][ks] = *(const v8s*)(kh + off); } } while (0)
            TK_LOAD(0, 0); TK_LOAD(1, 1);
            __builtin_amdgcn_sched_barrier(0);
#pragma unroll
            for (int kt = 0; kt < 8; ++kt) {
                if (kt + 2 < 8) TK_LOAD(kt + 2, (kt + 2) % 3);
                __builtin_amdgcn_sched_barrier(0);
                v4f acc = (v4f){0.f, 0.f, 0.f, 0.f};
#pragma unroll
                for (int ks = 0; ks < 4; ++ks) acc = MFMA16(Kh[kt % 3][ks], Qh[ks], acc);
                LAS float* dst = sc + (m * 16 + hp) * 129 + 16 * kt + 4 * kq;
                dst[0] = acc[0]; dst[1] = acc[1]; dst[2] = acc[2]; dst[3] = acc[3];
                __builtin_amdgcn_sched_barrier(0);
            }
#undef TK_LOAD
        }
        __syncthreads();
        if (F.tid < 256) {
            LAS float* L = sc + F.tid * 129;
            unsigned a[16];
#pragma unroll
            for (int p = 0; p < 16; ++p) a[p] = 0u;
#pragma unroll 4
            for (int i = 0; i < 128; ++i) {
                unsigned x = (ordkey(L[i]) & ~127u) | (unsigned)(127 - i);
#pragma unroll
                for (int p = 0; p < 16; ++p) { const unsigned hi = max(a[p], x); x = min(a[p], x); a[p] = hi; }
            }
            float v[16];
#pragma unroll
            for (int p = 0; p < 16; ++p) v[p] = L[127 - (int)(a[p] & 127u)];
#pragma unroll
            for (int p = 0; p < 16; ++p) { L[p] = v[p]; L[16 + p] = __int_as_float(127 - (int)(a[p] & 127u)); }
        }
        __syncthreads();
        if (F.tid < 128) {
            const LAS float* L1 = sc + (2 * F.tid) * 129; const LAS float* L2 = L1 + 129;
            float v1[16], v2[16];
#pragma unroll
            for (int p = 0; p < 16; ++p) { v1[p] = L1[p]; v2[p] = L2[p]; }
            unsigned b[16];
#pragma unroll
            for (int p = 0; p < 16; ++p) b[p] = 0u;
#pragma unroll
            for (int ci = 0; ci < 16; ++ci)
#pragma unroll
                for (int cj = 0; cj < 16; ++cj)
                    if ((ci + 1) * (cj + 1) <= 16) {
                        unsigned x = (ordkey(v1[ci] + v2[cj]) & ~255u) | (unsigned)(255 - (ci * 16 + cj));
#pragma unroll
                        for (int p = 0; p < 16; ++p) { const unsigned hi = max(b[p], x); x = min(b[p], x); b[p] = hi; }
                    }
            float s[16]; int ex[16];
#pragma unroll
            for (int r = 0; r < 16; ++r) { const int pos = 255 - (int)(b[r] & 255u), ci = pos >> 4, cj = pos & 15;
                s[r] = L1[ci] + L2[cj]; ex[r] = __float_as_int(L1[16 + ci]) * PNK + __float_as_int(L2[16 + cj]); }
            const float s0 = s[0]; float den = 0.f;
#pragma unroll
            for (int r = 0; r < 16; ++r) { s[r] = __expf(s[r] - s0); den += s[r]; }
            const float rden = 1.0f / den;
#pragma unroll
            for (int r = 0; r < 16; ++r) s[r] *= rden;
            const int tok = F.tid >> 3, h = F.tid & 7; const size_t o = (size_t)(t0 + tok) * 128 + h * 16;
#pragma unroll
            for (int r = 0; r < 16; ++r) { idx[o + r] = ex[r]; gate[o + r] = s[r]; }
        }
    }
}

__device__ __forceinline__ void peer_sparse_phase(Frame& F, const int* idx, const float* gate, const bf16* Hb, unsigned char* Wb) {
    const int gw = F.bid * NWAVES + F.wave, NGW = F.G * NWAVES;
    LAS unsigned char* row = F.lds + F.wave * 16384;
    const v4u z = (v4u){0u, 0u, 0u, 0u};
    for (int t = gw; t < NTOK; t += NGW) {
        const int e0 = idx[(size_t)t * 128 + F.lane], e1 = idx[(size_t)t * 128 + 64 + F.lane];
        const float g0 = gate[(size_t)t * 128 + F.lane], g1 = gate[(size_t)t * 128 + 64 + F.lane];
        const int r_ = t & 255, ai_ = r_ >> 7, wr_ = (r_ >> 6) & 1, m_ = (r_ >> 4) & 3, fr_ = r_ & 15;
        const size_t trow = ((size_t)(t >> 8) * (PE / 256)) * 8 * 16384 + (size_t)wr_ * 4 * 16384 + (size_t)((ai_ * 4 + m_) * 2) * 1024 + (size_t)fr_ * 16;
#define H_AT(e_) bf2f(*(const bf16*)((const unsigned char*)Hb + trow + (size_t)((e_) >> 8) * 8 * 16384 + (size_t)(((e_) >> 6) & 3) * 16384 + (size_t)(((e_) >> 5) & 1) * 1024 + (size_t)(((e_) >> 3) & 3) * 256 + (size_t)((e_) & 7) * 2))
        const float h0 = H_AT(e0), h1 = H_AT(e1);
#undef H_AT
#pragma unroll
        for (int j = 0; j < 16; ++j) *(LAS v4u*)(row + (64 * j + F.lane) * 16) = z;
        float tot0 = 0.f, tot1 = 0.f; bool first0 = true, first1 = true;
#pragma unroll 8
        for (int j = 0; j < 64; ++j) {
            const int ea = __shfl(e0, j), eb = __shfl(e1, j); const float ga = __shfl(g0, j), gb = __shfl(g1, j);
            if (ea == e0) { tot0 += ga; if (j < F.lane) first0 = false; }
            if (eb == e0) { tot0 += gb; }
            if (ea == e1) { tot1 += ga; first1 = false; }
            if (eb == e1) { tot1 += gb; if (j < F.lane) first1 = false; }
        }
        LDS_WAIT(); asm volatile("" ::: "memory");
        if (first0) row[e0] = (unsigned char)(pk4_fp8(clamp448(W8_SCALE * tot0 * gelu_tanh(h0)), 0.f, 0.f, 0.f) & 0xffu);
        if (first1) row[e1] = (unsigned char)(pk4_fp8(clamp448(W8_SCALE * tot1 * gelu_tanh(h1)), 0.f, 0.f, 0.f) & 0xffu);
        LDS_WAIT(); asm volatile("" ::: "memory");
        v4u* wrow = (v4u*)(Wb + (size_t)t * PE);
#pragma unroll
        for (int j = 0; j < 16; ++j) wrow[64 * j + F.lane] = *(const LAS v4u*)(row + (64 * j + F.lane) * 16);
        LDS_WAIT(); asm volatile("" ::: "memory");
    }
}

__device__ __forceinline__ void sb_attn_phase(const Args& a, Frame& F, unsigned* qctr, const int item_lo, const int item_hi) {
    const bf16* proj = (const bf16*)(a.ws + WS_HB);
    unsigned char* mixed = a.ws + WS_MIXED;
    LAS bf16* Qs = (LAS bf16*)F.lds;
    LAS bf16* Ks = Qs + 128 * 136;
    LAS bf16* Vt = Ks + 64 * 136;
    LAS float* wmaxs = (LAS float*)(Vt + 128 * 72);
    const int m = F.lane & 15, q = F.lane >> 4;
    volatile LAS int* slot = (volatile LAS int*)(F.lds + MISC_OFF + 64);
    for (;;) {
        __syncthreads();
        if (F.tid == 0) slot[0] = (int)__hip_atomic_fetch_add(qctr, 1u, __ATOMIC_RELAXED, __HIP_MEMORY_SCOPE_AGENT);
        __syncthreads();
        const int item = item_lo + slot[0];
        if (item >= item_hi) break;
        const int qb = 15 - (item >> 6), hd = item & 15, b = (item >> 4) & 3;
        const int t0 = qb * 128; const size_t row0 = (size_t)b * SEQ;
        __syncthreads();
        {   const int r = F.tid >> 2, c = (F.tid & 3) * 32;
#pragma unroll
            for (int i = 0; i < 4; ++i) *(LAS v4u*)(Qs + r * 136 + c + 8 * i) = *(const v4u*)(proj + (row0 + t0 + r) * ODD_IN + hd * HD + c + 8 * i); }
        __syncthreads();
        v8s Qf[4];
#pragma unroll
        for (int ks = 0; ks < 4; ++ks) Qf[ks] = *(const LAS v8s*)(Qs + (16 * F.wave + m) * 136 + 32 * ks + 8 * q);
        v4f O[8];
#pragma unroll
        for (int dt = 0; dt < 8; ++dt) O[dt] = (v4f){0.f, 0.f, 0.f, 0.f};
        float R = 0.f;
        const int tq = t0 + 16 * F.wave + m;
        const int lr_ = F.tid >> 3, lc_ = (F.tid & 7) * 16;
        v4u pk0, pk1, pv0, pv1;
#define SB_LOAD(kbx) do { const bf16* p_ = proj + (row0 + (size_t)(kbx) * 64 + lr_) * ODD_IN + hd * HD + lc_; \
            pk0 = *(const v4u*)(p_ + SBW); pk1 = *(const v4u*)(p_ + SBW + 8); pv0 = *(const v4u*)(p_ + 2 * SBW); pv1 = *(const v4u*)(p_ + 2 * SBW + 8); } while (0)
        SB_LOAD((t0 >> 6) + 1);
        for (int kb = (t0 >> 6) + 1; kb >= 0; --kb) {
            const int s0 = kb * 64;
            LDS_BARRIER();
            {   *(LAS v4u*)(Ks + lr_ * 136 + lc_) = pk0; *(LAS v4u*)(Ks + lr_ * 136 + lc_ + 8) = pk1;
                const unsigned vw[8] = {pv0.x, pv0.y, pv0.z, pv0.w, pv1.x, pv1.y, pv1.z, pv1.w};
#pragma unroll
                for (int i = 0; i < 8; ++i) { Vt[(lc_ + 2 * i) * 72 + lr_] = (bf16)(vw[i] & 0xffffu); Vt[(lc_ + 2 * i + 1) * 72 + lr_] = (bf16)(vw[i] >> 16); }
            }
            if (kb > 0) SB_LOAD(kb - 1);
            LDS_BARRIER();
            if (s0 < t0 + 16 * F.wave + 15) {
            v4f S[4];
#pragma unroll
            for (int jt = 0; jt < 4; ++jt) { S[jt] = (v4f){0.f, 0.f, 0.f, 0.f};
#pragma unroll
                for (int ks = 0; ks < 4; ++ks) { const v8s Kf = *(const LAS v8s*)(Ks + (16 * jt + m) * 136 + 32 * ks + 8 * q); S[jt] = MFMA16(Kf, Qf[ks], S[jt]); } }
            float l[4][4], G[4];
#pragma unroll
            for (int jt = 0; jt < 4; ++jt) { G[jt] = 0.f;
#pragma unroll
                for (int r = 0; r < 4; ++r) { const float z = S[jt][r] * 0.08838834764831845f; S[jt][r] = z;
                    const bool mk = (s0 + 16 * jt + 4 * q + r) < tq;
                    const float lv = mk ? -(fmaxf(z, 0.f) + __logf(1.0f + __expf(-fabsf(z)))) : 0.f; l[jt][r] = lv; G[jt] += lv; } }
            float tg[4], TOT[4];
#pragma unroll
            for (int jt = 0; jt < 4; ++jt) {
                const float g1 = __shfl_xor(G[jt], 16), g2 = __shfl_xor(G[jt], 32), g3 = __shfl_xor(G[jt], 48);
                TOT[jt] = (G[jt] + g1) + (g2 + g3);
                tg[jt] = (((q ^ 1) > q) ? g1 : 0.f) + (((q ^ 2) > q) ? g2 : 0.f) + (((q ^ 3) > q) ? g3 : 0.f);
            }
            float after = 0.f;
            v4u Pw[2];
#pragma unroll
            for (int jt = 3; jt >= 0; --jt) {
                float tail = R + after + tg[jt];
                float w[4];
#pragma unroll
                for (int r = 3; r >= 0; --r) {
                    const bool mk = (s0 + 16 * jt + 4 * q + r) < tq;
                    w[r] = mk ? __expf(S[jt][r] + l[jt][r] + tail) : 0.f;
                    tail += l[jt][r];
                }
                after += TOT[jt];
                const unsigned lo = pk2(w[0], w[1]), hi = pk2(w[2], w[3]);
                if (jt & 1) { Pw[jt >> 1].z = lo; Pw[jt >> 1].w = hi; } else { Pw[jt >> 1].x = lo; Pw[jt >> 1].y = hi; }
            }
            R += after;
#pragma unroll
            for (int kp = 0; kp < 2; ++kp) {
                const v8s Pf = __builtin_bit_cast(v8s, Pw[kp]);
#pragma unroll
                for (int dt = 0; dt < 8; ++dt) {
                    const v2u a0 = *(const LAS v2u*)(Vt + (16 * dt + m) * 72 + 32 * kp + 4 * q), a1 = *(const LAS v2u*)(Vt + (16 * dt + m) * 72 + 32 * kp + 16 + 4 * q);
                    const v4u av = (v4u){a0.x, a0.y, a1.x, a1.y};
                    O[dt] = MFMA16(__builtin_bit_cast(v8s, av), Pf, O[dt]);
                }
            }
            }
            const float wm = wave_max(R);
            if (F.lane == 0) wmaxs[F.wave] = wm;
            LDS_BARRIER();
            float bm = wmaxs[0];
#pragma unroll
            for (int w = 1; w < 8; ++w) bm = fmaxf(bm, wmaxs[w]);
            if (bm < -100.f) break;
        }
#pragma unroll
#if FP8_OUT
        for (int dt = 0; dt < 8; ++dt) *(unsigned*)(mixed + (row0 + tq) * ODD_MIX + hd * HD + 16 * dt + 4 * q) = pk4_fp8(clamp448(MIX8_SCALE * O[dt][0]), clamp448(MIX8_SCALE * O[dt][1]), clamp448(MIX8_SCALE * O[dt][2]), clamp448(MIX8_SCALE * O[dt][3]));
#else
        for (int dt = 0; dt < 8; ++dt) { v2u w; w.x = pk2(O[dt][0], O[dt][1]); w.y = pk2(O[dt][2], O[dt][3]); *(v2u*)((bf16*)mixed + (row0 + tq) * ODD_MIX + hd * HD + 16 * dt + 4 * q) = w; }
#endif
#undef SB_LOAD
    }
}

__device__ __forceinline__ void s5_phase(const Args& a, Frame& F) {
    const bf16* proj = (const bf16*)(a.ws + WS_HB);
    bf16* yg = (bf16*)(a.ws + WS_YG);
    LAS float* us = (LAS float*)F.lds;
    LAS float* hre = us + 64 * 16;
    LAS float* him = hre + 64 * 68;
    LAS float* Ere = him + 64 * 68;
    LAS float* Eim = Ere + 8 * 64;
    const int n = F.lane, m = F.lane & 15, q = F.lane >> 4;
    for (int item = F.bid; item < 256; item += F.G) {
        const int b = item >> 6, g = item & 63; const size_t row0 = (size_t)b * SEQ;
        const float dt = __expf(a.in[17][g]);
        const float lr = fminf(a.in[15][g * 64 + n], -1e-4f), li = a.in[16][g * 64 + n];
        const float mag = expf(lr * dt), ab_re = mag * cosf(li * dt), ab_im = mag * sinf(li * dt);
        const float den = lr * lr + li * li, nr = ab_re - 1.0f, ni = ab_im;
        const float cr = (nr * lr + ni * li) / den, ci = (ni * lr - nr * li) / den;
        float bbr[16], bbi[16];
#pragma unroll
        for (int c = 0; c < 16; ++c) { const float br = a.in[18][((size_t)g * 64 + n) * 16 + c], bi = a.in[19][((size_t)g * 64 + n) * 16 + c]; bbr[c] = cr * br - ci * bi; bbi[c] = cr * bi + ci * br; }
        float pr[8], pi[8];
        pr[0] = ab_re; pi[0] = ab_im;
#pragma unroll
        for (int i = 1; i < 8; ++i) { pr[i] = pr[i - 1] * ab_re - pi[i - 1] * ab_im; pi[i] = pr[i - 1] * ab_im + pi[i - 1] * ab_re; }
        v8s Cf[4];
#pragma unroll
        for (int ks = 0; ks < 4; ++ks) { const float* src = (ks < 2 ? a.in[20] : a.in[21]) + ((size_t)g * 16 + m) * 64 + 32 * (ks & 1) + 8 * q; const float sg = ks < 2 ? 1.f : -1.f;
            const v4f x = *(const v4f*)src, y = *(const v4f*)(src + 4);
            v4u p; p.x = pk2(sg * x.x, sg * x.y); p.y = pk2(sg * x.z, sg * x.w); p.z = pk2(sg * y.x, sg * y.y); p.w = pk2(sg * y.z, sg * y.w); Cf[ks] = __builtin_bit_cast(v8s, p); }
        const v4f Dv = *(const v4f*)(a.in[22] + g * 16 + 4 * q);
        float c_re = 0.f, c_im = 0.f;
        const int ur = F.tid >> 1, uc8 = (F.tid & 1) * 8;
        v4u upf = (v4u){0u, 0u, 0u, 0u};
        if (F.tid < 128) upf = *(const v4u*)(proj + (row0 + ur) * ODD_IN + 3 * SBW + g * 16 + uc8);
        __syncthreads();
        for (int ch = 0; ch < SEQ / 64; ++ch) {
            const size_t r0 = row0 + (size_t)ch * 64;
            if (F.tid < 128) { float x[8]; unpack8(upf, x);
                *(LAS v4f*)(us + ur * 16 + uc8) = (v4f){x[0], x[1], x[2], x[3]}; *(LAS v4f*)(us + ur * 16 + uc8 + 4) = (v4f){x[4], x[5], x[6], x[7]};
                if (ch + 1 < SEQ / 64) upf = *(const v4u*)(proj + (r0 + 64 + ur) * ODD_IN + 3 * SBW + g * 16 + uc8); }
            LDS_BARRIER();
            float hlr[8], hli[8]; float h_re = 0.f, h_im = 0.f;
#pragma unroll
            for (int i = 0; i < 8; ++i) { const int t = F.wave * 8 + i;
                const v4f u0 = *(const LAS v4f*)(us + t * 16), u1 = *(const LAS v4f*)(us + t * 16 + 4), u2 = *(const LAS v4f*)(us + t * 16 + 8), u3 = *(const LAS v4f*)(us + t * 16 + 12);
                const float sr = (u0.x * bbr[0] + u0.y * bbr[1] + u0.z * bbr[2] + u0.w * bbr[3]) + (u1.x * bbr[4] + u1.y * bbr[5] + u1.z * bbr[6] + u1.w * bbr[7])
                               + (u2.x * bbr[8] + u2.y * bbr[9] + u2.z * bbr[10] + u2.w * bbr[11]) + (u3.x * bbr[12] + u3.y * bbr[13] + u3.z * bbr[14] + u3.w * bbr[15]);
                const float si = (u0.x * bbi[0] + u0.y * bbi[1] + u0.z * bbi[2] + u0.w * bbi[3]) + (u1.x * bbi[4] + u1.y * bbi[5] + u1.z * bbi[6] + u1.w * bbi[7])
                               + (u2.x * bbi[8] + u2.y * bbi[9] + u2.z * bbi[10] + u2.w * bbi[11]) + (u3.x * bbi[12] + u3.y * bbi[13] + u3.z * bbi[14] + u3.w * bbi[15]);
                const float nre = ab_re * h_re - ab_im * h_im + sr, nim = ab_re * h_im + ab_im * h_re + si; h_re = nre; h_im = nim; hlr[i] = nre; hli[i] = nim; }
            Ere[F.wave * 64 + n] = h_re; Eim[F.wave * 64 + n] = h_im;
            LDS_BARRIER();
            float in_re = c_re, in_im = c_im;
#pragma unroll
            for (int w = 0; w < 8; ++w) {
                if (w == F.wave) { in_re = c_re; in_im = c_im; }
                const float er = Ere[w * 64 + n], ei = Eim[w * 64 + n];
                const float nre = pr[7] * c_re - pi[7] * c_im + er, nim = pr[7] * c_im + pi[7] * c_re + ei; c_re = nre; c_im = nim;
            }
#pragma unroll
            for (int i = 0; i < 8; ++i) { const int t = F.wave * 8 + i;
                hre[t * 68 + n] = hlr[i] + (pr[i] * in_re - pi[i] * in_im); him[t * 68 + n] = hli[i] + (pr[i] * in_im + pi[i] * in_re); }
            LDS_BARRIER();
            if (F.wave < 4) {
                const int t = F.wave * 16 + m;
                v4f acc = (v4f){0.f, 0.f, 0.f, 0.f};
#pragma unroll
                for (int ks = 0; ks < 4; ++ks) { const LAS float* hp = (ks < 2 ? hre : him) + t * 68 + 32 * (ks & 1) + 8 * q;
                    const v4f x = *(const LAS v4f*)hp, y = *(const LAS v4f*)(hp + 4);
                    v4u p; p.x = pk2(x.x, x.y); p.y = pk2(x.z, x.w); p.z = pk2(y.x, y.y); p.w = pk2(y.z, y.w);
                    acc = MFMA16(Cf[ks], __builtin_bit_cast(v8s, p), acc); }
                const v4f uv = *(const LAS v4f*)(us + t * 16 + 4 * q);
                v2u w; w.x = pk2(gelu_tanh(acc[0] + Dv.x * uv.x), gelu_tanh(acc[1] + Dv.y * uv.y)); w.y = pk2(gelu_tanh(acc[2] + Dv.z * uv.z), gelu_tanh(acc[3] + Dv.w * uv.w));
                *(v2u*)(yg + (r0 + t) * S5W + g * 16 + 4 * q) = w;
            }
            LDS_BARRIER();
        }
    }
}

namespace pg8 {
struct EpiGlu {
    static constexpr bool PERM = true, AFTER_DRAIN = false;
    unsigned char* O; int ldo; int ocol0; const bf16_t* Y; int ldy; const float* bias;
    __device__ __forceinline__ void operator()(const f32x4 (&acc)[2][2][4][2], const Unit& u, int wr, int wc, int fr, int fq) const {
        const int row0 = u.pm * BM + wr * 64 + fr, col0 = u.pn * BM + wc * 64 + 8 * fq;
#pragma unroll
        for (int ai = 0; ai < 2; ++ai)
#pragma unroll
            for (int m = 0; m < 4; ++m) { const int row = row0 + ai * HALF + m * 16;
#pragma unroll
                for (int bj = 0; bj < 2; ++bj) { const int col = col0 + bj * 32;
                    const f32x4 b0 = *(const f32x4*)(bias + col), b1 = *(const f32x4*)(bias + col + 4);
                    const f32x4 v0 = acc[ai][bj][m][0] + b0, v1 = acc[ai][bj][m][1] + b1;
                    const u32x4 yw = *(const u32x4*)(Y + (size_t)row * ldy + col);
                    float y[8]; unpack8(yw, y);
#if !FP8_OUT
                    { u32x4 wb; wb.x = pk2(y[0] * sigmoidf_(v0[0]), y[1] * sigmoidf_(v0[1])); wb.y = pk2(y[2] * sigmoidf_(v0[2]), y[3] * sigmoidf_(v0[3]));
                      wb.z = pk2(y[4] * sigmoidf_(v1[0]), y[5] * sigmoidf_(v1[1])); wb.w = pk2(y[6] * sigmoidf_(v1[2]), y[7] * sigmoidf_(v1[3]));
                      *(u32x4*)((bf16_t*)O + (size_t)row * ldo + ocol0 + col) = wb; continue; }
#endif
                    v2u w; w.x = pk4_fp8(clamp448(MIX8_SCALE * y[0] * sigmoidf_(v0[0])), clamp448(MIX8_SCALE * y[1] * sigmoidf_(v0[1])), clamp448(MIX8_SCALE * y[2] * sigmoidf_(v0[2])), clamp448(MIX8_SCALE * y[3] * sigmoidf_(v0[3])));
                    w.y = pk4_fp8(clamp448(MIX8_SCALE * y[4] * sigmoidf_(v1[0])), clamp448(MIX8_SCALE * y[5] * sigmoidf_(v1[1])), clamp448(MIX8_SCALE * y[6] * sigmoidf_(v1[2])), clamp448(MIX8_SCALE * y[7] * sigmoidf_(v1[3])));
                    *(v2u*)(O + (size_t)row * ldo + ocol0 + col) = w; } }
    }
};
struct EpiTiled {
    static constexpr bool PERM = true, AFTER_DRAIN = false;
    bf16_t* O; int ntn;
    __device__ __forceinline__ void operator()(const f32x4 (&acc)[2][2][4][2], const Unit& u, int wr, int wc, int fr, int fq) const {
        unsigned char* base = (unsigned char*)O + ((size_t)(u.pm * ntn + u.pn) * 8 + wr * 4 + wc) * 16384 + (size_t)(fq * 16 + fr) * 16;
#pragma unroll
        for (int ai = 0; ai < 2; ++ai)
#pragma unroll
            for (int m = 0; m < 4; ++m)
#pragma unroll
                for (int bj = 0; bj < 2; ++bj) { const f32x4 v0 = acc[ai][bj][m][0], v1 = acc[ai][bj][m][1];
                    u32x4 w; w.x = cvt_pk_bf16(v0[0], v0[1]); w.y = cvt_pk_bf16(v0[2], v0[3]); w.z = cvt_pk_bf16(v1[0], v1[1]); w.w = cvt_pk_bf16(v1[2], v1[3]);
                    *(u32x4*)(base + (size_t)(((ai * 4 + m) * 2 + bj) * 1024)) = w; }
    }
};
struct EpiNull { static constexpr bool PERM = true, AFTER_DRAIN = false; float* sink;
    __device__ __forceinline__ void operator()(const f32x4 (&acc)[2][2][4][2], const Unit& u, int wr, int wc, int fr, int fq) const {
        float s = 0.f;
#pragma unroll
        for (int a = 0; a < 2; ++a)
#pragma unroll
            for (int b = 0; b < 2; ++b)
#pragma unroll
                for (int m = 0; m < 4; ++m)
#pragma unroll
                    for (int n = 0; n < 2; ++n) s += acc[a][b][m][n][0] + acc[a][b][m][n][1] + acc[a][b][m][n][2] + acc[a][b][m][n][3];
        if (s == 123456.789f) sink[0] = s; } };
struct EpiFixed { static constexpr bool PERM = true, AFTER_DRAIN = false; EpiBf16<0> e;
    __device__ __forceinline__ void operator()(const f32x4 (&acc)[2][2][4][2], const Unit& u, int wr, int wc, int fr, int fq) const { const Unit z{0, 0}; e(acc, z, wr, wc, fr, fq); } };
}

struct RangeOrder : pg8::StaticOrder {
    int i0, i1;
    __device__ bool next(int i, pg8::Unit& u) const { return (i + i0 < i1) && pg8::StaticOrder::next(i + i0, u); }
};
template <int SW, int SX, class Epi>
__device__ __forceinline__ void gemm8_range(Frame& F, const unsigned char* A, const unsigned char* Bt, int M, int N, int K, int i0, int i1, const Epi& E) {
    if (i0 >= i1) return;
    pg8::Gemm g{(const bf16*)A, (const bf16*)Bt, M, N, K / 2}; RangeOrder S; S.init(M, N, F.G, F.bid); S.i0 = i0; S.i1 = i1;
    pg8::gemm_phase<Epi, RangeOrder, false, true, SW, SX>(F.lds, g, S, E, nullptr);
}
struct SameOrder : pg8::StaticOrder {
    int rounds;
    __device__ bool next(int i, pg8::Unit& u) const { if (i >= rounds) return false; u.pm = 0; u.pn = i; return true; }
};
template <int SW, int SX, class Epi>
__device__ __forceinline__ void gemm8_same(Frame& F, const unsigned char* A, const unsigned char* Bt, int M, int N, int K, int rounds, const Epi& E) {
    pg8::Gemm g{(const bf16*)A, (const bf16*)Bt, M, N, K / 2}; SameOrder S; S.init(M, N, F.G, F.bid); S.rounds = rounds;
    pg8::gemm_phase<Epi, SameOrder, false, true, SW, SX>(F.lds, g, S, E, nullptr);
}
template <class Epi>
__device__ __forceinline__ void gemm(Frame& F, const bf16* A, const bf16* Bt, int M, int N, int K, const Epi& E) {
    pg8::Gemm g{A, Bt, M, N, K}; pg8::StaticOrder S; S.init(M, N, F.G, F.bid);
    pg8::gemm_phase<Epi, pg8::StaticOrder, false, false>(F.lds, g, S, E, nullptr);
}
template <int SW, int SX, class Epi>
__device__ __forceinline__ void gemm8(Frame& F, const unsigned char* A, const unsigned char* Bt, int M, int N, int K, const Epi& E) {
    pg8::Gemm g{(const bf16*)A, (const bf16*)Bt, M, N, K / 2}; pg8::StaticOrder S; S.init(M, N, F.G, F.bid);
    pg8::gemm_phase<Epi, pg8::StaticOrder, false, true, SW, SX>(F.lds, g, S, E, nullptr);
}

#define PEER_LAYER(PB, L, HBF, H8, RESF, OUTF, OUTB, OUT8)                                                                                                            \
    if (IN(PB)) { if (FP8_WQ) gemm8<E8_WIN, E8_1>(F, (const unsigned char*)(H8), ws + ((L) ? WS_WQ1 : WS_WQ0), NTOK, PQ, DM, pg8::EpiF32{(float*)(ws + WS_Q), PQ, nullptr}); \
        else gemm(F, (const bf16*)(HBF), (const bf16*)(ws + ((L) ? WS_WQ1 : WS_WQ0)), NTOK, PQ, DM, pg8::EpiTiled{(bf16*)(ws + WS_Q), PQ / 256}); SEAM(PB); }     \
    if (IN(PB + 1)) {     \
        { const int gsplit = F.bid & 7;     \
          const pg8::EpiTiled EU{(bf16*)(ws + WS_HB), PE / 256};                                                                                     \
          gemm8_range<E8_U, E8_1>(F, (const unsigned char*)(H8), ws + ((L) ? WS_U8_1 : WS_U8_0), NTOK, PE, DM, 0, gsplit, EU);                                   \
          __syncthreads();                                                                                                                                        \
          REPEAT(REP_TOPK) peer_topk_phase(F, (const bf16*)(ws + WS_Q), (const bf16*)(ws + WS_KH) + (size_t)(L) * PH * 2 * PNK * PHALF, (const bf16*)(ws + WS_KL) + (size_t)(L) * PH * 2 * PNK * PHALF, (int*)(ws + WS_IDX), (float*)(ws + WS_GATE), ws + WS_WB);      \
          __syncthreads();                                                                                                                                        \
          if (!(L)) { p0_prologue(a, F, 2); __syncthreads(); }                                                                                                    \
          gemm8_range<E8_U, E8_1>(F, (const unsigned char*)(H8), ws + ((L) ? WS_U8_1 : WS_U8_0), NTOK, PE, DM, gsplit, 1 << 20, EU); }                           \
        SEAM(PB + 1); }    \
    if (IN(PB + 2)) { if (EXP_U == 1) gemm8<E8_U, E8_1>(F, (const unsigned char*)(H8), ws + ((L) ? WS_U8_1 : WS_U8_0), NTOK, PE, DM, pg8::EpiBf16<0>{(bf16*)(ws + WS_HB), PE, nullptr, 0, 0}); \
        if (EXP_U == 3) gemm8<E8_U, E8_1>(F, (const unsigned char*)(H8), ws + ((L) ? WS_U8_1 : WS_U8_0), NTOK, PE, DM, pg8::EpiFixed{pg8::EpiBf16<0>{(bf16*)(ws + WS_RES) + (size_t)F.bid * 256 * 256, 256, nullptr, 0, 0}}); \
        if (EXP_U == 2) gemm8<E8_U, E8_1>(F, (const unsigned char*)(H8), ws + ((L) ? WS_U8_1 : WS_U8_0), NTOK, PE, DM, pg8::EpiNull{(float*)(ws + WS_Q)}); \
        if (EXP_V) gemm8<E8_V, E8_W>(F, ws + WS_X8_1 - WS_X8_1 + WS_WB, ws + ((L) ? WS_VT8_1 : WS_VT8_0), NTOK, DM, PE, pg8::EpiBf16<0>{(bf16*)(ws + WS_MIX), DM, nullptr, 0, 0}); \
        REPEAT(REP_SPARSE) peer_sparse_phase(F, (const int*)(ws + WS_IDX), (const float*)(ws + WS_GATE), (const bf16*)(ws + WS_HB), ws + WS_WB); SEAM(PB + 2); }   \
    if (IN(PB + 3)) { gemm8<E8_V, E8_W>(F, ws + WS_WB, ws + ((L) ? WS_VT8_1 : WS_VT8_0), NTOK, DM, PE, pg8::EpiBf16<0>{(bf16*)(ws + WS_MIX), DM, nullptr, 0, 0}); SEAM(PB + 3); } \
    if (IN(PB + 4)) { REPEAT(REP_LN) ln_phase(F, (RESF), (const bf16*)(ws + WS_MIX), a.in[32] + (L) * DM, a.in[33] + (L) * DM, (OUTF), (OUTB), (OUT8)); SEAM(PB + 4); }

constexpr int N_PHASES = 22;
#ifndef ATTN_SPLIT
#define ATTN_SPLIT 448
#endif
#ifndef REP_PRO
#define REP_PRO 1
#endif
#ifndef REP_P2
#define REP_P2 1
#endif
#ifndef REP_REC
#define REP_REC 1
#endif
#ifndef REP_GS
#define REP_GS 1
#endif
#ifndef REP_LN
#define REP_LN 1
#endif
#ifndef REP_TOPK
#define REP_TOPK 1
#endif
#ifndef REP_SPARSE
#define REP_SPARSE 1
#endif
#ifndef REP_ATTN
#define REP_ATTN 1
#endif
#ifndef REP_S5
#define REP_S5 1
#endif
#ifndef REP_G8
#define REP_G8 1
#endif
#ifndef REP_G16
#define REP_G16 1
#endif
#ifndef REP_GP
#define REP_GP -1
#endif
#define RG16(p) (((p) == REP_GP) ? 2 : REP_G16)
#ifndef REP_PREP
#define REP_PREP 1
#endif
#ifndef REP_AB
#define REP_AB 1
#endif
#ifndef REP_RGG
#define REP_RGG 1
#endif
#ifndef REP_GATE
#define REP_GATE 1
#endif
#ifndef REP_SCAN
#define REP_SCAN 1
#endif
#ifndef REP_CA
#define REP_CA 1
#endif
#ifndef REP_CB
#define REP_CB 1
#endif
#ifndef EXP_U
#define EXP_U 0
#endif
#ifndef EXP_V
#define EXP_V 0
#endif
#ifndef SKEW_STEPS
#define SKEW_STEPS 0
#endif
#define SKEW_DELAY() do { _Pragma("unroll 1") for (int s_ = 0; s_ < SKEW_STEPS * (F.bid & 7); ++s_) __builtin_amdgcn_s_sleep(32); } while (0)
#define REPEAT(n) _Pragma("unroll 1") for (int rep_ = 0; rep_ < (n); ++rep_)

__global__ void __launch_bounds__(NTHR, 2) fwd_kernel(Args a) {
    extern __shared__ __attribute__((aligned(16))) unsigned char lds_raw[];
    Frame F; F.lds = (LAS unsigned char*)lds_raw; F.tid = threadIdx.x; F.lane = F.tid & 63; F.wave = __builtin_amdgcn_readfirstlane(F.tid >> 6); F.G = gridDim.x; F.bid = blockIdx.x;
    unsigned char* ws = a.ws;
    volatile LAS unsigned* MISC = (volatile LAS unsigned*)(F.lds + MISC_OFF);
    if (F.tid < 32) MISC[F.tid] = 0u;
    __syncthreads();
    const bool one_launch = (a.ph_hi - a.ph_lo) > 1;
    XcdBarrier bar; bar.bar = (unsigned*)(ws + WS_CTL) + CW_BAR; bar.x = 0; bar.st = nullptr;
    if (one_launch) bar = xcd_barrier_post((unsigned*)(ws + WS_CTL) + CW_BAR, MISC + 8);
    const int lo = a.ph_lo, hi = a.ph_hi;
#define IN(k) (lo <= (k) && (k) < hi)
#ifdef PROBE_WAIT
#ifndef PROBE_MASK
#define PROBE_MASK 0xffffffu
#endif
    unsigned long long wait_total = 0ull;
#ifndef PROBE_PHM
#define PROBE_PHM 0u
#endif
    unsigned long long tprev_ = __builtin_amdgcn_s_memrealtime();
#define SEAM(k) do { if (IN((k) + 1)) { const unsigned long long t0_ = __builtin_amdgcn_s_memrealtime(); xcd_barrier(bar); const unsigned long long t1_ = __builtin_amdgcn_s_memrealtime(); if ((PROBE_MASK >> (k)) & 1) wait_total += t1_ - t0_; \
        if ((PROBE_PHM >> (k)) & 1) wait_total += (t1_ - tprev_) * 4; tprev_ = t1_; } } while (0)
#else
#define SEAM(k) do { if (IN((k) + 1)) xcd_barrier(bar); } while (0)
#endif

#ifdef EXTRA_BARS
    if (one_launch) { _Pragma("unroll 1") for (int i_ = 0; i_ < EXTRA_BARS; ++i_) xcd_barrier(bar); }
#endif
    if (IN(0)) { REPEAT(REP_PRO) p0_prologue(a, F, 0); SEAM(0); }
#if FP8_INE
    if (IN(1)) {
        const int gsplit = F.bid % 7;
        const pg8::EpiBf16<0> E1{(bf16*)(ws + WS_HB), EVEN_IN, nullptr, 0, 0};
        gemm8_range<E8_WIN, E8_1>(F, ws + WS_X8_0, ws + WS_WINE, NTOK, EVEN_IN, DM, 0, gsplit, E1);
        __syncthreads();
        p0_prologue(a, F, 1);
        __syncthreads();
        gemm8_range<E8_WIN, E8_1>(F, ws + WS_X8_0, ws + WS_WINE, NTOK, EVEN_IN, DM, gsplit, 1 << 20, E1);
        SEAM(1); }
#else
    if (IN(1)) { p0_prologue(a, F, 1); __syncthreads(); REPEAT(RG16(1)) gemm(F, (const bf16*)(ws + WS_XB0), (const bf16*)(ws + WS_WINE), NTOK, EVEN_IN, DM, pg8::EpiBf16<0>{(bf16*)(ws + WS_HB), EVEN_IN, nullptr, 0, 0}); SEAM(1); }
#endif
    if (IN(2)) { REPEAT(REP_P2) { REPEAT(REP_PREP) gdn_prep_phase(a, F); REPEAT(REP_AB) ab_proj_phase(a, F); REPEAT(REP_RGG) rg_gates_phase(a, F); } SEAM(2); }
    if (IN(3)) { REPEAT(REP_REC) { REPEAT(REP_CA) gdn_chunk_prep_phase(a, F); if (one_launch) xcd_barrier(bar);
#ifdef PROBE_CB
        { const unsigned long long t0_ = __builtin_amdgcn_s_memrealtime(); gdn_chunk_rec_phase(a, F); wait_total += (__builtin_amdgcn_s_memrealtime() - t0_) * PROBE_CB; }
#else
        REPEAT(REP_CB) gdn_chunk_rec_phase(a, F);
#endif
        } SEAM(3); }
    if (IN(4)) { REPEAT(REP_GS) { REPEAT(REP_GATE) gdn_gate_phase(a, F); REPEAT(REP_SCAN) rg_scan_phase(a, F); } SEAM(4); }
#if FP8_OUT
    if (IN(5)) { REPEAT(RG16(5)) gemm8<E8_WOUT, E8_MIX>(F, ws + WS_MIXED, ws + WS_WOUTE, NTOK, DM, DM, pg8::EpiBf16<0>{(bf16*)(ws + WS_MIX), DM, nullptr, 0, 0}); SEAM(5); }
#else
    if (IN(5)) { REPEAT(RG16(5)) gemm(F, (const bf16*)(ws + WS_MIXED), (const bf16*)(ws + WS_WOUTE), NTOK, DM, DM, pg8::EpiBf16<0>{(bf16*)(ws + WS_MIX), DM, nullptr, 0, 0}); SEAM(5); }
#endif
    if (IN(6)) { REPEAT(REP_LN) ln_phase(F, (const bf16*)(ws + WS_XB0), (const bf16*)(ws + WS_MIX), a.in[26], a.in[27], (float*)nullptr, (bf16*)(ws + WS_XB1), ws + WS_X8_1); SEAM(6); }
    PEER_LAYER(7, 0, ws + WS_XB1, ws + WS_X8_1, (const bf16*)(ws + WS_XB1), (float*)nullptr, (bf16*)(ws + WS_XB0), ws + WS_X8_0)
#if FP8_INO
    if (IN(12)) { REPEAT(RG16(12)) gemm8<E8_WIN, E8_1>(F, ws + WS_X8_0, ws + WS_WINO, NTOK, ODD_IN, DM, pg8::EpiBf16<0>{(bf16*)(ws + WS_HB), ODD_IN, nullptr, 0, 0}); SEAM(12); }
#else
    if (IN(12)) { REPEAT(RG16(12)) gemm(F, (const bf16*)(ws + WS_XB0), (const bf16*)(ws + WS_WINO), NTOK, ODD_IN, DM, pg8::EpiBf16<0>{(bf16*)(ws + WS_HB), ODD_IN, nullptr, 0, 0}); SEAM(12); }
#endif
    if (IN(13)) { REPEAT(REP_S5) s5_phase(a, F); SEAM(13); }
    if (IN(14)) {
        gemm(F, (const bf16*)(ws + WS_YG), (const bf16*)(ws + WS_GLU), NTOK, S5W, S5W, pg8::EpiGlu{ws + WS_MIXED, ODD_MIX, SBW, (const bf16*)(ws + WS_YG), S5W, a.in[24]});
        sb_attn_phase(a, F, (unsigned*)(ws + WS_CTL) + 16384, 0, 1024); SEAM(14); }
#if FP8_OUT
    if (IN(15)) { REPEAT(RG16(15)) gemm8<E8_WOUT, E8_MIX>(F, ws + WS_MIXED, ws + WS_WOUTO, NTOK, DM, ODD_MIX, pg8::EpiBf16<0>{(bf16*)(ws + WS_MIX), DM, nullptr, 0, 0}); SEAM(15); }
#else
    if (IN(15)) { REPEAT(RG16(15)) gemm(F, (const bf16*)(ws + WS_MIXED), (const bf16*)(ws + WS_WOUTO), NTOK, DM, ODD_MIX, pg8::EpiBf16<0>{(bf16*)(ws + WS_MIX), DM, nullptr, 0, 0}); SEAM(15); }
#endif
    if (IN(16)) { REPEAT(REP_LN) ln_phase(F, (const bf16*)(ws + WS_XB0), (const bf16*)(ws + WS_MIX), a.in[26] + DM, a.in[27] + DM, (float*)nullptr, (bf16*)(ws + WS_XB1), ws + WS_X8_1); SEAM(16); }
    PEER_LAYER(17, 1, ws + WS_XB1, ws + WS_X8_1, (const bf16*)(ws + WS_XB1), a.out, (bf16*)nullptr, (unsigned char*)nullptr)
#ifdef PROBE_WAIT
    if ((PROBE_WAIT < 0) || ((int)F.bid == PROBE_WAIT)) { const unsigned long long t0_ = __builtin_amdgcn_s_memrealtime(); while (__builtin_amdgcn_s_memrealtime() - t0_ < wait_total) __builtin_amdgcn_s_sleep(8); }
#endif
#undef IN
#undef SEAM
}

#ifndef MK_ONE_LAUNCH
#define MK_ONE_LAUNCH 1
#endif
extern "C" void kernel_launch(void* const* d_in, const int* in_sizes, int n_in, void* d_out, int out_size, void* d_ws, size_t ws_size, hipStream_t stream) {
    static int grid = 0;
    if (grid == 0) {
        if (n_in != 34 || in_sizes[0] != NTOK * DM || out_size != NTOK * DM || ws_size < WS_END) { fprintf(stderr, "kernel_launch: unexpected shapes (n_in %d, in0 %d, out %d, ws %zu < %zu); nothing launched\n", n_in, n_in > 0 ? in_sizes[0] : -1, out_size, ws_size, (size_t)WS_END); grid = -1; return; }
        int dev = 0, cus = 0, per_cu = 0;
        if (hipGetDevice(&dev) != hipSuccess || hipDeviceGetAttribute(&cus, hipDeviceAttributeMultiprocessorCount, dev) != hipSuccess) { grid = -1; return; }
        if (hipFuncSetAttribute((const void*)fwd_kernel, hipFuncAttributeMaxDynamicSharedMemorySize, LDS_BYTES) != hipSuccess) { fprintf(stderr, "kernel_launch: hipFuncSetAttribute failed\n"); grid = -1; return; }
        if (hipOccupancyMaxActiveBlocksPerMultiprocessor(&per_cu, (const void*)fwd_kernel, NTHR, LDS_BYTES) != hipSuccess || per_cu < 1) { fprintf(stderr, "kernel_launch: occupancy query says %d blocks per CU\n", per_cu); }
        (void)hipGetLastError();
        grid = cus;
    }
    if (grid < 0) return;
    (void)hipMemsetAsync((char*)d_ws + WS_CTL, 0, CTL_ZERO_BYTES, stream);
    Args a{};
    for (int i = 0; i < 34; ++i) a.in[i] = (const float*)d_in[i];
    a.out = (float*)d_out; a.ws = (unsigned char*)d_ws;
#if MK_ONE_LAUNCH
    a.ph_lo = 0; a.ph_hi = N_PHASES;
    hipLaunchKernelGGL(fwd_kernel, dim3(grid), dim3(NTHR), LDS_BYTES, stream, a);
#else
    for (int p = 0; p < N_PHASES; ++p) { a.ph_lo = p; a.ph_hi = p + 1; hipLaunchKernelGGL(fwd_kernel, dim3(grid), dim3(NTHR), LDS_BYTES, stream, a); }
#endif
}
```

```cpp
#include <hip/hip_runtime.h>
#include <cstdio>
#include <cstdint>

#define GAS __attribute__((address_space(1)))
#define LAS __attribute__((address_space(3)))
typedef unsigned short bf16;
typedef unsigned v4u __attribute__((ext_vector_type(4)));
typedef unsigned v2u __attribute__((ext_vector_type(2)));
typedef float v4f __attribute__((ext_vector_type(4)));
typedef float v2f __attribute__((ext_vector_type(2)));
typedef short v8s __attribute__((ext_vector_type(8)));

constexpr int NB = 4, SEQ = 2048, DM = 4096, NTOK = NB * SEQ;
constexpr int GW = 2048, GH = 16, HD = 128;
constexpr int RGW = 2048, RGB = 128, RGN = 16;
constexpr int EVEN_IN_SRC = 12320;
constexpr int EVEN_IN = 12288;
constexpr int PE_Z = 6144, PE_RGIN = 8192, PE_RGGATE = 10240;
constexpr int ODD_IN = 7168;
constexpr int SBW = 2048, S5W = 1024, S5G = 64, S5N = 64, S5C = 16;
constexpr int ODD_MIX = 3072;
constexpr int PH = 8, PNK = 128, PHALF = 128, PTOPK = 16, PQ = 2048, PE = 16384;
constexpr float DN_ALPHA = 1.41421356237f;
constexpr float LN_EPS = 1e-5f, RMS_EPS = 1e-6f;

constexpr size_t MiB = 1u << 20;
constexpr size_t WS_CTL = 0, CTL_ZERO_BYTES = 1 * MiB;
constexpr size_t WS_WINE = 1 * MiB;
constexpr size_t WS_WAB = 97 * MiB;
constexpr size_t WS_WOUTE = 98 * MiB;
constexpr size_t WS_WINO = 130 * MiB;
constexpr size_t WS_WOUTO = 186 * MiB;
constexpr size_t WS_WQ0 = 210 * MiB;
constexpr size_t WS_WQ1 = 226 * MiB;
constexpr size_t WS_GLU = 242 * MiB;
constexpr size_t WS_RGW = 244 * MiB;
constexpr size_t WS_U0 = 246 * MiB;
constexpr size_t WS_U1 = 374 * MiB;
constexpr size_t WS_VT0 = 502 * MiB;
constexpr size_t WS_VT1 = 630 * MiB;
constexpr size_t WS_HB = 758 * MiB;
constexpr size_t WS_WB = 1014 * MiB;
constexpr size_t WS_XB0 = 1270 * MiB;
constexpr size_t WS_XB1 = 1334 * MiB;
constexpr size_t WS_RES = 1398 * MiB;
constexpr size_t WS_MIX = 1526 * MiB;
constexpr size_t WS_MIXED = 1590 * MiB;
constexpr size_t WS_Q = 1654 * MiB;
constexpr size_t WS_IDX = 1718 * MiB;
constexpr size_t WS_GATE = 1722 * MiB;
constexpr size_t WS_A = 1726 * MiB;
constexpr size_t WS_B = 1790 * MiB;
constexpr size_t WS_BETA = 1854 * MiB;
constexpr size_t WS_EG = 1855 * MiB;
constexpr size_t WS_YG = 1856 * MiB;
constexpr size_t WS_X8_0 = 1872 * MiB;
constexpr size_t WS_X8_1 = 1904 * MiB;
constexpr size_t WS_KH = 1936 * MiB;
constexpr size_t WS_KL = 1937 * MiB;
constexpr size_t WS_END = 1938 * MiB;
constexpr size_t WS_U8_0 = WS_U0, WS_U8_1 = WS_U0 + 64 * MiB;
constexpr size_t WS_VT8_0 = WS_VT0, WS_VT8_1 = WS_VT0 + 64 * MiB;
constexpr float U8_SCALE = 64.f, V8_SCALE = 8.f, W8_SCALE = 32.f, WIN8_SCALE = 64.f, WOUT8_SCALE = 128.f, MIX8_SCALE = 4.f;
constexpr int E8_1 = 0x7f7f7f7f, E8_U = 0x79797979  , E8_V = 0x7c7c7c7c  , E8_W = 0x7a7a7a7a  , E8_WIN = 0x79797979  , E8_WOUT = 0x78787878  , E8_MIX = 0x7d7d7d7d  ;
#ifndef FP8_WQ
#define FP8_WQ 0
#endif
#ifndef FP8_OUT
#define FP8_OUT 1
#endif
#ifndef FP8_INE
#define FP8_INE 1
#endif
#ifndef FP8_INO
#define FP8_INO 1
#endif
constexpr int CW_BAR = 4096;

constexpr int RING_BYTES = 131072;
constexpr int MISC_OFF = 147456 - 256;
constexpr int LDS_BYTES = 147456;
constexpr int NWAVES = 8, NTHR = 512;

typedef __bf16 v2bf __attribute__((ext_vector_type(2)));
__device__ __forceinline__ unsigned pk2(float lo, float hi) { const v2f f = {lo, hi}; return __builtin_bit_cast(unsigned, __builtin_convertvector(f, v2bf)); }
__device__ __forceinline__ float bflo(unsigned w) { return __uint_as_float(w << 16); }
__device__ __forceinline__ float bfhi(unsigned w) { return __uint_as_float(w & 0xffff0000u); }
__device__ __forceinline__ float bf2f(bf16 h) { return __uint_as_float(((unsigned)h) << 16); }
__device__ __forceinline__ void unpack8(const v4u w, float (&f)[8]) {
    f[0] = bflo(w.x); f[1] = bfhi(w.x); f[2] = bflo(w.y); f[3] = bfhi(w.y); f[4] = bflo(w.z); f[5] = bfhi(w.z); f[6] = bflo(w.w); f[7] = bfhi(w.w);
}
__device__ __forceinline__ v4u pack8(const float (&f)[8]) { v4u o; o.x = pk2(f[0], f[1]); o.y = pk2(f[2], f[3]); o.z = pk2(f[4], f[5]); o.w = pk2(f[6], f[7]); return o; }
__device__ __forceinline__ float sigmoidf_(float x) { return __builtin_amdgcn_rcpf(1.0f + __expf(-x)); }
__device__ __forceinline__ float siluf_(float x) { return x * __builtin_amdgcn_rcpf(1.0f + __expf(-x)); }
__device__ __forceinline__ float softplusf_(float x) { return fmaxf(x, 0.f) + log1pf(__expf(-fabsf(x))); }
__device__ __forceinline__ float gelu_tanh(float x) { const float u = 1.5957691216f * (x + 0.044715f * x * x * x); return x * __builtin_amdgcn_rcpf(1.0f + __expf(-u)); }
__device__ __forceinline__ float wave_sum(float v) {
#pragma unroll
    for (int o = 1; o < 64; o <<= 1) v += __shfl_xor(v, o);
    return v;
}
__device__ __forceinline__ float wave_max(float v) {
#pragma unroll
    for (int o = 1; o < 64; o <<= 1) v = fmaxf(v, __shfl_xor(v, o));
    return v;
}
__device__ __forceinline__ float row16_sum(float v) {
    v += __builtin_bit_cast(float, __builtin_amdgcn_update_dpp(0, __builtin_bit_cast(int, v), 0xB1, 0xf, 0xf, true));
    v += __builtin_bit_cast(float, __builtin_amdgcn_update_dpp(0, __builtin_bit_cast(int, v), 0x4E, 0xf, 0xf, true));
    v += __builtin_bit_cast(float, __builtin_amdgcn_update_dpp(0, __builtin_bit_cast(int, v), 0x141, 0xf, 0xf, true));
    v += __builtin_bit_cast(float, __builtin_amdgcn_update_dpp(0, __builtin_bit_cast(int, v), 0x140, 0xf, 0xf, true));
    return v;
}
__device__ __forceinline__ unsigned pk4_fp8(float a, float b, float c, float d) { int w = 0; w = __builtin_amdgcn_cvt_pk_fp8_f32(a, b, w, false); w = __builtin_amdgcn_cvt_pk_fp8_f32(c, d, w, true); return (unsigned)w; }
__device__ __forceinline__ float clamp448(float x) { return fminf(fmaxf(x, -448.f), 448.f); }
#define LDS_BARRIER() asm volatile("s_waitcnt lgkmcnt(0)\n\ts_barrier" ::: "memory")
__device__ __forceinline__ size_t tl_off(size_t t, int c, int ntn) {
    return ((t >> 8) * (size_t)ntn + (size_t)(c >> 8)) * 131072 + (size_t)((((t >> 6) & 1) * 4 + ((c >> 6) & 3)) * 16384) + (size_t)((((((t >> 7) & 1) * 4 + ((t >> 4) & 3)) * 2) + ((c >> 5) & 1)) * 1024)
         + (size_t)((((c >> 3) & 3) * 16 + (t & 15)) * 16) + (size_t)((c & 7) * 2);
}
#define LDS_WAIT() asm volatile("s_waitcnt lgkmcnt(0)" ::: "memory")
#define VM_WAIT() asm volatile("s_waitcnt vmcnt(0)" ::: "memory")
namespace pg8 {
#define PG8_LAS __attribute__((address_space(3)))
typedef unsigned short bf16_t;
typedef short bf16x8 __attribute__((ext_vector_type(8)));
typedef float f32x4 __attribute__((ext_vector_type(4)));
typedef unsigned u32x4 __attribute__((ext_vector_type(4)));
constexpr int BM = 256, BK = 64, HALF = 128, HTB = HALF * BK * 2  , STAGE_BYTES = 8 * HTB, NXCD = 8, WGM = 8;

__host__ __device__ __forceinline__ int lds_byte(int r, int c) { const int st = (r >> 4) * 2 + (c >> 5), rr = r & 15, cc = c & 31, ob = rr * 64 + cc * 2; return st * 1024 + (ob ^ (((ob >> 9) & 1) << 5)); }
__host__ __device__ __forceinline__ void stage_rc(int b, int& R, int& C) { const int st = b / 1024, sb = b % 1024, swz = sb ^ (((sb >> 9) & 1) << 5); R = (st >> 1) * 16 + swz / 64; C = (st & 1) * 32 + (swz % 64) / 2; }
__host__ __device__ __forceinline__ int perm32(int rho) { const int n = rho >> 4, i = rho & 15; return 8 * (i >> 2) + 4 * n + (i & 3); }

struct Unit { int pm, pn; };
struct Gemm { const bf16_t* A; const bf16_t* Bt; int M, N, K; };
typedef int i32x8 __attribute__((ext_vector_type(8)));
typedef int i32x4 __attribute__((ext_vector_type(4)));
__device__ __forceinline__ i32x8 pg8_cat(bf16x8 lo, bf16x8 hi) { const i32x4 a = __builtin_bit_cast(i32x4, lo), b = __builtin_bit_cast(i32x4, hi); return __builtin_shufflevector(a, b, 0, 1, 2, 3, 4, 5, 6, 7); }

struct StaticOrder {
    int nM, nN, nwg, G, c;
    __host__ __device__ void init(int M, int N, int G_, int c_) { nM = M / BM; nN = N / BM; nwg = nM * nN; G = G_; c = c_; }
    __host__ __device__ bool next(int i, Unit& u) const {
        const long L = (long)i * G + c; if (L >= nwg) return false;
        int wgid = (int)L; { const int q = nwg / NXCD, r = nwg % NXCD, xcd = wgid % NXCD, off = wgid / NXCD; wgid = (xcd < r ? xcd * (q + 1) : r * (q + 1) + (xcd - r) * q) + off; }
        const int nig = WGM * nN, gid = wgid / nig, fm = gid * WGM, gsz = (nM - fm) < WGM ? (nM - fm) : WGM;
        u.pm = fm + ((wgid % nig) % gsz); u.pn = (wgid % nig) / gsz; return true;
    }
    __device__ __forceinline__ void a_ready(const Unit&) const {}
    __device__ __forceinline__ void done(const Unit&) const {}
};
struct CountedOrder : StaticOrder {
    const unsigned* ready; unsigned need; unsigned* tmo;
    __device__ __forceinline__ void a_ready(const Unit& u) const {
        if (threadIdx.x < 64) {
            const unsigned long long t0 = __builtin_amdgcn_s_memrealtime(); unsigned polls = 0;
            while ((unsigned)__builtin_amdgcn_readfirstlane(__hip_atomic_load(ready + 64 * u.pm, __ATOMIC_RELAXED, __HIP_MEMORY_SCOPE_AGENT)) < need) {
                if ((++polls & 255u) == 0u && __builtin_amdgcn_readfirstlane(__hip_atomic_load(tmo, __ATOMIC_RELAXED, __HIP_MEMORY_SCOPE_AGENT)) != 0u) break;
                if (__builtin_amdgcn_s_memrealtime() - t0 > 2000000ull) {
                    if (threadIdx.x == 0) { unsigned expect = 0u; __hip_atomic_compare_exchange_strong(tmo + 1, &expect, 0x600u | (unsigned)(u.pm & 0xff), __ATOMIC_RELAXED, __ATOMIC_RELAXED, __HIP_MEMORY_SCOPE_AGENT); __hip_atomic_store(tmo, 1u, __ATOMIC_RELAXED, __HIP_MEMORY_SCOPE_AGENT); }
                    break; }
                __builtin_amdgcn_s_sleep(2); }
            __builtin_amdgcn_fence(__ATOMIC_ACQUIRE, "agent");
            asm volatile("s_waitcnt vmcnt(0)" ::: "memory");
        }
#if !defined(BROKEN_HOOK_NO_BARRIER)
        asm volatile("" ::: "memory"); __builtin_amdgcn_s_barrier(); asm volatile("" ::: "memory");
#endif
    }
};

__device__ __forceinline__ unsigned cvt_pk_bf16(float lo, float hi) { unsigned r; asm volatile("v_cvt_pk_bf16_f32 %0, %1, %2" : "=v"(r) : "v"(lo), "v"(hi)); return r; }
typedef float f32x2 __attribute__((ext_vector_type(2)));
__device__ __forceinline__ f32x2 gelu_pk(f32x2 v) {
    const f32x2 av = __builtin_elementwise_abs(v), d = av * 0.2316418882f + 1.0f;
    f32x2 t; t.x = __builtin_amdgcn_rcpf(d.x); t.y = __builtin_amdgcn_rcpf(d.y);
    f32x2 q = t * 0.5307027145f + (-0.7265760135f); q = q * t + 0.7107068705f; q = q * t + (-0.142248368f); q = q * t + 0.127414796f; q = q * t;
    const f32x2 s = (v * v) * (-0.72134752044f);
    f32x2 e; e.x = __builtin_amdgcn_exp2f(s.x); e.y = __builtin_amdgcn_exp2f(s.y);
    const f32x2 m = v * (q * e), r = v - m;
    f32x2 o; o.x = v.x < 0.f ? m.x : r.x; o.y = v.y < 0.f ? m.y : r.y; return o;
}

struct EpiF32 {
    static constexpr bool PERM = false, AFTER_DRAIN = false;
    float* C; int ldc; const float* bias;
    __device__ __forceinline__ void operator()(const f32x4 (&acc)[2][2][4][2], const Unit& u, int wr, int wc, int fr, int fq) const {
        const int row0 = u.pm * BM + wr * 64 + fr, col0 = u.pn * BM + wc * 32 + 4 * fq;
        f32x4 bv[2][2];
#pragma unroll
        for (int bj = 0; bj < 2; ++bj)
#pragma unroll
            for (int n = 0; n < 2; ++n) bv[bj][n] = bias ? *(const f32x4*)(bias + col0 + bj * HALF + n * 16) : (f32x4){0.f, 0.f, 0.f, 0.f};
#pragma unroll
        for (int ai = 0; ai < 2; ++ai)
#pragma unroll
            for (int m = 0; m < 4; ++m) { float* rowp = C + (size_t)(row0 + ai * HALF + m * 16) * ldc + col0;
#pragma unroll
                for (int bj = 0; bj < 2; ++bj)
#pragma unroll
                    for (int n = 0; n < 2; ++n) *(f32x4*)(rowp + bj * HALF + n * 16) = acc[ai][bj][m][n] + bv[bj][n]; }
    }
};
template <int ACT  > struct EpiBf16 {
    static constexpr bool PERM = true, AFTER_DRAIN = false;
    bf16_t* O; int ldc; const float* bias; int split_cols; size_t split_stride;
    __device__ __forceinline__ void operator()(const f32x4 (&acc)[2][2][4][2], const Unit& u, int wr, int wc, int fr, int fq) const {
        const int row0 = u.pm * BM + wr * 64 + fr; int colt = u.pn * BM; bf16_t* base = O;
        if (split_cols) { const int t = colt / split_cols; base += (size_t)t * split_stride; colt -= t * split_cols; }
        const int col0 = colt + wc * 64 + 8 * fq, bcol0 = u.pn * BM + wc * 64 + 8 * fq;
        f32x4 bv[2][2];
#pragma unroll
        for (int bj = 0; bj < 2; ++bj)
#pragma unroll
            for (int n = 0; n < 2; ++n) bv[bj][n] = bias ? *(const f32x4*)(bias + bcol0 + bj * 32 + 4 * n) : (f32x4){0.f, 0.f, 0.f, 0.f};
#pragma unroll
        for (int ai = 0; ai < 2; ++ai)
#pragma unroll
            for (int m = 0; m < 4; ++m) { bf16_t* rowp = base + (size_t)(row0 + ai * HALF + m * 16) * ldc + col0;
#pragma unroll
                for (int bj = 0; bj < 2; ++bj) { f32x4 v0 = acc[ai][bj][m][0] + bv[bj][0], v1 = acc[ai][bj][m][1] + bv[bj][1];
                    if (ACT == 1) { f32x2 a = gelu_pk((f32x2){v0[0], v0[1]}), b = gelu_pk((f32x2){v0[2], v0[3]}), c = gelu_pk((f32x2){v1[0], v1[1]}), d = gelu_pk((f32x2){v1[2], v1[3]});
                        v0 = (f32x4){a.x, a.y, b.x, b.y}; v1 = (f32x4){c.x, c.y, d.x, d.y}; }
                    if (ACT == 2) {
#pragma unroll
                        for (int j = 0; j < 4; ++j) { v0[j] = 0.5f * v0[j] * (1.0f + erff(v0[j] * 0.70710678f)); v1[j] = 0.5f * v1[j] * (1.0f + erff(v1[j] * 0.70710678f)); } }
                    u32x4 w; w.x = cvt_pk_bf16(v0[0], v0[1]); w.y = cvt_pk_bf16(v0[2], v0[3]); w.z = cvt_pk_bf16(v1[0], v1[1]); w.w = cvt_pk_bf16(v1[2], v1[3]);
#ifdef NT_STORES
                    __builtin_nontemporal_store(w, (u32x4*)(rowp + bj * 32)); } }
#else
                    *(u32x4*)(rowp + bj * 32) = w; } }
#endif
    }
};
template <class Epi, class Sched, bool STAMP = false, bool FP8 = false, int SW = 0x7f7f7f7f, int SX = 0x7f7f7f7f>
__device__ __forceinline__ void gemm_phase(PG8_LAS unsigned char* lds, const Gemm g, const Sched& S, const Epi& E, unsigned long long* stamps) {
    const int tid = threadIdx.x, wid = __builtin_amdgcn_readfirstlane(tid >> 6), lane = tid & 63, wr = wid >> 2, wc = wid & 3, fr = lane & 15, fq = lane >> 4;
    const int K = g.K, nt = K / BK;
    int ts_lo = 0, ts_hi = 0, nts = 0; const unsigned long long rt_entry = STAMP ? (unsigned long long)wall_clock64() : 0ull;
#define PG8_STAMP() do { if (STAMP && wid == 0 && nts < 64) { const unsigned long long _c = (unsigned long long)clock64(); \
        ts_lo = (lane == nts) ? (int)(unsigned)_c : ts_lo; ts_hi = (lane == nts) ? (int)(unsigned)(_c >> 32) : ts_hi; ++nts; } } while (0)
    PG8_STAMP();
    unsigned voffA[2], voffB[2];
#pragma unroll
    for (int i = 0; i < 2; ++i) { int R, C; stage_rc(tid * 16 + i * 8192, R, C); const int Rb = Epi::PERM ? (64 * (R >> 5) + perm32(R & 31)) : R;
        voffA[i] = (unsigned)(R * K + C) * 2u; voffB[i] = (unsigned)(Rb * K + C) * 2u; }
    const size_t kstep = (size_t)(BK * 2);
    const size_t hstep = (size_t)HALF * K * 2;
    const size_t hstepB = Epi::PERM ? (size_t)32 * K * 2 : hstep;
    const size_t tstep = 2 * hstep;
    const unsigned ldsw = (unsigned)wid * 1024u;
    const int aoff = lds_byte(wr * 64 + fr, fq * 8), boff = lds_byte(wc * 32 + fr, fq * 8);
#define PG8_SA(b, h) (((b) * 2 + (h)) * HTB)
#define PG8_SB(b, h) ((4 + (b) * 2 + (h)) * HTB)
#define PG8_STAGE(bufoff, gbase, voff) do { _Pragma("unroll") for (int _i = 0; _i < 2; ++_i) \
        __builtin_amdgcn_global_load_lds((const unsigned*)((const char*)(gbase) + (voff)[_i]), (PG8_LAS unsigned*)(lds + (bufoff) + ldsw + _i * 8192), 16, 0, 0); } while (0)
#define PG8_LDA(dst, b, h) do { _Pragma("unroll") for (int m = 0; m < 4; ++m) _Pragma("unroll") for (int k = 0; k < 2; ++k) dst[m][k] = *(const PG8_LAS bf16x8*)(lds + PG8_SA(b, h) + aoff + m * 2048 + k * 1024); } while (0)
#define PG8_LDB(dst, b, h) do { _Pragma("unroll") for (int n = 0; n < 2; ++n) _Pragma("unroll") for (int k = 0; k < 2; ++k) dst[n][k] = *(const PG8_LAS bf16x8*)(lds + PG8_SB(b, h) + boff + n * 2048 + k * 1024); } while (0)
#define PG8_MMA(ai, bj, At, Bt) do { __builtin_amdgcn_s_setprio(1); _Pragma("unroll") for (int m = 0; m < 4; ++m) _Pragma("unroll") for (int n = 0; n < 2; ++n) { \
        if constexpr (FP8) { asm volatile("v_mfma_scale_f32_16x16x128_f8f6f4 %0, %1, %2, %0, %3, %4 op_sel_hi:[0,0,0]" : "+v"(acc[ai][bj][m][n]) : "v"(pg8_cat(Bt[n][0], Bt[n][1])), "v"(pg8_cat(At[m][0], At[m][1])), "v"(SW), "v"(SX)); } \
        else { _Pragma("unroll") for (int k = 0; k < 2; ++k) acc[ai][bj][m][n] = __builtin_amdgcn_mfma_f32_16x16x32_bf16(Bt[n][k], At[m][k], acc[ai][bj][m][n], 0, 0, 0); } } __builtin_amdgcn_s_setprio(0); } while (0)
#define PG8_WAIT_V(n) asm volatile("s_waitcnt vmcnt(" #n ")" ::: "memory")
#define PG8_WAIT_L(n) asm volatile("s_waitcnt lgkmcnt(" #n ")" ::: "memory")
#define PG8_BAR __builtin_amdgcn_s_barrier()
#define PG8_SCHED __builtin_amdgcn_sched_barrier(0)
    Unit cur, nxt; int ui = 0;
    if (!S.next(0, cur)) return;
    f32x4 acc[2][2][4][2];
#pragma unroll
    for (int a = 0; a < 2; ++a)
#pragma unroll
        for (int b = 0; b < 2; ++b)
#pragma unroll
            for (int m = 0; m < 4; ++m)
#pragma unroll
                for (int n = 0; n < 2; ++n) acc[a][b][m][n] = (f32x4){0.f, 0.f, 0.f, 0.f};
    bf16x8 At[4][2], B0[2][2], B1[2][2];
    const char* cA = (const char*)g.A + (size_t)cur.pm * tstep; const char* cB = (const char*)g.Bt + (size_t)cur.pn * tstep;
    S.a_ready(cur);
    PG8_STAGE(PG8_SB(0, 0), cB, voffB); PG8_STAGE(PG8_SA(0, 0), cA, voffA); PG8_STAGE(PG8_SB(0, 1), cB + hstepB, voffB); PG8_STAGE(PG8_SA(0, 1), cA + hstep, voffA);
    if (wr == 1) PG8_BAR;
    PG8_WAIT_V(4); PG8_BAR;
    PG8_STAGE(PG8_SB(1, 0), cB + kstep, voffB); PG8_STAGE(PG8_SA(1, 0), cA + kstep, voffA); PG8_STAGE(PG8_SB(1, 1), cB + hstepB + kstep, voffB);
    PG8_WAIT_V(6); PG8_BAR;
    PG8_STAMP();
    for (;;) {
        const bool has_next = S.next(ui + 1, nxt);
        const char* nA = has_next ? (const char*)g.A + (size_t)nxt.pm * tstep : cA; const char* nB = has_next ? (const char*)g.Bt + (size_t)nxt.pn * tstep : cB;
        for (int t = 0; t < nt; t += 2) {
            const bool last = (t == nt - 2);
            const char* a1 = cA + (size_t)(t + 1) * kstep;
            const char* a2 = last ? nA : cA + (size_t)(t + 2) * kstep; const char* b2 = last ? nB : cB + (size_t)(t + 2) * kstep;
            const char* a3 = a2 + kstep; const char* b3 = b2 + kstep;
            if (last && has_next) S.a_ready(nxt);
            PG8_LDB(B0, 0, 0); PG8_SCHED; PG8_LDA(At, 0, 0); PG8_STAGE(PG8_SA(1, 1), a1 + hstep, voffA);
            PG8_WAIT_L(8); PG8_BAR; PG8_WAIT_L(0); PG8_MMA(0, 0, At, B0); PG8_BAR; PG8_SCHED;
            PG8_LDB(B1, 0, 1); PG8_STAGE(PG8_SB(0, 0), b2, voffB);
            PG8_BAR; PG8_WAIT_L(0); PG8_MMA(0, 1, At, B1); PG8_BAR;
            PG8_LDA(At, 0, 1); PG8_STAGE(PG8_SA(0, 0), a2, voffA);
            PG8_BAR; PG8_WAIT_L(0); PG8_MMA(1, 0, At, B0); PG8_BAR; PG8_SCHED;
            PG8_STAGE(PG8_SB(0, 1), b2 + hstepB, voffB);
            PG8_WAIT_V(6); PG8_BAR; PG8_MMA(1, 1, At, B1); PG8_BAR;
            PG8_LDB(B0, 1, 0); PG8_SCHED; PG8_LDA(At, 1, 0); PG8_STAGE(PG8_SA(0, 1), a2 + hstep, voffA);
            PG8_WAIT_L(8); PG8_BAR; PG8_WAIT_L(0); PG8_MMA(0, 0, At, B0); PG8_BAR; PG8_SCHED;
            PG8_LDB(B1, 1, 1); PG8_STAGE(PG8_SB(1, 0), b3, voffB);
            PG8_BAR; PG8_WAIT_L(0); PG8_MMA(0, 1, At, B1); PG8_BAR;
            PG8_LDA(At, 1, 1); PG8_STAGE(PG8_SA(1, 0), a3, voffA);
            PG8_BAR; PG8_WAIT_L(0); PG8_MMA(1, 0, At, B0); PG8_BAR; PG8_SCHED;
            PG8_STAGE(PG8_SB(1, 1), b3 + hstepB, voffB);
            PG8_WAIT_V(6); PG8_BAR; PG8_MMA(1, 1, At, B1); PG8_BAR;
        }
        PG8_STAMP();
        if constexpr (FP8) asm volatile("s_nop 15\n\ts_nop 15" ::: "memory");
        if constexpr (!Epi::AFTER_DRAIN) { E(acc, cur, wr, wc, fr, fq); S.done(cur); }
        PG8_STAMP();
        if (!has_next) break;
#pragma unroll
        for (int a = 0; a < 2; ++a)
#pragma unroll
            for (int b = 0; b < 2; ++b)
#pragma unroll
                for (int m = 0; m < 4; ++m)
#pragma unroll
                    for (int n = 0; n < 2; ++n) acc[a][b][m][n] = (f32x4){0.f, 0.f, 0.f, 0.f};
        cur = nxt; cA = nA; cB = nB; ++ui;
    }
    PG8_WAIT_V(0);
    if (wr == 0) PG8_BAR;
    PG8_BAR;
    if constexpr (Epi::AFTER_DRAIN) { E.fused(acc, cur, wr, wc, fr, fq, lds, wid, lane); S.done(cur); }
    PG8_STAMP();
    if (STAMP && wid == 0) { stamps[lane] = lane < nts ? (((unsigned long long)(unsigned)ts_hi << 32) | (unsigned)ts_lo) : 0ull;
        if (lane == 62) stamps[62] = rt_entry; if (lane == 63) stamps[63] = (unsigned long long)wall_clock64(); }
#undef PG8_STAMP
#undef PG8_SA
#undef PG8_SB
#undef PG8_STAGE
#undef PG8_LDA
#undef PG8_LDB
#undef PG8_MMA
#undef PG8_WAIT_V
#undef PG8_WAIT_L
#undef PG8_BAR
#undef PG8_SCHED
}
}
#define XB_TMO      128
#define XB_XCNT(j)  (256  + 64 * (j))
#define XB_XSUB(j)  (1280 + 64 * (j))
#define XB_XGEN(j)  (2304 + 64 * (j))
#define XB_TOP      3328
#define XB_TOPGEN   3392
#define XCD_BAR_WORDS 3456
#define XB_SPIN_CAP (1u << 18)

__device__ __forceinline__ unsigned xb_ld(unsigned* p)              { return __hip_atomic_load(p, __ATOMIC_RELAXED, __HIP_MEMORY_SCOPE_AGENT); }
__device__ __forceinline__ unsigned xb_add(unsigned* p, unsigned v) { return __hip_atomic_fetch_add(p, v, __ATOMIC_RELAXED, __HIP_MEMORY_SCOPE_AGENT); }
__device__ __forceinline__ unsigned xb_xcc_id() { return (unsigned)__builtin_amdgcn_s_getreg((3 << 11) | 20) & 0xFu; }
#define XB_SPIN(cond, bar) do { unsigned _sp = 0; while (cond) { __builtin_amdgcn_s_sleep(1); \
    if ((++_sp & 255u) == 0u) { if (xb_ld(&(bar)[XB_TMO])) break; if (_sp > XB_SPIN_CAP) { atomicAdd(&(bar)[XB_TMO], 1u); break; } } } } while (0)

struct XcdBarrier {
    unsigned* bar; unsigned x;
    volatile LAS unsigned* st;
};

__device__ __forceinline__ XcdBarrier xcd_barrier_post(unsigned* bar, volatile LAS unsigned* st) {
    XcdBarrier b; b.bar = bar; b.x = xb_xcc_id(); b.st = st;
    if (threadIdx.x == 0) (void)xb_add(&bar[XB_XCNT(b.x)], 1u);
    return b;
}
__device__ __forceinline__ void xcd_barrier_complete(unsigned* bar, unsigned x, unsigned& nloc, unsigned& nx) {
    const unsigned G = gridDim.x * gridDim.y * gridDim.z;
    unsigned sum, cnt, mine, sp = 0u;
    for (;;) {
        sum = 0u; cnt = 0u; mine = 0u;
#pragma unroll
        for (unsigned j = 0; j < 16; ++j) { const unsigned c = xb_ld(&bar[XB_XCNT(j)]); sum += c; cnt += (c > 0u) ? 1u : 0u; mine = (j == x) ? c : mine; }
        if (sum == G) break;
        __builtin_amdgcn_s_sleep(1);
        if ((++sp & 255u) == 0u) { if (xb_ld(&bar[XB_TMO])) break; if (sp > XB_SPIN_CAP) { atomicAdd(&bar[XB_TMO], 1u); break; } }
    }
    nloc = mine > 0u ? mine : 1u; nx = cnt > 0u ? cnt : 1u;
}

__device__ __forceinline__ void xcd_barrier(const XcdBarrier& b) {
    asm volatile("s_waitcnt vmcnt(0)" ::: "memory");
    __syncthreads();
    if (threadIdx.x == 0) {
        unsigned* bar = b.bar;
        __builtin_amdgcn_s_waitcnt(0);
        unsigned nloc = b.st[0], nx = b.st[1];
        if (nloc == 0u) { xcd_barrier_complete(bar, b.x, nloc, nx); b.st[0] = nloc; b.st[1] = nx; }
        const unsigned old = xb_add(&bar[XB_XSUB(b.x)], 1u);
        const unsigned gen = old / nloc;
        if (old + 1u == (gen + 1u) * nloc) {
            __builtin_amdgcn_fence(__ATOMIC_RELEASE, "agent");
            asm volatile("s_waitcnt vmcnt(0)" ::: "memory");
            const unsigned og = xb_add(&bar[XB_TOP], 1u);
            const unsigned tg = og / nx;
            if (og + 1u == (tg + 1u) * nx) xb_add(&bar[XB_TOPGEN], 1u);
            else XB_SPIN(xb_ld(&bar[XB_TOPGEN]) == tg, bar);
            __builtin_amdgcn_fence(__ATOMIC_ACQUIRE, "agent");
            xb_add(&bar[XB_XGEN(b.x)], 1u);
            asm volatile("s_waitcnt vmcnt(0)" ::: "memory");
        } else {
            XB_SPIN(xb_ld(&bar[XB_XGEN(b.x)]) == gen, bar);
            __builtin_amdgcn_fence(__ATOMIC_ACQUIRE, "agent");
            asm volatile("s_waitcnt vmcnt(0)" ::: "memory");
        }
    }
    __syncthreads();
}

struct Args { const float* in[34]; float* out; unsigned char* ws; int ph_lo, ph_hi; };
struct Frame { LAS unsigned char* lds; int tid, lane, wave, G, bid; };

#define MFMA16(a, b, c) __builtin_amdgcn_mfma_f32_16x16x32_bf16((a), (b), (c), 0, 0, 0)

struct TrDesc { const float* src; unsigned char* dst; int ldw, K, fp8, nvalid; float sc; };
__device__ __forceinline__ void tr_load(const TrDesc& d, int lane, v4f (&v)[16]) {
    const unsigned long long sp = (unsigned long long)d.src;
    unsigned long long pa = ((unsigned long long)(unsigned)__builtin_amdgcn_readfirstlane((int)(sp >> 32)) << 32) | (unsigned)__builtin_amdgcn_readfirstlane((int)sp);
    const int ldw = __builtin_amdgcn_readfirstlane(d.ldw);
    if (__builtin_amdgcn_readfirstlane(d.fp8)) {
        const unsigned long long step = (unsigned long long)(8 * ldw) * 4ull; const size_t lo = (size_t)(lane >> 3) * ldw + 4 * (lane & 7);
#pragma unroll
        for (int i = 0; i < 16; ++i) { asm volatile("" : "+s"(pa)); v[i] = *(const v4f*)((const float*)pa + lo); pa += step; }
    } else {
        const unsigned long long step = (unsigned long long)(4 * ldw) * 4ull; const size_t lo = (size_t)(lane >> 4) * ldw + 4 * (lane & 15);
#pragma unroll
        for (int i = 0; i < 16; ++i) { asm volatile("" : "+s"(pa)); v[i] = *(const v4f*)((const float*)pa + lo); pa += step; }
    }
}
__device__ __forceinline__ void tr_store(const TrDesc& d, int lane, const v4f (&v)[16], LAS float* scr) {
    if (d.fp8) {
        { LAS float* w = scr + (lane >> 3) * 33 + 4 * (lane & 7);
#pragma unroll
          for (int i = 0; i < 16; ++i) { w[(8 * i) * 33 + 0] = v[i].x; w[(8 * i) * 33 + 1] = v[i].y; w[(8 * i) * 33 + 2] = v[i].z; w[(8 * i) * 33 + 3] = v[i].w; } }
        LDS_WAIT(); asm volatile("" ::: "memory");
        const int c = lane & 7; const float sc = d.sc;
#pragma unroll
        for (int j = 0; j < 4; ++j) { const int n = (lane >> 3) + 8 * j; const LAS float* s = scr + (16 * c) * 33 + n;
            v4u o; o.x = pk4_fp8(s[0 * 33] * sc, s[1 * 33] * sc, s[2 * 33] * sc, s[3 * 33] * sc); o.y = pk4_fp8(s[4 * 33] * sc, s[5 * 33] * sc, s[6 * 33] * sc, s[7 * 33] * sc);
            o.z = pk4_fp8(s[8 * 33] * sc, s[9 * 33] * sc, s[10 * 33] * sc, s[11 * 33] * sc); o.w = pk4_fp8(s[12 * 33] * sc, s[13 * 33] * sc, s[14 * 33] * sc, s[15 * 33] * sc);
            *(v4u*)(d.dst + (size_t)n * d.K + 16 * c) = o; }
    } else {
        { LAS float* w = scr + (lane >> 4) * 65 + 4 * (lane & 15);
#pragma unroll
          for (int i = 0; i < 16; ++i) { w[(4 * i) * 65 + 0] = v[i].x; w[(4 * i) * 65 + 1] = v[i].y; w[(4 * i) * 65 + 2] = v[i].z; w[(4 * i) * 65 + 3] = v[i].w; } }
        LDS_WAIT(); asm volatile("" ::: "memory");
        const int c = lane & 7;
#pragma unroll
        for (int j = 0; j < 8; ++j) { const int n = (lane >> 3) + 8 * j; const LAS float* s = scr + (8 * c) * 65 + n;
            v4u o; o.x = pk2(s[0 * 65], s[1 * 65]); o.y = pk2(s[2 * 65], s[3 * 65]); o.z = pk2(s[4 * 65], s[5 * 65]); o.w = pk2(s[6 * 65], s[7 * 65]);
            if (n < d.nvalid) *(v4u*)(d.dst + ((size_t)n * d.K + 8 * c) * 2) = o; }
    }
    LDS_WAIT(); asm volatile("" ::: "memory");
}
constexpr int I_E1 = 64 * 128, I_E2 = 64 * 64, I_AB = 64, I_OE = 64 * 64, I_IO = 64 * 112, I_OO = 48 * 64, I_WQ = 64 * 32, I_GL = 16 * 16, I_RG = 128, I_V = 256 * 64;
constexpr int TR_N0 = I_E1 + I_E2 + I_AB, TR_N1 = I_OE + I_WQ + I_GL + I_RG + I_V, TR_N2 = I_IO + I_OO + I_WQ + I_V;
__device__ __forceinline__ TrDesc tr_decode(const Args& a, const int part, int r) {
    unsigned char* ws = a.ws; TrDesc d;
#define TR_MK(W_, ldw_, scol0_, K_, dst_, fp8_, drow0_, r_, nblk64_, sc_, nv_) do { const int r__ = (r_), nbk__ = (fp8_) ? (nblk64_) * 2 : (nblk64_), kb__ = r__ / nbk__, nb__ = r__ % nbk__, kt__ = (fp8_) ? 128 : 64, nt__ = (fp8_) ? 32 : 64; \
        d.src = (W_) + (size_t)(kt__ * kb__) * (ldw_) + (scol0_) + nt__ * nb__; d.ldw = (ldw_); d.K = (K_); d.fp8 = (fp8_); d.sc = (sc_); d.nvalid = (nv_); \
        d.dst = (unsigned char*)(dst_) + ((size_t)((drow0_) + nt__ * nb__) * (K_) + kt__ * kb__) * ((fp8_) ? 1 : 2); return d; } while (0)
    if (part == 0) {
        if (r < I_E1) TR_MK(a.in[1], EVEN_IN_SRC, 0, DM, ws + WS_WINE, FP8_INE, 0, r, 128, WIN8_SCALE, 64); r -= I_E1;
        if (r < I_E2) TR_MK(a.in[1], EVEN_IN_SRC, 8224, DM, ws + WS_WINE, FP8_INE, 8192, r, 64, WIN8_SCALE, 64); r -= I_E2;
        TR_MK(a.in[1], EVEN_IN_SRC, 8192, DM, ws + WS_WAB, 0, 0, r, 1, 1.f, 32);
    } else if (part == 1) {
        if (r < I_OE) TR_MK(a.in[13], DM, 0, DM, ws + WS_WOUTE, FP8_OUT, 0, r, 64, WOUT8_SCALE, 64); r -= I_OE;
        if (r < I_WQ) TR_MK(a.in[28], PQ, 0, DM, ws + WS_WQ0, FP8_WQ, 0, r, 32, WIN8_SCALE, 64); r -= I_WQ;
        if (r < I_GL) TR_MK(a.in[23], S5W, 0, S5W, ws + WS_GLU, 0, 0, r, 16, 1.f, 64); r -= I_GL;
        if (r < I_RG) { const int n = r >> 3, which = (r >> 2) & 1; TR_MK((which ? a.in[10] : a.in[8]) + (size_t)n * RGB * RGB, RGB, 0, RGB, ws + WS_RGW + (size_t)n * 256 * RGB * 2, 0, which * 128, r & 3, 2, 1.f, 64); } r -= I_RG;
        TR_MK(a.in[31], DM, 0, PE, ws + WS_VT8_0, 1, 0, r, 64, V8_SCALE, 64);
    } else {
        if (r < I_IO) TR_MK(a.in[14], ODD_IN, 0, DM, ws + WS_WINO, FP8_INO, 0, r, 112, WIN8_SCALE, 64); r -= I_IO;
        if (r < I_OO) TR_MK(a.in[25], DM, 0, ODD_MIX, ws + WS_WOUTO, FP8_OUT, 0, r, 64, WOUT8_SCALE, 64); r -= I_OO;
        if (r < I_WQ) TR_MK(a.in[28] + (size_t)DM * PQ, PQ, 0, DM, ws + WS_WQ1, FP8_WQ, 0, r, 32, WIN8_SCALE, 64); r -= I_WQ;
        TR_MK(a.in[31] + (size_t)PE * DM, DM, 0, PE, ws + WS_VT8_1, 1, 0, r, 64, V8_SCALE, 64);
    }
#undef TR_MK
}
__device__ __forceinline__ void p0_prologue(const Args& a, Frame& F, const int part) {
    unsigned char* ws = a.ws;
    LAS float* scr = (LAS float*)(F.lds + F.wave * 16896);
    const int gw = F.bid * NWAVES + F.wave, NGW = F.G * NWAVES;
#ifndef REP_TR
#define REP_TR 1
#endif
#ifndef REP_ST
#define REP_ST 1
#endif
    _Pragma("unroll 1") for (int rp_ = 0; rp_ < REP_TR; ++rp_)
    {   const int it_hi = part == 0 ? TR_N0 : (part == 1 ? TR_N1 : TR_N2);
        v4f v[16], nv[16]; TrDesc d = tr_decode(a, part, gw < it_hi ? gw : 0), nd = d;
        if (gw < it_hi) tr_load(d, F.lane, v);
        for (int it = gw; it < it_hi; it += NGW) {
            const bool more = it + NGW < it_hi;
            if (more) { nd = tr_decode(a, part, it + NGW); tr_load(nd, F.lane, nv); }
            tr_store(d, F.lane, v, scr);
            d = nd;
#pragma unroll
            for (int i = 0; i < 16; ++i) v[i] = nv[i];
        }
    }
    const size_t gtid = (size_t)F.bid * NTHR + F.tid, gsize = (size_t)F.G * NTHR;
    _Pragma("unroll 1") for (int rp_ = 0; rp_ < REP_ST; ++rp_) {
    if (part == 0)
    {
        const float* xs = a.in[0]; bf16* xb = (bf16*)(ws + WS_XB0); unsigned char* x8 = ws + WS_X8_0;
        const size_t n16 = (size_t)NTOK * DM / 16;
        for (size_t i = gtid; i < n16; i += 2 * gsize) {
            v4f f[2][4];
#pragma unroll
            for (int u = 0; u < 2; ++u) { const size_t ii = i + u * gsize; if (ii < n16) {
#pragma unroll
                for (int j = 0; j < 4; ++j) f[u][j] = *(const v4f*)(xs + 16 * ii + 4 * j); } }
#pragma unroll
            for (int u = 0; u < 2; ++u) { const size_t ii = i + u * gsize; if (ii < n16) {
                v4u o0, o1; o0.x = pk2(f[u][0].x, f[u][0].y); o0.y = pk2(f[u][0].z, f[u][0].w); o0.z = pk2(f[u][1].x, f[u][1].y); o0.w = pk2(f[u][1].z, f[u][1].w);
                o1.x = pk2(f[u][2].x, f[u][2].y); o1.y = pk2(f[u][2].z, f[u][2].w); o1.z = pk2(f[u][3].x, f[u][3].y); o1.w = pk2(f[u][3].z, f[u][3].w);
                *(v4u*)(xb + 16 * ii) = o0; *(v4u*)(xb + 16 * ii + 8) = o1;
                if (FP8_INE) { v4u o; o.x = pk4_fp8(f[u][0].x, f[u][0].y, f[u][0].z, f[u][0].w); o.y = pk4_fp8(f[u][1].x, f[u][1].y, f[u][1].z, f[u][1].w); o.z = pk4_fp8(f[u][2].x, f[u][2].y, f[u][2].z, f[u][2].w); o.w = pk4_fp8(f[u][3].x, f[u][3].y, f[u][3].z, f[u][3].w);
                    *(v4u*)(x8 + 16 * ii) = o; } } }
        }
    }
    if (part == 1)
    {
        const float* ks = a.in[29]; bf16* kh = (bf16*)(ws + WS_KH); bf16* kl = (bf16*)(ws + WS_KL);
        for (size_t i = gtid; i < (size_t)2 * PH * 2 * PNK * PHALF / 8; i += gsize) { const v4f x = *(const v4f*)(ks + 8 * i), y = *(const v4f*)(ks + 8 * i + 4);
            v4u h; h.x = pk2(x.x, x.y); h.y = pk2(x.z, x.w); h.z = pk2(y.x, y.y); h.w = pk2(y.z, y.w);
            v4u l; l.x = pk2(x.x - bflo(h.x), x.y - bfhi(h.x)); l.y = pk2(x.z - bflo(h.y), x.w - bfhi(h.y)); l.z = pk2(y.x - bflo(h.z), y.y - bfhi(h.z)); l.w = pk2(y.z - bflo(h.w), y.w - bfhi(h.w));
            const size_t blk = i >> 11; const int n = (int)(i >> 4) & 127, d8 = (int)i & 15; const size_t j = (blk << 11) + (size_t)((((n >> 4) * 4 + (d8 >> 2)) * 64) + (d8 & 3) * 16 + (n & 15));
            *(v4u*)(kh + 8 * j) = h; *(v4u*)(kl + 8 * j) = l; }
    }
    if (part >= 1)
    {
        const float* us = a.in[30] + (size_t)(part - 1) * PE * DM; unsigned char* u8 = ws + (part == 1 ? WS_U8_0 : WS_U8_1);
        const size_t n16 = (size_t)PE * DM / 16; const float sc = U8_SCALE;
        for (size_t i = gtid; i < n16; i += 4 * gsize) {
            v4f f[4][4];
#pragma unroll
            for (int u = 0; u < 4; ++u) { const size_t ii = i + u * gsize; if (ii < n16) {
#pragma unroll
                for (int j = 0; j < 4; ++j) f[u][j] = *(const v4f*)(us + 16 * ii + 4 * j); } }
#pragma unroll
            for (int u = 0; u < 4; ++u) { const size_t ii = i + u * gsize; if (ii < n16) {
                v4u o; o.x = pk4_fp8(f[u][0].x * sc, f[u][0].y * sc, f[u][0].z * sc, f[u][0].w * sc); o.y = pk4_fp8(f[u][1].x * sc, f[u][1].y * sc, f[u][1].z * sc, f[u][1].w * sc);
                o.z = pk4_fp8(f[u][2].x * sc, f[u][2].y * sc, f[u][2].z * sc, f[u][2].w * sc); o.w = pk4_fp8(f[u][3].x * sc, f[u][3].y * sc, f[u][3].z * sc, f[u][3].w * sc);
                *(v4u*)(u8 + 16 * ii) = o; } }
        }
    }
    }
}

__device__ __forceinline__ void gdn_prep_phase(const Args& a, Frame& F) {
    const bf16* proj = (const bf16*)(a.ws + WS_HB);
    bf16* qkvn = (bf16*)(a.ws + WS_WB);
    const float* cw = a.in[2];
    const int gw = F.bid * NWAVES + F.wave, NGW = F.G * NWAVES;
    for (int it = gw; it < 12 * 512; it += NGW) {
        const int tg = it / 12, j = it % 12, c0 = j * 512 + F.lane * 8, t0 = tg * 16;
        float w[4][8];
#pragma unroll
        for (int k = 0; k < 4; ++k) { const v4f w0 = *(const v4f*)(cw + k * 6144 + c0), w1 = *(const v4f*)(cw + k * 6144 + c0 + 4);
            w[k][0] = w0.x; w[k][1] = w0.y; w[k][2] = w0.z; w[k][3] = w0.w; w[k][4] = w1.x; w[k][5] = w1.y; w[k][6] = w1.z; w[k][7] = w1.w; }
        float xm3[8], xm2[8], xm1[8], xc[8];
        if ((t0 & (SEQ - 1)) == 0) {
#pragma unroll
            for (int e = 0; e < 8; ++e) { xm3[e] = 0.f; xm2[e] = 0.f; xm1[e] = 0.f; }
        } else {
            unpack8(*(const v4u*)(proj + (size_t)(t0 - 3) * EVEN_IN + c0), xm3);
            unpack8(*(const v4u*)(proj + (size_t)(t0 - 2) * EVEN_IN + c0), xm2);
            unpack8(*(const v4u*)(proj + (size_t)(t0 - 1) * EVEN_IN + c0), xm1);
        }
        bf16* dst = qkvn + (size_t)(j >> 2) * NTOK * GW + (size_t)(j & 3) * 512 + F.lane * 8;
        v4u rw[16];
#pragma unroll
        for (int i = 0; i < 16; ++i) rw[i] = *(const v4u*)(proj + (size_t)(t0 + i) * EVEN_IN + c0);
#pragma unroll
        for (int i = 0; i < 16; ++i) {
            const int t = t0 + i;
            unpack8(rw[i], xc);
            float y[8]; float ss = 0.f;
#pragma unroll
            for (int e = 0; e < 8; ++e) { float v = w[0][e] * xm3[e] + w[1][e] * xm2[e] + w[2][e] * xm1[e] + w[3][e] * xc[e]; v = siluf_(v); y[e] = v; ss += v * v; }
            if (j < 8) {
                ss = row16_sum(ss);
                float r = rsqrtf(ss + RMS_EPS); if (j < 4) r *= 0.08838834764831845f;
#pragma unroll
                for (int e = 0; e < 8; ++e) y[e] *= r;
            }
            *(v4u*)(dst + (size_t)t * GW) = pack8(y);
#pragma unroll
            for (int e = 0; e < 8; ++e) { xm3[e] = xm2[e]; xm2[e] = xm1[e]; xm1[e] = xc[e]; }
        }
    }
}

__device__ __forceinline__ void ab_proj_phase(const Args& a, Frame& F) {
    const bf16* xb = (const bf16*)(a.ws + WS_XB0);
    const bf16* wab = (const bf16*)(a.ws + WS_WAB);
    float* beta = (float*)(a.ws + WS_BETA); float* eg = (float*)(a.ws + WS_EG);
    LAS float* red = (LAS float*)F.lds;
    const int m = F.lane & 15, q = F.lane >> 4;
    for (int blk = F.bid; blk < NTOK / 32; blk += F.G) {
        const int r0 = blk * 32;
        v4f acc[2][2];
#pragma unroll
        for (int i = 0; i < 2; ++i)
#pragma unroll
            for (int j = 0; j < 2; ++j) acc[i][j] = (v4f){0.f, 0.f, 0.f, 0.f};
        for (int ks = 0; ks < 16; ++ks) {
            const int k = F.wave * 512 + ks * 32 + 8 * q;
            v8s af[2], bfr[2];
#pragma unroll
            for (int i = 0; i < 2; ++i) { af[i] = *(const v8s*)(xb + (size_t)(r0 + 16 * i + m) * DM + k); bfr[i] = *(const v8s*)(wab + (size_t)(16 * i + m) * DM + k); }
#pragma unroll
            for (int i = 0; i < 2; ++i)
#pragma unroll
                for (int j = 0; j < 2; ++j) acc[i][j] = MFMA16(bfr[j], af[i], acc[i][j]);
        }
#pragma unroll
        for (int i = 0; i < 2; ++i)
#pragma unroll
            for (int j = 0; j < 2; ++j) *(LAS v4f*)(red + ((F.wave * 4 + i * 2 + j) * 64 + F.lane) * 4) = acc[i][j];
        __syncthreads();
        for (int o = F.tid; o < 1024; o += NTHR) {
            float s = 0.f;
#pragma unroll
            for (int w = 0; w < 8; ++w) s += red[w * 1024 + o];
            const int tile = o >> 8, ln = (o >> 2) & 63, r = o & 3, i = tile >> 1, j = tile & 1;
            const int row = r0 + 16 * i + (ln & 15), col = 16 * j + 4 * (ln >> 4) + r;
            if (col < 16) { const float g = -__expf(a.in[3][col]) * softplusf_(s + a.in[4][col]); eg[(size_t)row * 16 + col] = g; }
            else beta[(size_t)row * 16 + (col - 16)] = sigmoidf_(s);
        }
        __syncthreads();
    }
}

__device__ __forceinline__ void rg_gates_phase(const Args& a, Frame& F) {
    const bf16* proj = (const bf16*)(a.ws + WS_HB);
    const bf16* rgw = (const bf16*)(a.ws + WS_RGW);
    unsigned* ABout = (unsigned*)(a.ws + WS_A);
    const float* convw = a.in[6]; const float* convb = a.in[7]; const float* ba = a.in[9]; const float* bx = a.in[11]; const float* lam = a.in[12];
    LAS float* xr = (LAS float*)F.lds;
    LAS bf16* Bw = (LAS bf16*)(F.lds + 33792);
    LAS float* cw = (LAS float*)(F.lds + 33792 + 69632);
    const int rt = F.wave & 3, ch = F.wave >> 2, m = F.lane & 15, q = F.lane >> 4;
    const int tl = F.tid >> 3, cg = (F.tid & 7) * 16;
    int cur_n = -1;
    float kba[4][4], kbx[4][4], ksp[4][4];
    v4u raw[4][2];
#define RG_LOAD(u_) do { const int t_ = ((u_) >> 4) * 64 + tl, ts_ = t_ & (SEQ - 1), n_ = (u_) & 15; \
        _Pragma("unroll") for (int k = 0; k < 4; ++k) { const bool ok_ = ts_ + k - 3 >= 0; const bf16* p_ = proj + (size_t)(t_ + (ok_ ? k - 3 : 0)) * EVEN_IN + PE_RGIN + n_ * 128 + cg; \
            raw[k][0] = *(const v4u*)p_; raw[k][1] = *(const v4u*)(p_ + 8); if (!ok_) { raw[k][0] = (v4u){0u, 0u, 0u, 0u}; raw[k][1] = (v4u){0u, 0u, 0u, 0u}; } } } while (0)
    if (F.bid < 2048) RG_LOAD(F.bid);
    for (int u = F.bid; u < 2048; u += F.G) {
        const int tt = u >> 4, n = u & 15, t0 = tt * 64;
        __syncthreads();
        if (n != cur_n) {
            cur_n = n;
#pragma unroll
            for (int i = 0; i < 8; ++i) { const int f = F.tid + NTHR * i, row = f >> 4, c8 = (f & 15) * 8; *(LAS v4u*)(Bw + row * 136 + c8) = *(const v4u*)(rgw + ((size_t)n * 256 + row) * RGB + c8); }
            for (int o = F.tid; o < 640; o += NTHR) { const int k = o >> 7, c = o & 127; cw[o] = (k < 4) ? convw[k * RGW + n * 128 + c] : convb[n * 128 + c]; }
#pragma unroll
            for (int jj = 0; jj < 4; ++jj) { const int C = n * 128 + 16 * (4 * ch + jj) + 4 * q;
                const v4f b0 = *(const v4f*)(ba + C), b1 = *(const v4f*)(bx + C), lm = *(const v4f*)(lam + C);
#pragma unroll
                for (int r = 0; r < 4; ++r) { kba[jj][r] = b0[r]; kbx[jj][r] = b1[r]; ksp[jj][r] = 8.0f * softplusf_(-lm[r]); } }
            __syncthreads();
        }
        {
#pragma unroll
            for (int hh = 0; hh < 2; ++hh) {
                float acc[8];
                { const v4f b0 = *(const LAS v4f*)(cw + 512 + cg + hh * 8), b1 = *(const LAS v4f*)(cw + 512 + cg + hh * 8 + 4); acc[0] = b0.x; acc[1] = b0.y; acc[2] = b0.z; acc[3] = b0.w; acc[4] = b1.x; acc[5] = b1.y; acc[6] = b1.z; acc[7] = b1.w; }
#pragma unroll
                for (int k = 0; k < 4; ++k) { float x[8]; unpack8(raw[k][hh], x);
                    const v4f w0 = *(const LAS v4f*)(cw + k * 128 + cg + hh * 8), w1 = *(const LAS v4f*)(cw + k * 128 + cg + hh * 8 + 4);
                    acc[0] += w0.x * x[0]; acc[1] += w0.y * x[1]; acc[2] += w0.z * x[2]; acc[3] += w0.w * x[3]; acc[4] += w1.x * x[4]; acc[5] += w1.y * x[5]; acc[6] += w1.z * x[6]; acc[7] += w1.w * x[7]; }
                *(LAS v4f*)(xr + tl * 132 + cg + hh * 8) = (v4f){acc[0], acc[1], acc[2], acc[3]};
                *(LAS v4f*)(xr + tl * 132 + cg + hh * 8 + 4) = (v4f){acc[4], acc[5], acc[6], acc[7]};
            }
        }
        LDS_BARRIER();
        if (u + F.G < 2048) RG_LOAD(u + F.G);
        {   v8s Af[4];
#pragma unroll
            for (int ks = 0; ks < 4; ++ks) { const v4f x0 = *(const LAS v4f*)(xr + (16 * rt + m) * 132 + 32 * ks + 8 * q), x1 = *(const LAS v4f*)(xr + (16 * rt + m) * 132 + 32 * ks + 8 * q + 4);
                v4u p; p.x = pk2(x0.x, x0.y); p.y = pk2(x0.z, x0.w); p.z = pk2(x1.x, x1.y); p.w = pk2(x1.z, x1.w); Af[ks] = __builtin_bit_cast(v8s, p); }
#pragma unroll
            for (int jj = 0; jj < 4; ++jj) {
                const int jt = 4 * ch + jj;
                v4f accr = (v4f){0.f, 0.f, 0.f, 0.f}, acci = (v4f){0.f, 0.f, 0.f, 0.f};
#pragma unroll
                for (int ks = 0; ks < 4; ++ks) {
                    const v8s Br = *(const LAS v8s*)(Bw + (16 * jt + m) * 136 + 32 * ks + 8 * q);
                    const v8s Bi = *(const LAS v8s*)(Bw + (128 + 16 * jt + m) * 136 + 32 * ks + 8 * q);
                    accr = MFMA16(Br, Af[ks], accr); acci = MFMA16(Bi, Af[ks], acci);
                }
                const int cc = 16 * jt + 4 * q, C = n * 128 + cc, row = 16 * rt + m;
                const v4f xv = *(const LAS v4f*)(xr + row * 132 + cc);
                v4u pk;
#pragma unroll
                for (int r = 0; r < 4; ++r) {
                    const float rr = sigmoidf_(accr[r] + kba[jj][r]), ii = sigmoidf_(acci[r] + kbx[jj][r]);
                    const float la = -rr * ksp[jj][r], x2 = 2.0f * la;
                    const float om = (x2 > -0.125f) ? -x2 * (1.0f + x2 * (0.5f + x2 * (0.16666667f + x2 * (0.041666668f + x2 * 0.0083333333f)))) : 1.0f - __expf(x2);
                    pk[r] = pk2(la, __builtin_amdgcn_sqrtf(fmaxf(om, 0.f)) * (ii * xv[r]));
                }
                *(v4u*)(ABout + (size_t)(t0 + row) * RGW + C) = pk;
            }
        }
    }
#undef RG_LOAD
}

constexpr size_t GDN_O = WS_WB + 96 * MiB, GDN_UT = WS_WB + 160 * MiB, GDN_W = WS_RES, GDN_QD = WS_RES + 32 * MiB, GDN_KT = WS_RES + 64 * MiB, GDN_AQK = WS_RES + 96 * MiB, GDN_GL = WS_RES + 112 * MiB;

__device__ __forceinline__ void gdn_chunk_prep_phase(const Args& a, Frame& F) {
    const bf16* qb = (const bf16*)(a.ws + WS_WB); const bf16* kb = qb + (size_t)NTOK * GW; const bf16* vb = kb + (size_t)NTOK * GW;
    const float* G = (const float*)(a.ws + WS_EG); const float* beta = (const float*)(a.ws + WS_BETA);
    float* UT = (float*)(a.ws + GDN_UT); bf16* Wg = (bf16*)(a.ws + GDN_W); bf16* QD = (bf16*)(a.ws + GDN_QD); bf16* KT = (bf16*)(a.ws + GDN_KT); bf16* AQK = (bf16*)(a.ws + GDN_AQK); float* GL = (float*)(a.ws + GDN_GL);
    const int half = F.wave >> 2, wv = F.wave & 3, ht = F.tid & 255, m = F.lane & 15, q = F.lane >> 4;
    constexpr int HALF_BYTES = 3 * 17408 + 17408 + 1024;
    LAS unsigned char* hb = F.lds + half * HALF_BYTES;
    LAS bf16* Kt = (LAS bf16*)hb;
    LAS bf16* Qt = Kt + 64 * 136;
    LAS bf16* Vt = Qt + 64 * 136;
    LAS float* Mm = (LAS float*)(hb + 3 * 17408);
    LAS float* gcs = (LAS float*)(hb + 4 * 17408);
    v4u pK[4], pQ[4], pV[4]; float pg = 0.f, pbt = 0.f;
    const int lr_ = ht >> 4, lsg_ = (ht & 15) * 8;
#define CA_PREFETCH(it_) do { const int c_ = (it_) & 31, h_ = ((it_) >> 5) & 15, b_ = (it_) >> 9; const size_t r0_ = (size_t)b_ * SEQ + (size_t)c_ * 64; const size_t go_ = (r0_ + lr_) * GW + h_ * HD + lsg_; \
        _Pragma("unroll") for (int i = 0; i < 4; ++i) { pK[i] = *(const v4u*)(kb + go_ + (size_t)16 * i * GW); pQ[i] = *(const v4u*)(qb + go_ + (size_t)16 * i * GW); pV[i] = *(const v4u*)(vb + go_ + (size_t)16 * i * GW); } \
        if (wv == 0) { pg = G[(r0_ + F.lane) * 16 + h_]; pbt = beta[(r0_ + F.lane) * 16 + h_]; } } while (0)
    if (F.bid * 2 < 2048) CA_PREFETCH(F.bid * 2 + half);
    for (int it0 = F.bid * 2; it0 < 2048; it0 += F.G * 2) {
        const int it = it0 + half, sl = (it & 31) * 64 + (it >> 5);
        LDS_BARRIER();
        {
#pragma unroll
            for (int i = 0; i < 4; ++i) { *(LAS v4u*)(Kt + (16 * i + lr_) * 136 + lsg_) = pK[i]; *(LAS v4u*)(Qt + (16 * i + lr_) * 136 + lsg_) = pQ[i]; *(LAS v4u*)(Vt + (16 * i + lr_) * 136 + lsg_) = pV[i]; }
            if (wv == 0) {
                float gv = pg;
#pragma unroll
                for (int o = 1; o < 64; o <<= 1) { const float t = __shfl_up(gv, o); if (F.lane >= o) gv += t; }
                gcs[F.lane] = gv; gcs[64 + F.lane] = pbt; gcs[128 + F.lane] = __expf(gv);
                if (F.lane == 63) GL[sl] = __expf(gv);
            }
        }
        LDS_BARRIER();
        {
            const int i = 16 * wv + m; const float gci = gcs[i], bi = gcs[64 + i];
            v8s Ki[4], Qi[4];
#pragma unroll
            for (int ks = 0; ks < 4; ++ks) { Ki[ks] = *(const LAS v8s*)(Kt + i * 136 + 32 * ks + 8 * q); Qi[ks] = *(const LAS v8s*)(Qt + i * 136 + 32 * ks + 8 * q); }
            for (int jt = 0; jt < 4; ++jt) {
                v4f mk = (v4f){0.f, 0.f, 0.f, 0.f}, ak = (v4f){0.f, 0.f, 0.f, 0.f};
                if (jt <= wv) {
                    v4f kk = (v4f){0.f, 0.f, 0.f, 0.f}, qk = (v4f){0.f, 0.f, 0.f, 0.f};
#pragma unroll
                    for (int ks = 0; ks < 4; ++ks) { const v8s Kj = *(const LAS v8s*)(Kt + (16 * jt + m) * 136 + 32 * ks + 8 * q); kk = MFMA16(Kj, Ki[ks], kk); qk = MFMA16(Kj, Qi[ks], qk); }
                    const v4f gj = *(const LAS v4f*)(gcs + 16 * jt + 4 * q);
#pragma unroll
                    for (int r = 0; r < 4; ++r) { const int j = 16 * jt + 4 * q + r; const float gm = __expf(gci - gj[r]);
                        mk[r] = (j < i) ? bi * kk[r] * gm : 0.f; ak[r] = (j <= i) ? qk[r] * gm : 0.f; }
                }
                *(LAS v4f*)(Mm + i * 68 + 16 * jt + 4 * q) = mk;
                v2u w; w.x = pk2(ak[0], ak[1]); w.y = pk2(ak[2], ak[3]);
                *(v2u*)(AQK + (size_t)sl * 4096 + (((wv * 2 + (jt >> 1)) * 64 + ((jt & 1) * 2 + (q >> 1)) * 16 + m) * 8 + 4 * (q & 1))) = w;
            }
        }
        {
            const int r = ht >> 2, sg = (ht & 3) * 32; const float eq = gcs[128 + r];
#pragma unroll
            for (int i = 0; i < 4; ++i) { float x[8]; unpack8(*(const LAS v4u*)(Qt + r * 136 + sg + 8 * i), x);
#pragma unroll
                for (int e = 0; e < 8; ++e) x[e] *= eq;
                *(v4u*)(QD + (size_t)sl * 8192 + ((((r >> 4) * 4 + (ht & 3)) * 64 + i * 16 + (r & 15)) * 8)) = pack8(x); }
            const int d = ht >> 1, tb = (ht & 1) * 32; const float gl = gcs[63];
#pragma unroll
            for (int i = 0; i < 4; ++i) { float x[8];
#pragma unroll
                for (int e = 0; e < 8; ++e) { const int t = tb + 8 * i + e; const v4f g4 = *(const LAS v4f*)(gcs + tb + 8 * i + (e & 4)); x[e] = bf2f(Kt[t * 136 + d]) * __expf(gl - g4[e & 3]); }
                *(v4u*)(KT + (size_t)sl * 8192 + ((((d >> 4) * 2 + (ht & 1)) * 64 + i * 16 + (d & 15)) * 8)) = pack8(x); }
        }
        if (it0 + F.G * 2 < 2048) CA_PREFETCH(it0 + F.G * 2 + half);
        LDS_BARRIER();
        LAS bf16* T1t = Qt;
        LAS bf16* T2t = (LAS bf16*)Mm;
        if (wv == 0) {
            const int cc = F.lane; int ccv = cc;
            float X[64];
#ifndef REP_SUB
#define REP_SUB 1
#endif
#pragma unroll 1
            for (int rs_ = 0; rs_ < REP_SUB; ++rs_)
#pragma unroll
            for (int i = 0; i < 64; ++i) {
                float acc0 = 0.f, acc1 = 0.f;
#pragma unroll
                for (int j4 = 0; j4 < (i + 3) / 4; ++j4) { const v4f mv = *(const LAS v4f*)(Mm + i * 68 + 4 * j4);
                    if (4 * j4 + 0 < i) acc0 += mv.x * X[4 * j4 + 0];
                    if (4 * j4 + 1 < i) acc1 += mv.y * X[4 * j4 + 1];
                    if (4 * j4 + 2 < i) acc0 += mv.z * X[4 * j4 + 2];
                    if (4 * j4 + 3 < i) acc1 += mv.w * X[4 * j4 + 3]; }
                X[i] = ((i == ccv) ? 1.f : 0.f) - (acc0 + acc1);
                asm volatile("" : "+v"(X[i]), "+v"(ccv) :: "memory");
            }
            const float s1 = gcs[64 + cc], s2 = s1 * gcs[128 + cc];
            LDS_WAIT(); asm volatile("" ::: "memory");
#pragma unroll
            for (int i = 0; i < 64; ++i) { T1t[i * 72 + cc] = (bf16)(pk2(X[i] * s1, 0.f) & 0xffffu); T2t[i * 72 + cc] = (bf16)(pk2(X[i] * s2, 0.f) & 0xffffu); }
        }
        LDS_BARRIER();
        {
#pragma unroll
            for (int dd = 0; dd < 2; ++dd) { const int dt = 2 * wv + dd;
                v8s Vf[2], Kf[2];
#pragma unroll
                for (int ks = 0; ks < 2; ++ks) { const LAS bf16* vp = Vt + (32 * ks + 8 * q) * 136 + 16 * dt + m; const LAS bf16* kp = Kt + (32 * ks + 8 * q) * 136 + 16 * dt + m;
                    v4u vv, kk;
                    vv.x = (unsigned)vp[0 * 136] | ((unsigned)vp[1 * 136] << 16); vv.y = (unsigned)vp[2 * 136] | ((unsigned)vp[3 * 136] << 16); vv.z = (unsigned)vp[4 * 136] | ((unsigned)vp[5 * 136] << 16); vv.w = (unsigned)vp[6 * 136] | ((unsigned)vp[7 * 136] << 16);
                    kk.x = (unsigned)kp[0 * 136] | ((unsigned)kp[1 * 136] << 16); kk.y = (unsigned)kp[2 * 136] | ((unsigned)kp[3 * 136] << 16); kk.z = (unsigned)kp[4 * 136] | ((unsigned)kp[5 * 136] << 16); kk.w = (unsigned)kp[6 * 136] | ((unsigned)kp[7 * 136] << 16);
                    Vf[ks] = __builtin_bit_cast(v8s, vv); Kf[ks] = __builtin_bit_cast(v8s, kk); }
#pragma unroll
                for (int ti = 0; ti < 4; ++ti) {
                    v4f du = (v4f){0.f, 0.f, 0.f, 0.f}, dw = (v4f){0.f, 0.f, 0.f, 0.f};
#pragma unroll
                    for (int ks = 0; ks < 2; ++ks) { const v8s t1 = *(const LAS v8s*)(T1t + (16 * ti + m) * 72 + 32 * ks + 8 * q), t2 = *(const LAS v8s*)(T2t + (16 * ti + m) * 72 + 32 * ks + 8 * q);
                        du = MFMA16(t1, Vf[ks], du); dw = MFMA16(Kf[ks], t2, dw); }
                    *(v4f*)(UT + (size_t)sl * 8192 + ((dt * 4 + ti) * 64 + F.lane) * 4) = du;
                    v2u ww; ww.x = pk2(dw[0], dw[1]); ww.y = pk2(dw[2], dw[3]);
                    *(v2u*)(Wg + (size_t)sl * 8192 + (((ti * 4 + (dt >> 1)) * 64 + ((dt & 1) * 2 + (q >> 1)) * 16 + m) * 8 + 4 * (q & 1))) = ww;
                }
            }
        }
    }
#undef CA_PREFETCH
}

__device__ __forceinline__ void gdn_chunk_rec_phase(const Args& a, Frame& F) {
    const float* UT = (const float*)(a.ws + GDN_UT); const bf16* Wg = (const bf16*)(a.ws + GDN_W); const bf16* QD = (const bf16*)(a.ws + GDN_QD); const bf16* KT = (const bf16*)(a.ws + GDN_KT);
    const bf16* AQK = (const bf16*)(a.ws + GDN_AQK); const float* GL = (const float*)(a.ws + GDN_GL);
    float* og = (float*)(a.ws + GDN_O);
    LAS bf16* ST = (LAS bf16*)F.lds;
    LAS bf16* VNT = ST + 2 * 64 * 136;
    const int m = F.lane & 15, q = F.lane >> 4, tt = F.wave >> 1, nta = F.wave & 1;
    for (int item = F.bid; item < 128; item += F.G) {
        const int bh = (item & 7) * 8 + (item >> 4), cg = (item >> 3) & 1, b = bh >> 4, h = bh & 15;
        const size_t row0 = (size_t)b * SEQ;
        __syncthreads();
        for (int o = F.tid; o < 64 * 136 / 2; o += NTHR) ((LAS unsigned*)ST)[o] = 0u;
        v4f S[4] = {(v4f){0.f, 0.f, 0.f, 0.f}, (v4f){0.f, 0.f, 0.f, 0.f}, (v4f){0.f, 0.f, 0.f, 0.f}, (v4f){0.f, 0.f, 0.f, 0.f}};
        v8s Wf[2][4], QDf[2][4], AQf[2][2], KTf[2][2]; v4f UTv[2][2]; float egl[2];
#define GDN_PFA(ci, s_) do { const size_t it_ = (size_t)(ci) * 64 + bh; \
            _Pragma("unroll") for (int ks = 0; ks < 4; ++ks) Wf[s_][ks] = *(const v8s*)(Wg + it_ * 8192 + ((tt * 4 + ks) * 64 + F.lane) * 8); \
            _Pragma("unroll") for (int j = 0; j < 2; ++j) UTv[s_][j] = *(const v4f*)(UT + it_ * 8192 + (((cg * 4 + nta * 2 + j) * 4 + tt) * 64 + F.lane) * 4); } while (0)
#define GDN_PFQ(ci, s_) do { const size_t it_ = (size_t)(ci) * 64 + bh; \
            _Pragma("unroll") for (int ks = 0; ks < 4; ++ks) QDf[s_][ks] = *(const v8s*)(QD + it_ * 8192 + ((tt * 4 + ks) * 64 + F.lane) * 8); \
            _Pragma("unroll") for (int ks = 0; ks < 2; ++ks) AQf[s_][ks] = *(const v8s*)(AQK + it_ * 4096 + ((tt * 2 + ks) * 64 + F.lane) * 8); } while (0)
#define GDN_PFK(ci, s_) do { const size_t it_ = (size_t)(ci) * 64 + bh; \
            _Pragma("unroll") for (int ks = 0; ks < 2; ++ks) KTf[s_][ks] = *(const v8s*)(KT + it_ * 8192 + ((F.wave * 2 + ks) * 64 + F.lane) * 8); \
            egl[s_] = GL[it_]; } while (0)
#define GDN_STEP(c, s_) do { \
            const LAS bf16* STc = ST + ((c) & 1) * 64 * 136; LAS bf16* STn = ST + (((c) + 1) & 1) * 64 * 136; \
            v8s STf[2][4]; \
            _Pragma("unroll") for (int j = 0; j < 2; ++j) _Pragma("unroll") for (int ks = 0; ks < 4; ++ks) STf[j][ks] = *(const LAS v8s*)(STc + (32 * nta + 16 * j + m) * 136 + 32 * ks + 8 * q); \
            _Pragma("unroll") for (int j = 0; j < 2; ++j) { v4f P = (v4f){0.f, 0.f, 0.f, 0.f}; \
                _Pragma("unroll") for (int ks = 0; ks < 4; ++ks) P = MFMA16(Wf[s_][ks], STf[j][ks], P); \
                const v4f vn = UTv[s_][j] - P; v2u w; w.x = pk2(vn[0], vn[1]); w.y = pk2(vn[2], vn[3]); *(LAS v2u*)(VNT + (32 * nta + 16 * j + m) * 72 + 16 * tt + 4 * q) = w; } \
            GDN_PFA(((c) + 2 < 32 ? (c) + 2 : 31), s_); \
            LDS_BARRIER(); \
            _Pragma("unroll") for (int j = 0; j < 2; ++j) { v4f O = (v4f){0.f, 0.f, 0.f, 0.f}; \
                _Pragma("unroll") for (int ks = 0; ks < 4; ++ks) O = MFMA16(STf[j][ks], QDf[s_][ks], O); \
                _Pragma("unroll") for (int ks = 0; ks < 2; ++ks) { const v8s vf = *(const LAS v8s*)(VNT + (32 * nta + 16 * j + m) * 72 + 32 * ks + 8 * q); O = MFMA16(vf, AQf[s_][ks], O); } \
                *(v4f*)(og + (row0 + (size_t)(c) * 64 + 16 * tt + m) * GW + h * HD + cg * 64 + 32 * nta + 16 * j + 4 * q) = O; } \
            GDN_PFQ(((c) + 2 < 32 ? (c) + 2 : 31), s_); \
            { v8s vf[4][2]; \
                _Pragma("unroll") for (int nt = 0; nt < 4; ++nt) _Pragma("unroll") for (int ks = 0; ks < 2; ++ks) vf[nt][ks] = *(const LAS v8s*)(VNT + (16 * nt + m) * 72 + 32 * ks + 8 * q); \
                _Pragma("unroll") for (int nt = 0; nt < 4; ++nt) { \
                    S[nt] = S[nt] * egl[s_]; \
                    _Pragma("unroll") for (int ks = 0; ks < 2; ++ks) S[nt] = MFMA16(KTf[s_][ks], vf[nt][ks], S[nt]); } \
                _Pragma("unroll") for (int nt = 0; nt < 4; ++nt) { v2u w; w.x = pk2(S[nt][0], S[nt][1]); w.y = pk2(S[nt][2], S[nt][3]); \
                    *(LAS v2u*)(STn + (16 * nt + m) * 136 + 16 * F.wave + 4 * q) = w; } } \
            GDN_PFK(((c) + 2 < 32 ? (c) + 2 : 31), s_); \
            LDS_BARRIER(); } while (0)
        GDN_PFA(0, 0); GDN_PFQ(0, 0); GDN_PFK(0, 0); GDN_PFA(1, 1); GDN_PFQ(1, 1); GDN_PFK(1, 1);
        __syncthreads();
        for (int c = 0; c < 32; c += 2) { GDN_STEP(c, 0); GDN_STEP(c + 1, 1); }
#undef GDN_PFQ
#undef GDN_PFK
#undef GDN_STEP
#undef GDN_PFA
#undef GDN_PFB
    }
}

__device__ __forceinline__ void gdn_gate_phase(const Args& a, Frame& F) {
    const float* og = (const float*)(a.ws + GDN_O);
    const bf16* proj = (const bf16*)(a.ws + WS_HB);
    unsigned char* mixed = a.ws + WS_MIXED;
    const float* nw = a.in[5];
    const int gw = F.bid * NWAVES + F.wave, NGW = F.G * NWAVES;
    const int cl = (F.lane & 15) * 8;
    const v4f n0 = *(const v4f*)(nw + cl), n1 = *(const v4f*)(nw + cl + 4);
    for (int t = gw; t < NTOK; t += NGW) {
#pragma unroll
        for (int j = 0; j < 4; ++j) {
            const int c = j * 512 + F.lane * 8;
            const v4f o0 = *(const v4f*)(og + (size_t)t * GW + c), o1 = *(const v4f*)(og + (size_t)t * GW + c + 4);
            float z[8]; unpack8(*(const v4u*)(proj + (size_t)t * EVEN_IN + PE_Z + c), z);
            float ss = (o0.x * o0.x + o0.y * o0.y) + (o0.z * o0.z + o0.w * o0.w) + (o1.x * o1.x + o1.y * o1.y) + (o1.z * o1.z + o1.w * o1.w);
            ss = row16_sum(ss);
            const float r = rsqrtf(ss * (1.0f / 128.0f) + RMS_EPS);
            float y[8];
            y[0] = o0.x * r * n0.x * siluf_(z[0]); y[1] = o0.y * r * n0.y * siluf_(z[1]); y[2] = o0.z * r * n0.z * siluf_(z[2]); y[3] = o0.w * r * n0.w * siluf_(z[3]);
            y[4] = o1.x * r * n1.x * siluf_(z[4]); y[5] = o1.y * r * n1.y * siluf_(z[5]); y[6] = o1.z * r * n1.z * siluf_(z[6]); y[7] = o1.w * r * n1.w * siluf_(z[7]);
#if FP8_OUT
            { v2u w; w.x = pk4_fp8(MIX8_SCALE * y[0], MIX8_SCALE * y[1], MIX8_SCALE * y[2], MIX8_SCALE * y[3]); w.y = pk4_fp8(MIX8_SCALE * y[4], MIX8_SCALE * y[5], MIX8_SCALE * y[6], MIX8_SCALE * y[7]); *(v2u*)(mixed + (size_t)t * DM + c) = w; }
#else
            *(v4u*)((bf16*)mixed + (size_t)t * DM + c) = pack8(y);
#endif
        }
    }
}

__device__ __forceinline__ void rg_scan_phase(const Args& a, Frame& F) {
    const unsigned* ABin = (const unsigned*)(a.ws + WS_A);
    const bf16* proj = (const bf16*)(a.ws + WS_HB);
    unsigned char* mixed = a.ws + WS_MIXED;
    LAS float* sA = (LAS float*)F.lds; LAS float* sH = sA + 64 * 32;
    const int c4 = (F.lane & 7) * 4, seg = F.wave * 8 + (F.lane >> 3);
    for (int item = F.bid; item < 256; item += F.G) {
        const int b = item >> 6, c = (item & 63) * 32 + c4;
        const size_t r0 = (size_t)b * SEQ + (size_t)seg * 32;
        float Ap[4] = {1.f, 1.f, 1.f, 1.f}, Hh[4] = {0.f, 0.f, 0.f, 0.f};
#pragma unroll 8
        for (int t = 0; t < 32; ++t) { const v4u w = *(const v4u*)(ABin + (r0 + t) * RGW + c);
#pragma unroll
            for (int e = 0; e < 4; ++e) { const float av = __expf(bflo(w[e])), bv = bfhi(w[e]); Hh[e] = av * Hh[e] + bv; Ap[e] *= av; } }
        __syncthreads();
        *(LAS v4f*)(sA + seg * 32 + c4) = (v4f){Ap[0], Ap[1], Ap[2], Ap[3]}; *(LAS v4f*)(sH + seg * 32 + c4) = (v4f){Hh[0], Hh[1], Hh[2], Hh[3]};
        __syncthreads();
        v4f hin = (v4f){0.f, 0.f, 0.f, 0.f};
        for (int s = 0; s < seg; ++s) hin = *(const LAS v4f*)(sA + s * 32 + c4) * hin + *(const LAS v4f*)(sH + s * 32 + c4);
        float hcur[4] = {hin.x, hin.y, hin.z, hin.w};
#pragma unroll 8
        for (int t = 0; t < 32; ++t) {
            const v4u w = *(const v4u*)(ABin + (r0 + t) * RGW + c);
            const v2u gw2 = *(const v2u*)(proj + (r0 + t) * EVEN_IN + PE_RGGATE + c);
            const float g[4] = {bflo(gw2.x), bfhi(gw2.x), bflo(gw2.y), bfhi(gw2.y)};
            float o[4];
#pragma unroll
            for (int e = 0; e < 4; ++e) { const float av = __expf(bflo(w[e])), bv = bfhi(w[e]); hcur[e] = av * hcur[e] + bv; o[e] = hcur[e] * gelu_tanh(g[e]); }
#if FP8_OUT
            *(unsigned*)(mixed + (r0 + t) * DM + GW + c) = pk4_fp8(clamp448(MIX8_SCALE * o[0]), clamp448(MIX8_SCALE * o[1]), clamp448(MIX8_SCALE * o[2]), clamp448(MIX8_SCALE * o[3]));
#else
            { v2u ow; ow.x = pk2(o[0], o[1]); ow.y = pk2(o[2], o[3]); *(v2u*)((bf16*)mixed + (r0 + t) * DM + GW + c) = ow; }
#endif
        }
    }
}

__device__ __forceinline__ void ln_phase(Frame& F, const bf16* res, const bf16* mixb, const float* g, const float* bb, float* outf, bf16* outb, unsigned char* out8) {
    const int gw = F.bid * NWAVES + F.wave, NGW = F.G * NWAVES;
    for (int row = gw; row < NTOK; row += NGW) {
        const bf16* rr = res + (size_t)row * DM; const bf16* mr = mixb + (size_t)row * DM;
        float y[8][8]; float s = 0.f;
#pragma unroll
        for (int j = 0; j < 8; ++j) {
            float x[8], mv[8]; unpack8(*(const v4u*)(rr + (64 * j + F.lane) * 8), x); unpack8(*(const v4u*)(mr + (64 * j + F.lane) * 8), mv);
#pragma unroll
            for (int e = 0; e < 8; ++e) { y[j][e] = DN_ALPHA * x[e] + mv[e]; s += y[j][e]; }
        }
        const float mean = wave_sum(s) * (1.0f / DM); float s2 = 0.f;
#pragma unroll
        for (int j = 0; j < 8; ++j)
#pragma unroll
            for (int e = 0; e < 8; ++e) { y[j][e] -= mean; s2 += y[j][e] * y[j][e]; }
        const float rstd = rsqrtf(wave_sum(s2) * (1.0f / DM) + LN_EPS);
#pragma unroll
        for (int j = 0; j < 8; ++j) {
            const int c = (64 * j + F.lane) * 8;
            const v4f g0 = *(const v4f*)(g + c), g1 = *(const v4f*)(g + c + 4), b0 = *(const v4f*)(bb + c), b1 = *(const v4f*)(bb + c + 4);
            float o[8];
            o[0] = y[j][0] * rstd * g0.x + b0.x; o[1] = y[j][1] * rstd * g0.y + b0.y; o[2] = y[j][2] * rstd * g0.z + b0.z; o[3] = y[j][3] * rstd * g0.w + b0.w;
            o[4] = y[j][4] * rstd * g1.x + b1.x; o[5] = y[j][5] * rstd * g1.y + b1.y; o[6] = y[j][6] * rstd * g1.z + b1.z; o[7] = y[j][7] * rstd * g1.w + b1.w;
            if (outf) { *(v4f*)(outf + (size_t)row * DM + c) = (v4f){o[0], o[1], o[2], o[3]}; *(v4f*)(outf + (size_t)row * DM + c + 4) = (v4f){o[4], o[5], o[6], o[7]}; }
            if (outb) *(v4u*)(outb + (size_t)row * DM + c) = pack8(o);
            if (out8) { v2u w; w.x = pk4_fp8(clamp448(o[0]), clamp448(o[1]), clamp448(o[2]), clamp448(o[3])); w.y = pk4_fp8(clamp448(o[4]), clamp448(o[5]), clamp448(o[6]), clamp448(o[7])); *(v2u*)(out8 + (size_t)row * DM + c) = w; }
        }
    }
}

__device__ __forceinline__ unsigned ordkey(float f) { const unsigned u = __float_as_uint(f); return (u & 0x80000000u) ? ~u : (u | 0x80000000u); }
__device__ __forceinline__ void split8(const v4f a, const v4f b, v8s& hi, v8s& lo) {
    v4u h; h.x = pk2(a.x, a.y); h.y = pk2(a.z, a.w); h.z = pk2(b.x, b.y); h.w = pk2(b.z, b.w);
    v4u l; l.x = pk2(a.x - bflo(h.x), a.y - bfhi(h.x)); l.y = pk2(a.z - bflo(h.y), a.w - bfhi(h.y)); l.z = pk2(b.x - bflo(h.z), b.y - bfhi(h.z)); l.w = pk2(b.z - bflo(h.w), b.w - bfhi(h.w));
    hi = __builtin_bit_cast(v8s, h); lo = __builtin_bit_cast(v8s, l);
}
__device__ __forceinline__ void peer_topk_phase(Frame& F, const bf16* q, const bf16* kh, const bf16* kl, int* idx, float* gate, unsigned char* Wz) {
    LAS float* sc = (LAS float*)F.lds;
    const int m = F.lane & 15, kq = F.lane >> 4;
    for (int u = F.bid; u < NTOK / 16; u += F.G) {
        const int t0 = u * 16;
        __syncthreads();
#ifndef REP_SC
#define REP_SC 1
#endif
#pragma unroll 1
        for (int hpi = 0; hpi < 2 * REP_SC; ++hpi) {
            const int hp = 2 * F.wave + (hpi & 1);
            v8s Qh[4];
#pragma unroll
            for (int ks = 0; ks < 4; ++ks) Qh[ks] = *(const v8s*)((const unsigned char*)q + tl_off((size_t)(t0 + m), hp * 128 + 32 * ks + 8 * kq, PQ / 256));
            v8s Kh[3][4];
#define TK_LOAD(kt_, s_) do { _Pragma("unroll") for (int ks = 0; ks < 4; ++ks) { const size_t off = (size_t)hp * 16384 + (((kt_) * 4 + ks) * 64 + F.lane) * 8; Kh[s_][ks] = *(const v8s*)(kh + off); } } while (0)
            TK_LOAD(0, 0); TK_LOAD(1, 1);
            __builtin_amdgcn_sched_barrier(0);
#pragma unroll
            for (int kt = 0; kt < 8; ++kt) {
                if (kt + 2 < 8) TK_LOAD(kt + 2, (kt + 2) % 3);
                __builtin_amdgcn_sched_barrier(0);
                v4f acc = (v4f){0.f, 0.f, 0.f, 0.f};
#pragma unroll
                for (int ks = 0; ks < 4; ++ks) acc = MFMA16(Kh[kt % 3][ks], Qh[ks], acc);
                LAS float* dst = sc + (m * 16 + hp) * 129 + 16 * kt + 4 * kq;
                dst[0] = acc[0]; dst[1] = acc[1]; dst[2] = acc[2]; dst[3] = acc[3];
                __builtin_amdgcn_sched_barrier(0);
            }
#undef TK_LOAD
        }
        __syncthreads();
        if (F.tid < 256) {
            LAS float* L = sc + F.tid * 129;
            unsigned a[16];
#pragma unroll
            for (int p = 0; p < 16; ++p) a[p] = 0u;
#pragma unroll 4
            for (int i = 0; i < 128; ++i) {
                unsigned x = (ordkey(L[i]) & ~127u) | (unsigned)(127 - i);
#pragma unroll
                for (int p = 0; p < 16; ++p) { const unsigned hi = max(a[p], x); x = min(a[p], x); a[p] = hi; }
            }
            float v[16];
#pragma unroll
            for (int p = 0; p < 16; ++p) v[p] = L[127 - (int)(a[p] & 127u)];
#pragma unroll
            for (int p = 0; p < 16; ++p) { L[p] = v[p]; L[16 + p] = __int_as_float(127 - (int)(a[p] & 127u)); }
        }
        __syncthreads();
        if (F.tid < 128) {
            const LAS float* L1 = sc + (2 * F.tid) * 129; const LAS float* L2 = L1 + 129;
            float v1[16], v2[16];
#pragma unroll
            for (int p = 0; p < 16; ++p) { v1[p] = L1[p]; v2[p] = L2[p]; }
            unsigned b[16];
#pragma unroll
            for (int p = 0; p < 16; ++p) b[p] = 0u;
#pragma unroll
            for (int ci = 0; ci < 16; ++ci)
#pragma unroll
                for (int cj = 0; cj < 16; ++cj)
                    if ((ci + 1) * (cj + 1) <= 16) {
                        unsigned x = (ordkey(v1[ci] + v2[cj]) & ~255u) | (unsigned)(255 - (ci * 16 + cj));
#pragma unroll
                        for (int p = 0; p < 16; ++p) { const unsigned hi = max(b[p], x); x = min(b[p], x); b[p] = hi; }
                    }
            float s[16]; int ex[16];
#pragma unroll
            for (int r = 0; r < 16; ++r) { const int pos = 255 - (int)(b[r] & 255u), ci = pos >> 4, cj = pos & 15;
                s[r] = L1[ci] + L2[cj]; ex[r] = __float_as_int(L1[16 + ci]) * PNK + __float_as_int(L2[16 + cj]); }
            const float s0 = s[0]; float den = 0.f;
#pragma unroll
            for (int r = 0; r < 16; ++r) { s[r] = __expf(s[r] - s0); den += s[r]; }
            const float rden = 1.0f / den;
#pragma unroll
            for (int r = 0; r < 16; ++r) s[r] *= rden;
            const int tok = F.tid >> 3, h = F.tid & 7; const size_t o = (size_t)(t0 + tok) * 128 + h * 16;
#pragma unroll
            for (int r = 0; r < 16; ++r) { idx[o + r] = ex[r]; gate[o + r] = s[r]; }
        }
    }
}

__device__ __forceinline__ void peer_sparse_phase(Frame& F, const int* idx, const float* gate, const bf16* Hb, unsigned char* Wb) {
    const int gw = F.bid * NWAVES + F.wave, NGW = F.G * NWAVES;
    LAS unsigned char* row = F.lds + F.wave * 16384;
    const v4u z = (v4u){0u, 0u, 0u, 0u};
    for (int t = gw; t < NTOK; t += NGW) {
        const int e0 = idx[(size_t)t * 128 + F.lane], e1 = idx[(size_t)t * 128 + 64 + F.lane];
        const float g0 = gate[(size_t)t * 128 + F.lane], g1 = gate[(size_t)t * 128 + 64 + F.lane];
        const int r_ = t & 255, ai_ = r_ >> 7, wr_ = (r_ >> 6) & 1, m_ = (r_ >> 4) & 3, fr_ = r_ & 15;
        const size_t trow = ((size_t)(t >> 8) * (PE / 256)) * 8 * 16384 + (size_t)wr_ * 4 * 16384 + (size_t)((ai_ * 4 + m_) * 2) * 1024 + (size_t)fr_ * 16;
#define H_AT(e_) bf2f(*(const bf16*)((const unsigned char*)Hb + trow + (size_t)((e_) >> 8) * 8 * 16384 + (size_t)(((e_) >> 6) & 3) * 16384 + (size_t)(((e_) >> 5) & 1) * 1024 + (size_t)(((e_) >> 3) & 3) * 256 + (size_t)((e_) & 7) * 2))
        const float h0 = H_AT(e0), h1 = H_AT(e1);
#undef H_AT
#pragma unroll
        for (int j = 0; j < 16; ++j) *(LAS v4u*)(row + (64 * j + F.lane) * 16) = z;
        float tot0 = 0.f, tot1 = 0.f; bool first0 = true, first1 = true;
#pragma unroll 8
        for (int j = 0; j < 64; ++j) {
            const int ea = __shfl(e0, j), eb = __shfl(e1, j); const float ga = __shfl(g0, j), gb = __shfl(g1, j);
            if (ea == e0) { tot0 += ga; if (j < F.lane) first0 = false; }
            if (eb == e0) { tot0 += gb; }
            if (ea == e1) { tot1 += ga; first1 = false; }
            if (eb == e1) { tot1 += gb; if (j < F.lane) first1 = false; }
        }
        LDS_WAIT(); asm volatile("" ::: "memory");
        if (first0) row[e0] = (unsigned char)(pk4_fp8(clamp448(W8_SCALE * tot0 * gelu_tanh(h0)), 0.f, 0.f, 0.f) & 0xffu);
        if (first1) row[e1] = (unsigned char)(pk4_fp8(clamp448(W8_SCALE * tot1 * gelu_tanh(h1)), 0.f, 0.f, 0.f) & 0xffu);
        LDS_WAIT(); asm volatile("" ::: "memory");
        v4u* wrow = (v4u*)(Wb + (size_t)t * PE);
#pragma unroll
        for (int j = 0; j < 16; ++j) wrow[64 * j + F.lane] = *(const LAS v4u*)(row + (64 * j + F.lane) * 16);
        LDS_WAIT(); asm volatile("" ::: "memory");
    }
}

__device__ __forceinline__ void sb_attn_phase(const Args& a, Frame& F, unsigned* qctr, const int item_lo, const int item_hi) {
    const bf16* proj = (const bf16*)(a.ws + WS_HB);
    unsigned char* mixed = a.ws + WS_MIXED;
    LAS bf16* Qs = (LAS bf16*)F.lds;
    LAS bf16* Ks = Qs + 128 * 136;
    LAS bf16* Vt = Ks + 64 * 136;
    LAS float* wmaxs = (LAS float*)(Vt + 128 * 72);
    const int m = F.lane & 15, q = F.lane >> 4;
    volatile LAS int* slot = (volatile LAS int*)(F.lds + MISC_OFF + 64);
    for (;;) {
        __syncthreads();
        if (F.tid == 0) slot[0] = (int)__hip_atomic_fetch_add(qctr, 1u, __ATOMIC_RELAXED, __HIP_MEMORY_SCOPE_AGENT);
        __syncthreads();
        const int item = item_lo + slot[0];
        if (item >= item_hi) break;
        const int qb = 15 - (item >> 6), hd = item & 15, b = (item >> 4) & 3;
        const int t0 = qb * 128; const size_t row0 = (size_t)b * SEQ;
        __syncthreads();
        {   const int r = F.tid >> 2, c = (F.tid & 3) * 32;
#pragma unroll
            for (int i = 0; i < 4; ++i) *(LAS v4u*)(Qs + r * 136 + c + 8 * i) = *(const v4u*)(proj + (row0 + t0 + r) * ODD_IN + hd * HD + c + 8 * i); }
        __syncthreads();
        v8s Qf[4];
#pragma unroll
        for (int ks = 0; ks < 4; ++ks) Qf[ks] = *(const LAS v8s*)(Qs + (16 * F.wave + m) * 136 + 32 * ks + 8 * q);
        v4f O[8];
#pragma unroll
        for (int dt = 0; dt < 8; ++dt) O[dt] = (v4f){0.f, 0.f, 0.f, 0.f};
        float R = 0.f;
        const int tq = t0 + 16 * F.wave + m;
        const int lr_ = F.tid >> 3, lc_ = (F.tid & 7) * 16;
        v4u pk0, pk1, pv0, pv1;
#define SB_LOAD(kbx) do { const bf16* p_ = proj + (row0 + (size_t)(kbx) * 64 + lr_) * ODD_IN + hd * HD + lc_; \
            pk0 = *(const v4u*)(p_ + SBW); pk1 = *(const v4u*)(p_ + SBW + 8); pv0 = *(const v4u*)(p_ + 2 * SBW); pv1 = *(const v4u*)(p_ + 2 * SBW + 8); } while (0)
        SB_LOAD((t0 >> 6) + 1);
        for (int kb = (t0 >> 6) + 1; kb >= 0; --kb) {
            const int s0 = kb * 64;
            LDS_BARRIER();
            {   *(LAS v4u*)(Ks + lr_ * 136 + lc_) = pk0; *(LAS v4u*)(Ks + lr_ * 136 + lc_ + 8) = pk1;
                const unsigned vw[8] = {pv0.x, pv0.y, pv0.z, pv0.w, pv1.x, pv1.y, pv1.z, pv1.w};
#pragma unroll
                for (int i = 0; i < 8; ++i) { Vt[(lc_ + 2 * i) * 72 + lr_] = (bf16)(vw[i] & 0xffffu); Vt[(lc_ + 2 * i + 1) * 72 + lr_] = (bf16)(vw[i] >> 16); }
            }
            if (kb > 0) SB_LOAD(kb - 1);
            LDS_BARRIER();
            if (s0 < t0 + 16 * F.wave + 15) {
            v4f S[4];
#pragma unroll
            for (int jt = 0; jt < 4; ++jt) { S[jt] = (v4f){0.f, 0.f, 0.f, 0.f};
#pragma unroll
                for (int ks = 0; ks < 4; ++ks) { const v8s Kf = *(const LAS v8s*)(Ks + (16 * jt + m) * 136 + 32 * ks + 8 * q); S[jt] = MFMA16(Kf, Qf[ks], S[jt]); } }
            float l[4][4], G[4];
#pragma unroll
            for (int jt = 0; jt < 4; ++jt) { G[jt] = 0.f;
#pragma unroll
                for (int r = 0; r < 4; ++r) { const float z = S[jt][r] * 0.08838834764831845f; S[jt][r] = z;
                    const bool mk = (s0 + 16 * jt + 4 * q + r) < tq;
                    const float lv = mk ? -(fmaxf(z, 0.f) + __logf(1.0f + __expf(-fabsf(z)))) : 0.f; l[jt][r] = lv; G[jt] += lv; } }
            float tg[4], TOT[4];
#pragma unroll
            for (int jt = 0; jt < 4; ++jt) {
                const float g1 = __shfl_xor(G[jt], 16), g2 = __shfl_xor(G[jt], 32), g3 = __shfl_xor(G[jt], 48);
                TOT[jt] = (G[jt] + g1) + (g2 + g3);
                tg[jt] = (((q ^ 1) > q) ? g1 : 0.f) + (((q ^ 2) > q) ? g2 : 0.f) + (((q ^ 3) > q) ? g3 : 0.f);
            }
            float after = 0.f;
            v4u Pw[2];
#pragma unroll
            for (int jt = 3; jt >= 0; --jt) {
                float tail = R + after + tg[jt];
                float w[4];
#pragma unroll
                for (int r = 3; r >= 0; --r) {
                    const bool mk = (s0 + 16 * jt + 4 * q + r) < tq;
                    w[r] = mk ? __expf(S[jt][r] + l[jt][r] + tail) : 0.f;
                    tail += l[jt][r];
                }
                after += TOT[jt];
                const unsigned lo = pk2(w[0], w[1]), hi = pk2(w[2], w[3]);
                if (jt & 1) { Pw[jt >> 1].z = lo; Pw[jt >> 1].w = hi; } else { Pw[jt >> 1].x = lo; Pw[jt >> 1].y = hi; }
            }
            R += after;
#pragma unroll
            for (int kp = 0; kp < 2; ++kp) {
                const v8s Pf = __builtin_bit_cast(v8s, Pw[kp]);
#pragma unroll
                for (int dt = 0; dt < 8; ++dt) {
                    const v2u a0 = *(const LAS v2u*)(Vt + (16 * dt + m) * 72 + 32 * kp + 4 * q), a1 = *(const LAS v2u*)(Vt + (16 * dt + m) * 72 + 32 * kp + 16 + 4 * q);
                    const v4u av = (v4u){a0.x, a0.y, a1.x, a1.y};
                    O[dt] = MFMA16(__builtin_bit_cast(v8s, av), Pf, O[dt]);
                }
            }
            }
            const float wm = wave_max(R);
            if (F.lane == 0) wmaxs[F.wave] = wm;
            LDS_BARRIER();
            float bm = wmaxs[0];
#pragma unroll
            for (int w = 1; w < 8; ++w) bm = fmaxf(bm, wmaxs[w]);
            if (bm < -100.f) break;
        }
#pragma unroll
#if FP8_OUT
        for (int dt = 0; dt < 8; ++dt) *(unsigned*)(mixed + (row0 + tq) * ODD_MIX + hd * HD + 16 * dt + 4 * q) = pk4_fp8(clamp448(MIX8_SCALE * O[dt][0]), clamp448(MIX8_SCALE * O[dt][1]), clamp448(MIX8_SCALE * O[dt][2]), clamp448(MIX8_SCALE * O[dt][3]));
#else
        for (int dt = 0; dt < 8; ++dt) { v2u w; w.x = pk2(O[dt][0], O[dt][1]); w.y = pk2(O[dt][2], O[dt][3]); *(v2u*)((bf16*)mixed + (row0 + tq) * ODD_MIX + hd * HD + 16 * dt + 4 * q) = w; }
#endif
#undef SB_LOAD
    }
}

__device__ __forceinline__ void s5_phase(const Args& a, Frame& F) {
    const bf16* proj = (const bf16*)(a.ws + WS_HB);
    bf16* yg = (bf16*)(a.ws + WS_YG);
    LAS float* us = (LAS float*)F.lds;
    LAS float* hre = us + 64 * 16;
    LAS float* him = hre + 64 * 68;
    LAS float* Ere = him + 64 * 68;
    LAS float* Eim = Ere + 8 * 64;
    const int n = F.lane, m = F.lane & 15, q = F.lane >> 4;
    for (int item = F.bid; item < 256; item += F.G) {
        const int b = item >> 6, g = item & 63; const size_t row0 = (size_t)b * SEQ;
        const float dt = __expf(a.in[17][g]);
        const float lr = fminf(a.in[15][g * 64 + n], -1e-4f), li = a.in[16][g * 64 + n];
        const float mag = expf(lr * dt), ab_re = mag * cosf(li * dt), ab_im = mag * sinf(li * dt);
        const float den = lr * lr + li * li, nr = ab_re - 1.0f, ni = ab_im;
        const float cr = (nr * lr + ni * li) / den, ci = (ni * lr - nr * li) / den;
        float bbr[16], bbi[16];
#pragma unroll
        for (int c = 0; c < 16; ++c) { const float br = a.in[18][((size_t)g * 64 + n) * 16 + c], bi = a.in[19][((size_t)g * 64 + n) * 16 + c]; bbr[c] = cr * br - ci * bi; bbi[c] = cr * bi + ci * br; }
        float pr[8], pi[8];
        pr[0] = ab_re; pi[0] = ab_im;
#pragma unroll
        for (int i = 1; i < 8; ++i) { pr[i] = pr[i - 1] * ab_re - pi[i - 1] * ab_im; pi[i] = pr[i - 1] * ab_im + pi[i - 1] * ab_re; }
        v8s Cf[4];
#pragma unroll
        for (int ks = 0; ks < 4; ++ks) { const float* src = (ks < 2 ? a.in[20] : a.in[21]) + ((size_t)g * 16 + m) * 64 + 32 * (ks & 1) + 8 * q; const float sg = ks < 2 ? 1.f : -1.f;
            const v4f x = *(const v4f*)src, y = *(const v4f*)(src + 4);
            v4u p; p.x = pk2(sg * x.x, sg * x.y); p.y = pk2(sg * x.z, sg * x.w); p.z = pk2(sg * y.x, sg * y.y); p.w = pk2(sg * y.z, sg * y.w); Cf[ks] = __builtin_bit_cast(v8s, p); }
        const v4f Dv = *(const v4f*)(a.in[22] + g * 16 + 4 * q);
        float c_re = 0.f, c_im = 0.f;
        const int ur = F.tid >> 1, uc8 = (F.tid & 1) * 8;
        v4u upf = (v4u){0u, 0u, 0u, 0u};
        if (F.tid < 128) upf = *(const v4u*)(proj + (row0 + ur) * ODD_IN + 3 * SBW + g * 16 + uc8);
        __syncthreads();
        for (int ch = 0; ch < SEQ / 64; ++ch) {
            const size_t r0 = row0 + (size_t)ch * 64;
            if (F.tid < 128) { float x[8]; unpack8(upf, x);
                *(LAS v4f*)(us + ur * 16 + uc8) = (v4f){x[0], x[1], x[2], x[3]}; *(LAS v4f*)(us + ur * 16 + uc8 + 4) = (v4f){x[4], x[5], x[6], x[7]};
                if (ch + 1 < SEQ / 64) upf = *(const v4u*)(proj + (r0 + 64 + ur) * ODD_IN + 3 * SBW + g * 16 + uc8); }
            LDS_BARRIER();
            float hlr[8], hli[8]; float h_re = 0.f, h_im = 0.f;
#pragma unroll
            for (int i = 0; i < 8; ++i) { const int t = F.wave * 8 + i;
                const v4f u0 = *(const LAS v4f*)(us + t * 16), u1 = *(const LAS v4f*)(us + t * 16 + 4), u2 = *(const LAS v4f*)(us + t * 16 + 8), u3 = *(const LAS v4f*)(us + t * 16 + 12);
                const float sr = (u0.x * bbr[0] + u0.y * bbr[1] + u0.z * bbr[2] + u0.w * bbr[3]) + (u1.x * bbr[4] + u1.y * bbr[5] + u1.z * bbr[6] + u1.w * bbr[7])
                               + (u2.x * bbr[8] + u2.y * bbr[9] + u2.z * bbr[10] + u2.w * bbr[11]) + (u3.x * bbr[12] + u3.y * bbr[13] + u3.z * bbr[14] + u3.w * bbr[15]);
                const float si = (u0.x * bbi[0] + u0.y * bbi[1] + u0.z * bbi[2] + u0.w * bbi[3]) + (u1.x * bbi[4] + u1.y * bbi[5] + u1.z * bbi[6] + u1.w * bbi[7])
                               + (u2.x * bbi[8] + u2.y * bbi[9] + u2.z * bbi[10] + u2.w * bbi[11]) + (u3.x * bbi[12] + u3.y * bbi[13] + u3.z * bbi[14] + u3.w * bbi[15]);
                const float nre = ab_re * h_re - ab_im * h_im + sr, nim = ab_re * h_im + ab_im * h_re + si; h_re = nre; h_im = nim; hlr[i] = nre; hli[i] = nim; }
            Ere[F.wave * 64 + n] = h_re; Eim[F.wave * 64 + n] = h_im;
            LDS_BARRIER();
            float in_re = c_re, in_im = c_im;
#pragma unroll
            for (int w = 0; w < 8; ++w) {
                if (w == F.wave) { in_re = c_re; in_im = c_im; }
                const float er = Ere[w * 64 + n], ei = Eim[w * 64 + n];
                const float nre = pr[7] * c_re - pi[7] * c_im + er, nim = pr[7] * c_im + pi[7] * c_re + ei; c_re = nre; c_im = nim;
            }
#pragma unroll
            for (int i = 0; i < 8; ++i) { const int t = F.wave * 8 + i;
                hre[t * 68 + n] = hlr[i] + (pr[i] * in_re - pi[i] * in_im); him[t * 68 + n] = hli[i] + (pr[i] * in_im + pi[i] * in_re); }
            LDS_BARRIER();
            if (F.wave < 4) {
                const int t = F.wave * 16 + m;
                v4f acc = (v4f){0.f, 0.f, 0.f, 0.f};
#pragma unroll
                for (int ks = 0; ks < 4; ++ks) { const LAS float* hp = (ks < 2 ? hre : him) + t * 68 + 32 * (ks & 1) + 8 * q;
                    const v4f x = *(const LAS v4f*)hp, y = *(const LAS v4f*)(hp + 4);
                    v4u p; p.x = pk2(x.x, x.y); p.y = pk2(x.z, x.w); p.z = pk2(y.x, y.y); p.w = pk2(y.z, y.w);
                    acc = MFMA16(Cf[ks], __builtin_bit_cast(v8s, p), acc); }
                const v4f uv = *(const LAS v4f*)(us + t * 16 + 4 * q);
                v2u w; w.x = pk2(gelu_tanh(acc[0] + Dv.x * uv.x), gelu_tanh(acc[1] + Dv.y * uv.y)); w.y = pk2(gelu_tanh(acc[2] + Dv.z * uv.z), gelu_tanh(acc[3] + Dv.w * uv.w));
                *(v2u*)(yg + (r0 + t) * S5W + g * 16 + 4 * q) = w;
            }
            LDS_BARRIER();
        }
    }
}

namespace pg8 {
struct EpiGlu {
    static constexpr bool PERM = true, AFTER_DRAIN = false;
    unsigned char* O; int ldo; int ocol0; const bf16_t* Y; int ldy; const float* bias;
    __device__ __forceinline__ void operator()(const f32x4 (&acc)[2][2][4][2], const Unit& u, int wr, int wc, int fr, int fq) const {
        const int row0 = u.pm * BM + wr * 64 + fr, col0 = u.pn * BM + wc * 64 + 8 * fq;
#pragma unroll
        for (int ai = 0; ai < 2; ++ai)
#pragma unroll
            for (int m = 0; m < 4; ++m) { const int row = row0 + ai * HALF + m * 16;
#pragma unroll
                for (int bj = 0; bj < 2; ++bj) { const int col = col0 + bj * 32;
                    const f32x4 b0 = *(const f32x4*)(bias + col), b1 = *(const f32x4*)(bias + col + 4);
                    const f32x4 v0 = acc[ai][bj][m][0] + b0, v1 = acc[ai][bj][m][1] + b1;
                    const u32x4 yw = *(const u32x4*)(Y + (size_t)row * ldy + col);
                    float y[8]; unpack8(yw, y);
#if !FP8_OUT
                    { u32x4 wb; wb.x = pk2(y[0] * sigmoidf_(v0[0]), y[1] * sigmoidf_(v0[1])); wb.y = pk2(y[2] * sigmoidf_(v0[2]), y[3] * sigmoidf_(v0[3]));
                      wb.z = pk2(y[4] * sigmoidf_(v1[0]), y[5] * sigmoidf_(v1[1])); wb.w = pk2(y[6] * sigmoidf_(v1[2]), y[7] * sigmoidf_(v1[3]));
                      *(u32x4*)((bf16_t*)O + (size_t)row * ldo + ocol0 + col) = wb; continue; }
#endif
                    v2u w; w.x = pk4_fp8(clamp448(MIX8_SCALE * y[0] * sigmoidf_(v0[0])), clamp448(MIX8_SCALE * y[1] * sigmoidf_(v0[1])), clamp448(MIX8_SCALE * y[2] * sigmoidf_(v0[2])), clamp448(MIX8_SCALE * y[3] * sigmoidf_(v0[3])));
                    w.y = pk4_fp8(clamp448(MIX8_SCALE * y[4] * sigmoidf_(v1[0])), clamp448(MIX8_SCALE * y[5] * sigmoidf_(v1[1])), clamp448(MIX8_SCALE * y[6] * sigmoidf_(v1[2])), clamp448(MIX8_SCALE * y[7] * sigmoidf_(v1[3])));
                    *(v2u*)(O + (size_t)row * ldo + ocol0 + col) = w; } }
    }
};
struct EpiTiled {
    static constexpr bool PERM = true, AFTER_DRAIN = false;
    bf16_t* O; int ntn;
    __device__ __forceinline__ void operator()(const f32x4 (&acc)[2][2][4][2], const Unit& u, int wr, int wc, int fr, int fq) const {
        unsigned char* base = (unsigned char*)O + ((size_t)(u.pm * ntn + u.pn) * 8 + wr * 4 + wc) * 16384 + (size_t)(fq * 16 + fr) * 16;
#pragma unroll
        for (int ai = 0; ai < 2; ++ai)
#pragma unroll
            for (int m = 0; m < 4; ++m)
#pragma unroll
                for (int bj = 0; bj < 2; ++bj) { const f32x4 v0 = acc[ai][bj][m][0], v1 = acc[ai][bj][m][1];
                    u32x4 w; w.x = cvt_pk_bf16(v0[0], v0[1]); w.y = cvt_pk_bf16(v0[2], v0[3]); w.z = cvt_pk_bf16(v1[0], v1[1]); w.w = cvt_pk_bf16(v1[2], v1[3]);
                    *(u32x4*)(base + (size_t)(((ai * 4 + m) * 2 + bj) * 1024)) = w; }
    }
};
struct EpiNull { static constexpr bool PERM = true, AFTER_DRAIN = false; float* sink;
    __device__ __forceinline__ void operator()(const f32x4 (&acc)[2][2][4][2], const Unit& u, int wr, int wc, int fr, int fq) const {
        float s = 0.f;
#pragma unroll
        for (int a = 0; a < 2; ++a)
#pragma unroll
            for (int b = 0; b < 2; ++b)
#pragma unroll
                for (int m = 0; m < 4; ++m)
#pragma unroll
                    for (int n = 0; n < 2; ++n) s += acc[a][b][m][n][0] + acc[a][b][m][n][1] + acc[a][b][m][n][2] + acc[a][b][m][n][3];
        if (s == 123456.789f) sink[0] = s; } };
struct EpiFixed { static constexpr bool PERM = true, AFTER_DRAIN = false; EpiBf16<0> e;
    __device__ __forceinline__ void operator()(const f32x4 (&acc)[2][2][4][2], const Unit& u, int wr, int wc, int fr, int fq) const { const Unit z{0, 0}; e(acc, z, wr, wc, fr, fq); } };
}

struct RangeOrder : pg8::StaticOrder {
    int i0, i1;
    __device__ bool next(int i, pg8::Unit& u) const { return (i + i0 < i1) && pg8::StaticOrder::next(i + i0, u); }
};
template <int SW, int SX, class Epi>
__device__ __forceinline__ void gemm8_range(Frame& F, const unsigned char* A, const unsigned char* Bt, int M, int N, int K, int i0, int i1, const Epi& E) {
    if (i0 >= i1) return;
    pg8::Gemm g{(const bf16*)A, (const bf16*)Bt, M, N, K / 2}; RangeOrder S; S.init(M, N, F.G, F.bid); S.i0 = i0; S.i1 = i1;
    pg8::gemm_phase<Epi, RangeOrder, false, true, SW, SX>(F.lds, g, S, E, nullptr);
}
struct SameOrder : pg8::StaticOrder {
    int rounds;
    __device__ bool next(int i, pg8::Unit& u) const { if (i >= rounds) return false; u.pm = 0; u.pn = i; return true; }
};
template <int SW, int SX, class Epi>
__device__ __forceinline__ void gemm8_same(Frame& F, const unsigned char* A, const unsigned char* Bt, int M, int N, int K, int rounds, const Epi& E) {
    pg8::Gemm g{(const bf16*)A, (const bf16*)Bt, M, N, K / 2}; SameOrder S; S.init(M, N, F.G, F.bid); S.rounds = rounds;
    pg8::gemm_phase<Epi, SameOrder, false, true, SW, SX>(F.lds, g, S, E, nullptr);
}
template <class Epi>
__device__ __forceinline__ void gemm(Frame& F, const bf16* A, const bf16* Bt, int M, int N, int K, const Epi& E) {
    pg8::Gemm g{A, Bt, M, N, K}; pg8::StaticOrder S; S.init(M, N, F.G, F.bid);
    pg8::gemm_phase<Epi, pg8::StaticOrder, false, false>(F.lds, g, S, E, nullptr);
}
template <int SW, int SX, class Epi>
__device__ __forceinline__ void gemm8(Frame& F, const unsigned char* A, const unsigned char* Bt, int M, int N, int K, const Epi& E) {
    pg8::Gemm g{(const bf16*)A, (const bf16*)Bt, M, N, K / 2}; pg8::StaticOrder S; S.init(M, N, F.G, F.bid);
    pg8::gemm_phase<Epi, pg8::StaticOrder, false, true, SW, SX>(F.lds, g, S, E, nullptr);
}

#define PEER_LAYER(PB, L, HBF, H8, RESF, OUTF, OUTB, OUT8)                                                                                                            \
    if (IN(PB)) { if (FP8_WQ) gemm8<E8_WIN, E8_1>(F, (const unsigned char*)(H8), ws + ((L) ? WS_WQ1 : WS_WQ0), NTOK, PQ, DM, pg8::EpiF32{(float*)(ws + WS_Q), PQ, nullptr}); \
        else gemm(F, (const bf16*)(HBF), (const bf16*)(ws + ((L) ? WS_WQ1 : WS_WQ0)), NTOK, PQ, DM, pg8::EpiTiled{(bf16*)(ws + WS_Q), PQ / 256}); SEAM(PB); }     \
    if (IN(PB + 1)) {     \
        { const int gsplit = F.bid & 7;     \
          const pg8::EpiTiled EU{(bf16*)(ws + WS_HB), PE / 256};                                                                                     \
          gemm8_range<E8_U, E8_1>(F, (const unsigned char*)(H8), ws + ((L) ? WS_U8_1 : WS_U8_0), NTOK, PE, DM, 0, gsplit, EU);                                   \
          __syncthreads();                                                                                                                                        \
          REPEAT(REP_TOPK) peer_topk_phase(F, (const bf16*)(ws + WS_Q), (const bf16*)(ws + WS_KH) + (size_t)(L) * PH * 2 * PNK * PHALF, (const bf16*)(ws + WS_KL) + (size_t)(L) * PH * 2 * PNK * PHALF, (int*)(ws + WS_IDX), (float*)(ws + WS_GATE), ws + WS_WB);      \
          __syncthreads();                                                                                                                                        \
          if (!(L)) { p0_prologue(a, F, 2); __syncthreads(); }                                                                                                    \
          gemm8_range<E8_U, E8_1>(F, (const unsigned char*)(H8), ws + ((L) ? WS_U8_1 : WS_U8_0), NTOK, PE, DM, gsplit, 1 << 20, EU); }                           \
        SEAM(PB + 1); }    \
    if (IN(PB + 2)) { if (EXP_U == 1) gemm8<E8_U, E8_1>(F, (const unsigned char*)(H8), ws + ((L) ? WS_U8_1 : WS_U8_0), NTOK, PE, DM, pg8::EpiBf16<0>{(bf16*)(ws + WS_HB), PE, nullptr, 0, 0}); \
        if (EXP_U == 3) gemm8<E8_U, E8_1>(F, (const unsigned char*)(H8), ws + ((L) ? WS_U8_1 : WS_U8_0), NTOK, PE, DM, pg8::EpiFixed{pg8::EpiBf16<0>{(bf16*)(ws + WS_RES) + (size_t)F.bid * 256 * 256, 256, nullptr, 0, 0}}); \
        if (EXP_U == 2) gemm8<E8_U, E8_1>(F, (const unsigned char*)(H8), ws + ((L) ? WS_U8_1 : WS_U8_0), NTOK, PE, DM, pg8::EpiNull{(float*)(ws + WS_Q)}); \
        if (EXP_V) gemm8<E8_V, E8_W>(F, ws + WS_X8_1 - WS_X8_1 + WS_WB, ws + ((L) ? WS_VT8_1 : WS_VT8_0), NTOK, DM, PE, pg8::EpiBf16<0>{(bf16*)(ws + WS_MIX), DM, nullptr, 0, 0}); \
        REPEAT(REP_SPARSE) peer_sparse_phase(F, (const int*)(ws + WS_IDX), (const float*)(ws + WS_GATE), (const bf16*)(ws + WS_HB), ws + WS_WB); SEAM(PB + 2); }   \
    if (IN(PB + 3)) { gemm8<E8_V, E8_W>(F, ws + WS_WB, ws + ((L) ? WS_VT8_1 : WS_VT8_0), NTOK, DM, PE, pg8::EpiBf16<0>{(bf16*)(ws + WS_MIX), DM, nullptr, 0, 0}); SEAM(PB + 3); } \
    if (IN(PB + 4)) { REPEAT(REP_LN) ln_phase(F, (RESF), (const bf16*)(ws + WS_MIX), a.in[32] + (L) * DM, a.in[33] + (L) * DM, (OUTF), (OUTB), (OUT8)); SEAM(PB + 4); }

constexpr int N_PHASES = 22;
#ifndef ATTN_SPLIT
#define ATTN_SPLIT 448
#endif
#ifndef REP_PRO
#define REP_PRO 1
#endif
#ifndef REP_P2
#define REP_P2 1
#endif
#ifndef REP_REC
#define REP_REC 1
#endif
#ifndef REP_GS
#define REP_GS 1
#endif
#ifndef REP_LN
#define REP_LN 1
#endif
#ifndef REP_TOPK
#define REP_TOPK 1
#endif
#ifndef REP_SPARSE
#define REP_SPARSE 1
#endif
#ifndef REP_ATTN
#define REP_ATTN 1
#endif
#ifndef REP_S5
#define REP_S5 1
#endif
#ifndef REP_G8
#define REP_G8 1
#endif
#ifndef REP_G16
#define REP_G16 1
#endif
#ifndef REP_GP
#define REP_GP -1
#endif
#define RG16(p) (((p) == REP_GP) ? 2 : REP_G16)
#ifndef REP_PREP
#define REP_PREP 1
#endif
#ifndef REP_AB
#define REP_AB 1
#endif
#ifndef REP_RGG
#define REP_RGG 1
#endif
#ifndef REP_GATE
#define REP_GATE 1
#endif
#ifndef REP_SCAN
#define REP_SCAN 1
#endif
#ifndef REP_CA
#define REP_CA 1
#endif
#ifndef REP_CB
#define REP_CB 1
#endif
#ifndef EXP_U
#define EXP_U 0
#endif
#ifndef EXP_V
#define EXP_V 0
#endif
#ifndef SKEW_STEPS
#define SKEW_STEPS 0
#endif
#define SKEW_DELAY() do { _Pragma("unroll 1") for (int s_ = 0; s_ < SKEW_STEPS * (F.bid & 7); ++s_) __builtin_amdgcn_s_sleep(32); } while (0)
#define REPEAT(n) _Pragma("unroll 1") for (int rep_ = 0; rep_ < (n); ++rep_)

__global__ void __launch_bounds__(NTHR, 2) fwd_kernel(Args a) {
    extern __shared__ __attribute__((aligned(16))) unsigned char lds_raw[];
    Frame F; F.lds = (LAS unsigned char*)lds_raw; F.tid = threadIdx.x; F.lane = F.tid & 63; F.wave = __builtin_amdgcn_readfirstlane(F.tid >> 6); F.G = gridDim.x; F.bid = blockIdx.x;
    unsigned char* ws = a.ws;
    volatile LAS unsigned* MISC = (volatile LAS unsigned*)(F.lds + MISC_OFF);
    if (F.tid < 32) MISC[F.tid] = 0u;
    __syncthreads();
    const bool one_launch = (a.ph_hi - a.ph_lo) > 1;
    XcdBarrier bar; bar.bar = (unsigned*)(ws + WS_CTL) + CW_BAR; bar.x = 0; bar.st = nullptr;
    if (one_launch) bar = xcd_barrier_post((unsigned*)(ws + WS_CTL) + CW_BAR, MISC + 8);
    const int lo = a.ph_lo, hi = a.ph_hi;
    const bool rg_under_ = one_launch && F.G == 256 && REP_CB == 1 && REP_SCAN == 1;
#define IN(k) (lo <= (k) && (k) < hi)
#ifdef PROBE_WAIT
#ifndef PROBE_MASK
#define PROBE_MASK 0xffffffu
#endif
    unsigned long long wait_total = 0ull;
#ifndef PROBE_PHM
#define PROBE_PHM 0u
#endif
    unsigned long long tprev_ = __builtin_amdgcn_s_memrealtime();
#define SEAM(k) do { if (IN((k) + 1)) { const unsigned long long t0_ = __builtin_amdgcn_s_memrealtime(); xcd_barrier(bar); const unsigned long long t1_ = __builtin_amdgcn_s_memrealtime(); if ((PROBE_MASK >> (k)) & 1) wait_total += t1_ - t0_; \
        if ((PROBE_PHM >> (k)) & 1) wait_total += (t1_ - tprev_) * 4; tprev_ = t1_; } } while (0)
#else
#define SEAM(k) do { if (IN((k) + 1)) xcd_barrier(bar); } while (0)
#endif

#ifdef EXTRA_BARS
    if (one_launch) { _Pragma("unroll 1") for (int i_ = 0; i_ < EXTRA_BARS; ++i_) xcd_barrier(bar); }
#endif
    if (IN(0)) { REPEAT(REP_PRO) p0_prologue(a, F, 0); SEAM(0); }
#if FP8_INE
    if (IN(1)) {
        const int gsplit = F.bid % 7;
        const pg8::EpiBf16<0> E1{(bf16*)(ws + WS_HB), EVEN_IN, nullptr, 0, 0};
        gemm8_range<E8_WIN, E8_1>(F, ws + WS_X8_0, ws + WS_WINE, NTOK, EVEN_IN, DM, 0, gsplit, E1);
        __syncthreads();
        p0_prologue(a, F, 1);
        __syncthreads();
        gemm8_range<E8_WIN, E8_1>(F, ws + WS_X8_0, ws + WS_WINE, NTOK, EVEN_IN, DM, gsplit, 1 << 20, E1);
        SEAM(1); }
#else
    if (IN(1)) { p0_prologue(a, F, 1); __syncthreads(); REPEAT(RG16(1)) gemm(F, (const bf16*)(ws + WS_XB0), (const bf16*)(ws + WS_WINE), NTOK, EVEN_IN, DM, pg8::EpiBf16<0>{(bf16*)(ws + WS_HB), EVEN_IN, nullptr, 0, 0}); SEAM(1); }
#endif
    if (IN(2)) { REPEAT(REP_P2) { REPEAT(REP_PREP) gdn_prep_phase(a, F); REPEAT(REP_AB) ab_proj_phase(a, F); REPEAT(REP_RGG) rg_gates_phase(a, F); } SEAM(2); }
    if (IN(3)) { REPEAT(REP_REC) { REPEAT(REP_CA) gdn_chunk_prep_phase(a, F); if (one_launch) xcd_barrier(bar);
#ifdef PROBE_CB
        { const unsigned long long t0_ = __builtin_amdgcn_s_memrealtime(); gdn_chunk_rec_phase(a, F); wait_total += (__builtin_amdgcn_s_memrealtime() - t0_) * PROBE_CB; }
#else
        if (rg_under_) { if (F.bid < 128) gdn_chunk_rec_phase(a, F); else { Frame F2 = F; F2.bid = F.bid - 128; F2.G = 128; rg_scan_phase(a, F2); } }
        else { REPEAT(REP_CB) gdn_chunk_rec_phase(a, F); }
#endif
        } SEAM(3); }
    if (IN(4)) { REPEAT(REP_GS) { REPEAT(REP_GATE) gdn_gate_phase(a, F); if (!rg_under_) { REPEAT(REP_SCAN) rg_scan_phase(a, F); } } SEAM(4); }
#if FP8_OUT
    if (IN(5)) { REPEAT(RG16(5)) gemm8<E8_WOUT, E8_MIX>(F, ws + WS_MIXED, ws + WS_WOUTE, NTOK, DM, DM, pg8::EpiBf16<0>{(bf16*)(ws + WS_MIX), DM, nullptr, 0, 0}); SEAM(5); }
#else
    if (IN(5)) { REPEAT(RG16(5)) gemm(F, (const bf16*)(ws + WS_MIXED), (const bf16*)(ws + WS_WOUTE), NTOK, DM, DM, pg8::EpiBf16<0>{(bf16*)(ws + WS_MIX), DM, nullptr, 0, 0}); SEAM(5); }
#endif
    if (IN(6)) { REPEAT(REP_LN) ln_phase(F, (const bf16*)(ws + WS_XB0), (const bf16*)(ws + WS_MIX), a.in[26], a.in[27], (float*)nullptr, (bf16*)(ws + WS_XB1), ws + WS_X8_1); SEAM(6); }
    PEER_LAYER(7, 0, ws + WS_XB1, ws + WS_X8_1, (const bf16*)(ws + WS_XB1), (float*)nullptr, (bf16*)(ws + WS_XB0), ws + WS_X8_0)
#if FP8_INO
    if (IN(12)) { REPEAT(RG16(12)) gemm8<E8_WIN, E8_1>(F, ws + WS_X8_0, ws + WS_WINO, NTOK, ODD_IN, DM, pg8::EpiBf16<0>{(bf16*)(ws + WS_HB), ODD_IN, nullptr, 0, 0}); SEAM(12); }
#else
    if (IN(12)) { REPEAT(RG16(12)) gemm(F, (const bf16*)(ws + WS_XB0), (const bf16*)(ws + WS_WINO), NTOK, ODD_IN, DM, pg8::EpiBf16<0>{(bf16*)(ws + WS_HB), ODD_IN, nullptr, 0, 0}); SEAM(12); }
#endif
    if (IN(13)) { REPEAT(REP_S5) s5_phase(a, F); SEAM(13); }
    if (IN(14)) {
        gemm(F, (const bf16*)(ws + WS_YG), (const bf16*)(ws + WS_GLU), NTOK, S5W, S5W, pg8::EpiGlu{ws + WS_MIXED, ODD_MIX, SBW, (const bf16*)(ws + WS_YG), S5W, a.in[24]});
        sb_attn_phase(a, F, (unsigned*)(ws + WS_CTL) + 16384, 0, 1024); SEAM(14); }
#if FP8_OUT
    if (IN(15)) { REPEAT(RG16(15)) gemm8<E8_WOUT, E8_MIX>(F, ws + WS_MIXED, ws + WS_WOUTO, NTOK, DM, ODD_MIX, pg8::EpiBf16<0>{(bf16*)(ws + WS_MIX), DM, nullptr, 0, 0}); SEAM(15); }
#else
    if (IN(15)) { REPEAT(RG16(15)) gemm(F, (const bf16*)(ws + WS_MIXED), (const bf16*)(ws + WS_WOUTO), NTOK, DM, ODD_MIX, pg8::EpiBf16<0>{(bf16*)(ws + WS_MIX), DM, nullptr, 0, 0}); SEAM(15); }
#endif
    if (IN(16)) { REPEAT(REP_LN) ln_phase(F, (const bf16*)(ws + WS_XB0), (const bf16*)(ws + WS_MIX), a.in[26] + DM, a.in[27] + DM, (float*)nullptr, (bf16*)(ws + WS_XB1), ws + WS_X8_1); SEAM(16); }
    PEER_LAYER(17, 1, ws + WS_XB1, ws + WS_X8_1, (const bf16*)(ws + WS_XB1), a.out, (bf16*)nullptr, (unsigned char*)nullptr)
#ifdef PROBE_WAIT
    if ((PROBE_WAIT < 0) || ((int)F.bid == PROBE_WAIT)) { const unsigned long long t0_ = __builtin_amdgcn_s_memrealtime(); while (__builtin_amdgcn_s_memrealtime() - t0_ < wait_total) __builtin_amdgcn_s_sleep(8); }
#endif
#undef IN
#undef SEAM
}

#ifndef MK_ONE_LAUNCH
#define MK_ONE_LAUNCH 1
#endif
extern "C" void kernel_launch(void* const* d_in, const int* in_sizes, int n_in, void* d_out, int out_size, void* d_ws, size_t ws_size, hipStream_t stream) {
    static int grid = 0;
    if (grid == 0) {
        if (n_in != 34 || in_sizes[0] != NTOK * DM || out_size != NTOK * DM || ws_size < WS_END) { fprintf(stderr, "kernel_launch: unexpected shapes (n_in %d, in0 %d, out %d, ws %zu < %zu); nothing launched\n", n_in, n_in > 0 ? in_sizes[0] : -1, out_size, ws_size, (size_t)WS_END); grid = -1; return; }
        int dev = 0, cus = 0, per_cu = 0;
        if (hipGetDevice(&dev) != hipSuccess || hipDeviceGetAttribute(&cus, hipDeviceAttributeMultiprocessorCount, dev) != hipSuccess) { grid = -1; return; }
        if (hipFuncSetAttribute((const void*)fwd_kernel, hipFuncAttributeMaxDynamicSharedMemorySize, LDS_BYTES) != hipSuccess) { fprintf(stderr, "kernel_launch: hipFuncSetAttribute failed\n"); grid = -1; return; }
        if (hipOccupancyMaxActiveBlocksPerMultiprocessor(&per_cu, (const void*)fwd_kernel, NTHR, LDS_BYTES) != hipSuccess || per_cu < 1) { fprintf(stderr, "kernel_launch: occupancy query says %d blocks per CU\n", per_cu); }
        (void)hipGetLastError();
        grid = cus;
    }
    if (grid < 0) return;
    (void)hipMemsetAsync((char*)d_ws + WS_CTL, 0, CTL_ZERO_BYTES, stream);
    Args a{};
    for (int i = 0; i < 34; ++i) a.in[i] = (const float*)d_in[i];
    a.out = (float*)d_out; a.ws = (unsigned char*)d_ws;
#if MK_ONE_LAUNCH
    a.ph_lo = 0; a.ph_hi = N_PHASES;
    hipLaunchKernelGGL(fwd_kernel, dim3(grid), dim3(NTHR), LDS_BYTES, stream, a);
#else
    for (int p = 0; p < N_PHASES; ++p) { a.ph_lo = p; a.ph_hi = p + 1; hipLaunchKernelGGL(fwd_kernel, dim3(grid), dim3(NTHR), LDS_BYTES, stream, a); }
#endif
}
```

```cpp
#define FP8_WQ 1
#include <hip/hip_runtime.h>
#include <cstdio>
#include <cstdint>

#define GAS __attribute__((address_space(1)))
#define LAS __attribute__((address_space(3)))
typedef unsigned short bf16;
typedef unsigned v4u __attribute__((ext_vector_type(4)));
typedef unsigned v2u __attribute__((ext_vector_type(2)));
typedef float v4f __attribute__((ext_vector_type(4)));
typedef float v2f __attribute__((ext_vector_type(2)));
typedef short v8s __attribute__((ext_vector_type(8)));

constexpr int NB = 4, SEQ = 2048, DM = 4096, NTOK = NB * SEQ;
constexpr int GW = 2048, GH = 16, HD = 128;
constexpr int RGW = 2048, RGB = 128, RGN = 16;
constexpr int EVEN_IN_SRC = 12320;
constexpr int EVEN_IN = 12288;
constexpr int PE_Z = 6144, PE_RGIN = 8192, PE_RGGATE = 10240;
constexpr int ODD_IN = 7168;
constexpr int SBW = 2048, S5W = 1024, S5G = 64, S5N = 64, S5C = 16;
constexpr int ODD_MIX = 3072;
constexpr int PH = 8, PNK = 128, PHALF = 128, PTOPK = 16, PQ = 2048, PE = 16384;
constexpr float DN_ALPHA = 1.41421356237f;
constexpr float LN_EPS = 1e-5f, RMS_EPS = 1e-6f;

constexpr size_t MiB = 1u << 20;
constexpr size_t WS_CTL = 0, CTL_ZERO_BYTES = 1 * MiB;
constexpr size_t WS_WINE = 1 * MiB;
constexpr size_t WS_WAB = 97 * MiB;
constexpr size_t WS_WOUTE = 98 * MiB;
constexpr size_t WS_WINO = 130 * MiB;
constexpr size_t WS_WOUTO = 186 * MiB;
constexpr size_t WS_WQ0 = 210 * MiB;
constexpr size_t WS_WQ1 = 226 * MiB;
constexpr size_t WS_GLU = 242 * MiB;
constexpr size_t WS_RGW = 244 * MiB;
constexpr size_t WS_U0 = 246 * MiB;
constexpr size_t WS_U1 = 374 * MiB;
constexpr size_t WS_VT0 = 502 * MiB;
constexpr size_t WS_VT1 = 630 * MiB;
constexpr size_t WS_HB = 758 * MiB;
constexpr size_t WS_WB = 1014 * MiB;
constexpr size_t WS_XB0 = 1270 * MiB;
constexpr size_t WS_XB1 = 1334 * MiB;
constexpr size_t WS_RES = 1398 * MiB;
constexpr size_t WS_MIX = 1526 * MiB;
constexpr size_t WS_MIXED = 1590 * MiB;
constexpr size_t WS_Q = 1654 * MiB;
constexpr size_t WS_IDX = 1718 * MiB;
constexpr size_t WS_GATE = 1722 * MiB;
constexpr size_t WS_A = 1726 * MiB;
constexpr size_t WS_B = 1790 * MiB;
constexpr size_t WS_BETA = 1854 * MiB;
constexpr size_t WS_EG = 1855 * MiB;
constexpr size_t WS_YG = 1856 * MiB;
constexpr size_t WS_X8_0 = 1872 * MiB;
constexpr size_t WS_X8_1 = 1904 * MiB;
constexpr size_t WS_KH = 1936 * MiB;
constexpr size_t WS_KL = 1937 * MiB;
constexpr size_t WS_END = 1938 * MiB;
constexpr size_t WS_U8_0 = WS_U0, WS_U8_1 = WS_U0 + 64 * MiB;
constexpr size_t WS_VT8_0 = WS_VT0, WS_VT8_1 = WS_VT0 + 64 * MiB;
constexpr float U8_SCALE = 64.f, V8_SCALE = 8.f, W8_SCALE = 32.f, WIN8_SCALE = 64.f, WOUT8_SCALE = 128.f, MIX8_SCALE = 4.f;
#ifndef HID8
#define HID8 1
#endif
constexpr float H8_SCALE = 16.f;
constexpr int E8_1 = 0x7f7f7f7f, E8_U = 0x79797979  , E8_V = 0x7c7c7c7c  , E8_W = 0x7a7a7a7a  , E8_WIN = 0x79797979  , E8_WOUT = 0x78787878  , E8_MIX = 0x7d7d7d7d  ;
#ifndef FP8_WQ
#define FP8_WQ 0
#endif
#ifndef FP8_OUT
#define FP8_OUT 1
#endif
#ifndef FP8_INE
#define FP8_INE 1
#endif
#ifndef FP8_INO
#define FP8_INO 1
#endif
constexpr int CW_BAR = 4096;

constexpr int RING_BYTES = 131072;
constexpr int MISC_OFF = 147456 - 256;
constexpr int LDS_BYTES = 147456;
constexpr int NWAVES = 8, NTHR = 512;

typedef __bf16 v2bf __attribute__((ext_vector_type(2)));
__device__ __forceinline__ unsigned pk2(float lo, float hi) { const v2f f = {lo, hi}; return __builtin_bit_cast(unsigned, __builtin_convertvector(f, v2bf)); }
__device__ __forceinline__ float bflo(unsigned w) { return __uint_as_float(w << 16); }
__device__ __forceinline__ float bfhi(unsigned w) { return __uint_as_float(w & 0xffff0000u); }
__device__ __forceinline__ float bf2f(bf16 h) { return __uint_as_float(((unsigned)h) << 16); }
__device__ __forceinline__ void unpack8(const v4u w, float (&f)[8]) {
    f[0] = bflo(w.x); f[1] = bfhi(w.x); f[2] = bflo(w.y); f[3] = bfhi(w.y); f[4] = bflo(w.z); f[5] = bfhi(w.z); f[6] = bflo(w.w); f[7] = bfhi(w.w);
}
__device__ __forceinline__ v4u pack8(const float (&f)[8]) { v4u o; o.x = pk2(f[0], f[1]); o.y = pk2(f[2], f[3]); o.z = pk2(f[4], f[5]); o.w = pk2(f[6], f[7]); return o; }
__device__ __forceinline__ float sigmoidf_(float x) { return __builtin_amdgcn_rcpf(1.0f + __expf(-x)); }
__device__ __forceinline__ float siluf_(float x) { return x * __builtin_amdgcn_rcpf(1.0f + __expf(-x)); }
__device__ __forceinline__ float softplusf_(float x) { return fmaxf(x, 0.f) + log1pf(__expf(-fabsf(x))); }
__device__ __forceinline__ float gelu_tanh(float x) { const float u = 1.5957691216f * (x + 0.044715f * x * x * x); return x * __builtin_amdgcn_rcpf(1.0f + __expf(-u)); }
__device__ __forceinline__ float wave_sum(float v) {
#pragma unroll
    for (int o = 1; o < 64; o <<= 1) v += __shfl_xor(v, o);
    return v;
}
__device__ __forceinline__ float wave_max(float v) {
#pragma unroll
    for (int o = 1; o < 64; o <<= 1) v = fmaxf(v, __shfl_xor(v, o));
    return v;
}
__device__ __forceinline__ float row16_sum(float v) {
    v += __builtin_bit_cast(float, __builtin_amdgcn_update_dpp(0, __builtin_bit_cast(int, v), 0xB1, 0xf, 0xf, true));
    v += __builtin_bit_cast(float, __builtin_amdgcn_update_dpp(0, __builtin_bit_cast(int, v), 0x4E, 0xf, 0xf, true));
    v += __builtin_bit_cast(float, __builtin_amdgcn_update_dpp(0, __builtin_bit_cast(int, v), 0x141, 0xf, 0xf, true));
    v += __builtin_bit_cast(float, __builtin_amdgcn_update_dpp(0, __builtin_bit_cast(int, v), 0x140, 0xf, 0xf, true));
    return v;
}
__device__ __forceinline__ unsigned pk4_fp8(float a, float b, float c, float d) { int w = 0; w = __builtin_amdgcn_cvt_pk_fp8_f32(a, b, w, false); w = __builtin_amdgcn_cvt_pk_fp8_f32(c, d, w, true); return (unsigned)w; }
__device__ __forceinline__ float clamp448(float x) { return fminf(fmaxf(x, -448.f), 448.f); }
#define LDS_BARRIER() asm volatile("s_waitcnt lgkmcnt(0)\n\ts_barrier" ::: "memory")
__device__ __forceinline__ size_t tl_off(size_t t, int c, int ntn) {
    return ((t >> 8) * (size_t)ntn + (size_t)(c >> 8)) * 131072 + (size_t)((((t >> 6) & 1) * 4 + ((c >> 6) & 3)) * 16384) + (size_t)((((((t >> 7) & 1) * 4 + ((t >> 4) & 3)) * 2) + ((c >> 5) & 1)) * 1024)
         + (size_t)((((c >> 3) & 3) * 16 + (t & 15)) * 16) + (size_t)((c & 7) * 2);
}
#define LDS_WAIT() asm volatile("s_waitcnt lgkmcnt(0)" ::: "memory")
#define VM_WAIT() asm volatile("s_waitcnt vmcnt(0)" ::: "memory")
namespace pg8 {
#define PG8_LAS __attribute__((address_space(3)))
typedef unsigned short bf16_t;
typedef short bf16x8 __attribute__((ext_vector_type(8)));
typedef float f32x4 __attribute__((ext_vector_type(4)));
typedef unsigned u32x4 __attribute__((ext_vector_type(4)));
constexpr int BM = 256, BK = 64, HALF = 128, HTB = HALF * BK * 2  , STAGE_BYTES = 8 * HTB, NXCD = 8, WGM = 8;

__host__ __device__ __forceinline__ int lds_byte(int r, int c) { const int st = (r >> 4) * 2 + (c >> 5), rr = r & 15, cc = c & 31, ob = rr * 64 + cc * 2; return st * 1024 + (ob ^ (((ob >> 9) & 1) << 5)); }
__host__ __device__ __forceinline__ void stage_rc(int b, int& R, int& C) { const int st = b / 1024, sb = b % 1024, swz = sb ^ (((sb >> 9) & 1) << 5); R = (st >> 1) * 16 + swz / 64; C = (st & 1) * 32 + (swz % 64) / 2; }
__host__ __device__ __forceinline__ int perm32(int rho) { const int n = rho >> 4, i = rho & 15; return 8 * (i >> 2) + 4 * n + (i & 3); }

struct Unit { int pm, pn; };
struct Gemm { const bf16_t* A; const bf16_t* Bt; int M, N, K; };
typedef int i32x8 __attribute__((ext_vector_type(8)));
typedef int i32x4 __attribute__((ext_vector_type(4)));
__device__ __forceinline__ i32x8 pg8_cat(bf16x8 lo, bf16x8 hi) { const i32x4 a = __builtin_bit_cast(i32x4, lo), b = __builtin_bit_cast(i32x4, hi); return __builtin_shufflevector(a, b, 0, 1, 2, 3, 4, 5, 6, 7); }

struct StaticOrder {
    int nM, nN, nwg, G, c;
    __host__ __device__ void init(int M, int N, int G_, int c_) { nM = M / BM; nN = N / BM; nwg = nM * nN; G = G_; c = c_; }
    __host__ __device__ bool next(int i, Unit& u) const {
        const long L = (long)i * G + c; if (L >= nwg) return false;
        int wgid = (int)L; { const int q = nwg / NXCD, r = nwg % NXCD, xcd = wgid % NXCD, off = wgid / NXCD; wgid = (xcd < r ? xcd * (q + 1) : r * (q + 1) + (xcd - r) * q) + off; }
        const int nig = WGM * nN, gid = wgid / nig, fm = gid * WGM, gsz = (nM - fm) < WGM ? (nM - fm) : WGM;
        u.pm = fm + ((wgid % nig) % gsz); u.pn = (wgid % nig) / gsz; return true;
    }
    __device__ __forceinline__ void a_ready(const Unit&) const {}
    __device__ __forceinline__ void done(const Unit&) const {}
};
struct CountedOrder : StaticOrder {
    const unsigned* ready; unsigned need; unsigned* tmo;
    __device__ __forceinline__ void a_ready(const Unit& u) const {
        if (threadIdx.x < 64) {
            const unsigned long long t0 = __builtin_amdgcn_s_memrealtime(); unsigned polls = 0;
            while ((unsigned)__builtin_amdgcn_readfirstlane(__hip_atomic_load(ready + 64 * u.pm, __ATOMIC_RELAXED, __HIP_MEMORY_SCOPE_AGENT)) < need) {
                if ((++polls & 255u) == 0u && __builtin_amdgcn_readfirstlane(__hip_atomic_load(tmo, __ATOMIC_RELAXED, __HIP_MEMORY_SCOPE_AGENT)) != 0u) break;
                if (__builtin_amdgcn_s_memrealtime() - t0 > 2000000ull) {
                    if (threadIdx.x == 0) { unsigned expect = 0u; __hip_atomic_compare_exchange_strong(tmo + 1, &expect, 0x600u | (unsigned)(u.pm & 0xff), __ATOMIC_RELAXED, __ATOMIC_RELAXED, __HIP_MEMORY_SCOPE_AGENT); __hip_atomic_store(tmo, 1u, __ATOMIC_RELAXED, __HIP_MEMORY_SCOPE_AGENT); }
                    break; }
                __builtin_amdgcn_s_sleep(2); }
            __builtin_amdgcn_fence(__ATOMIC_ACQUIRE, "agent");
            asm volatile("s_waitcnt vmcnt(0)" ::: "memory");
        }
#if !defined(BROKEN_HOOK_NO_BARRIER)
        asm volatile("" ::: "memory"); __builtin_amdgcn_s_barrier(); asm volatile("" ::: "memory");
#endif
    }
};

__device__ __forceinline__ unsigned cvt_pk_bf16(float lo, float hi) { unsigned r; asm volatile("v_cvt_pk_bf16_f32 %0, %1, %2" : "=v"(r) : "v"(lo), "v"(hi)); return r; }
typedef float f32x2 __attribute__((ext_vector_type(2)));
__device__ __forceinline__ f32x2 gelu_pk(f32x2 v) {
    const f32x2 av = __builtin_elementwise_abs(v), d = av * 0.2316418882f + 1.0f;
    f32x2 t; t.x = __builtin_amdgcn_rcpf(d.x); t.y = __builtin_amdgcn_rcpf(d.y);
    f32x2 q = t * 0.5307027145f + (-0.7265760135f); q = q * t + 0.7107068705f; q = q * t + (-0.142248368f); q = q * t + 0.127414796f; q = q * t;
    const f32x2 s = (v * v) * (-0.72134752044f);
    f32x2 e; e.x = __builtin_amdgcn_exp2f(s.x); e.y = __builtin_amdgcn_exp2f(s.y);
    const f32x2 m = v * (q * e), r = v - m;
    f32x2 o; o.x = v.x < 0.f ? m.x : r.x; o.y = v.y < 0.f ? m.y : r.y; return o;
}

struct EpiF32 {
    static constexpr bool PERM = false, AFTER_DRAIN = false;
    float* C; int ldc; const float* bias;
    __device__ __forceinline__ void operator()(const f32x4 (&acc)[2][2][4][2], const Unit& u, int wr, int wc, int fr, int fq) const {
        const int row0 = u.pm * BM + wr * 64 + fr, col0 = u.pn * BM + wc * 32 + 4 * fq;
        f32x4 bv[2][2];
#pragma unroll
        for (int bj = 0; bj < 2; ++bj)
#pragma unroll
            for (int n = 0; n < 2; ++n) bv[bj][n] = bias ? *(const f32x4*)(bias + col0 + bj * HALF + n * 16) : (f32x4){0.f, 0.f, 0.f, 0.f};
#pragma unroll
        for (int ai = 0; ai < 2; ++ai)
#pragma unroll
            for (int m = 0; m < 4; ++m) { float* rowp = C + (size_t)(row0 + ai * HALF + m * 16) * ldc + col0;
#pragma unroll
                for (int bj = 0; bj < 2; ++bj)
#pragma unroll
                    for (int n = 0; n < 2; ++n) *(f32x4*)(rowp + bj * HALF + n * 16) = acc[ai][bj][m][n] + bv[bj][n]; }
    }
};
template <int ACT  > struct EpiBf16 {
    static constexpr bool PERM = true, AFTER_DRAIN = false;
    bf16_t* O; int ldc; const float* bias; int split_cols; size_t split_stride;
    __device__ __forceinline__ void operator()(const f32x4 (&acc)[2][2][4][2], const Unit& u, int wr, int wc, int fr, int fq) const {
        const int row0 = u.pm * BM + wr * 64 + fr; int colt = u.pn * BM; bf16_t* base = O;
        if (split_cols) { const int t = colt / split_cols; base += (size_t)t * split_stride; colt -= t * split_cols; }
        const int col0 = colt + wc * 64 + 8 * fq, bcol0 = u.pn * BM + wc * 64 + 8 * fq;
        f32x4 bv[2][2];
#pragma unroll
        for (int bj = 0; bj < 2; ++bj)
#pragma unroll
            for (int n = 0; n < 2; ++n) bv[bj][n] = bias ? *(const f32x4*)(bias + bcol0 + bj * 32 + 4 * n) : (f32x4){0.f, 0.f, 0.f, 0.f};
#pragma unroll
        for (int ai = 0; ai < 2; ++ai)
#pragma unroll
            for (int m = 0; m < 4; ++m) { bf16_t* rowp = base + (size_t)(row0 + ai * HALF + m * 16) * ldc + col0;
#pragma unroll
                for (int bj = 0; bj < 2; ++bj) { f32x4 v0 = acc[ai][bj][m][0] + bv[bj][0], v1 = acc[ai][bj][m][1] + bv[bj][1];
                    if (ACT == 1) { f32x2 a = gelu_pk((f32x2){v0[0], v0[1]}), b = gelu_pk((f32x2){v0[2], v0[3]}), c = gelu_pk((f32x2){v1[0], v1[1]}), d = gelu_pk((f32x2){v1[2], v1[3]});
                        v0 = (f32x4){a.x, a.y, b.x, b.y}; v1 = (f32x4){c.x, c.y, d.x, d.y}; }
                    if (ACT == 2) {
#pragma unroll
                        for (int j = 0; j < 4; ++j) { v0[j] = 0.5f * v0[j] * (1.0f + erff(v0[j] * 0.70710678f)); v1[j] = 0.5f * v1[j] * (1.0f + erff(v1[j] * 0.70710678f)); } }
                    u32x4 w; w.x = cvt_pk_bf16(v0[0], v0[1]); w.y = cvt_pk_bf16(v0[2], v0[3]); w.z = cvt_pk_bf16(v1[0], v1[1]); w.w = cvt_pk_bf16(v1[2], v1[3]);
#ifdef NT_STORES
                    __builtin_nontemporal_store(w, (u32x4*)(rowp + bj * 32)); } }
#else
                    *(u32x4*)(rowp + bj * 32) = w; } }
#endif
    }
};
template <class Epi, class Sched, bool STAMP = false, bool FP8 = false, int SW = 0x7f7f7f7f, int SX = 0x7f7f7f7f>
__device__ __forceinline__ void gemm_phase(PG8_LAS unsigned char* lds, const Gemm g, const Sched& S, const Epi& E, unsigned long long* stamps) {
    const int tid = threadIdx.x, wid = __builtin_amdgcn_readfirstlane(tid >> 6), lane = tid & 63, wr = wid >> 2, wc = wid & 3, fr = lane & 15, fq = lane >> 4;
    const int K = g.K, nt = K / BK;
    int ts_lo = 0, ts_hi = 0, nts = 0; const unsigned long long rt_entry = STAMP ? (unsigned long long)wall_clock64() : 0ull;
#define PG8_STAMP() do { if (STAMP && wid == 0 && nts < 64) { const unsigned long long _c = (unsigned long long)clock64(); \
        ts_lo = (lane == nts) ? (int)(unsigned)_c : ts_lo; ts_hi = (lane == nts) ? (int)(unsigned)(_c >> 32) : ts_hi; ++nts; } } while (0)
    PG8_STAMP();
    unsigned voffA[2], voffB[2];
#pragma unroll
    for (int i = 0; i < 2; ++i) { int R, C; stage_rc(tid * 16 + i * 8192, R, C); const int Rb = Epi::PERM ? (64 * (R >> 5) + perm32(R & 31)) : R;
        voffA[i] = (unsigned)(R * K + C) * 2u; voffB[i] = (unsigned)(Rb * K + C) * 2u; }
    const size_t kstep = (size_t)(BK * 2);
    const size_t hstep = (size_t)HALF * K * 2;
    const size_t hstepB = Epi::PERM ? (size_t)32 * K * 2 : hstep;
    const size_t tstep = 2 * hstep;
    const unsigned ldsw = (unsigned)wid * 1024u;
    const int aoff = lds_byte(wr * 64 + fr, fq * 8), boff = lds_byte(wc * 32 + fr, fq * 8);
#define PG8_SA(b, h) (((b) * 2 + (h)) * HTB)
#define PG8_SB(b, h) ((4 + (b) * 2 + (h)) * HTB)
#define PG8_STAGE(bufoff, gbase, voff) do { _Pragma("unroll") for (int _i = 0; _i < 2; ++_i) \
        __builtin_amdgcn_global_load_lds((const unsigned*)((const char*)(gbase) + (voff)[_i]), (PG8_LAS unsigned*)(lds + (bufoff) + ldsw + _i * 8192), 16, 0, 0); } while (0)
#define PG8_LDA(dst, b, h) do { _Pragma("unroll") for (int m = 0; m < 4; ++m) _Pragma("unroll") for (int k = 0; k < 2; ++k) dst[m][k] = *(const PG8_LAS bf16x8*)(lds + PG8_SA(b, h) + aoff + m * 2048 + k * 1024); } while (0)
#define PG8_LDB(dst, b, h) do { _Pragma("unroll") for (int n = 0; n < 2; ++n) _Pragma("unroll") for (int k = 0; k < 2; ++k) dst[n][k] = *(const PG8_LAS bf16x8*)(lds + PG8_SB(b, h) + boff + n * 2048 + k * 1024); } while (0)
#define PG8_MMA(ai, bj, At, Bt) do { __builtin_amdgcn_s_setprio(1); _Pragma("unroll") for (int m = 0; m < 4; ++m) _Pragma("unroll") for (int n = 0; n < 2; ++n) { \
        if constexpr (FP8) { asm volatile("v_mfma_scale_f32_16x16x128_f8f6f4 %0, %1, %2, %0, %3, %4 op_sel_hi:[0,0,0]" : "+v"(acc[ai][bj][m][n]) : "v"(pg8_cat(Bt[n][0], Bt[n][1])), "v"(pg8_cat(At[m][0], At[m][1])), "v"(SW), "v"(SX)); } \
        else { _Pragma("unroll") for (int k = 0; k < 2; ++k) acc[ai][bj][m][n] = __builtin_amdgcn_mfma_f32_16x16x32_bf16(Bt[n][k], At[m][k], acc[ai][bj][m][n], 0, 0, 0); } } __builtin_amdgcn_s_setprio(0); } while (0)
#define PG8_WAIT_V(n) asm volatile("s_waitcnt vmcnt(" #n ")" ::: "memory")
#define PG8_WAIT_L(n) asm volatile("s_waitcnt lgkmcnt(" #n ")" ::: "memory")
#define PG8_BAR __builtin_amdgcn_s_barrier()
#define PG8_SCHED __builtin_amdgcn_sched_barrier(0)
    Unit cur, nxt; int ui = 0;
    if (!S.next(0, cur)) return;
    f32x4 acc[2][2][4][2];
#pragma unroll
    for (int a = 0; a < 2; ++a)
#pragma unroll
        for (int b = 0; b < 2; ++b)
#pragma unroll
            for (int m = 0; m < 4; ++m)
#pragma unroll
                for (int n = 0; n < 2; ++n) acc[a][b][m][n] = (f32x4){0.f, 0.f, 0.f, 0.f};
    bf16x8 At[4][2], B0[2][2], B1[2][2];
    const char* cA = (const char*)g.A + (size_t)cur.pm * tstep; const char* cB = (const char*)g.Bt + (size_t)cur.pn * tstep;
    S.a_ready(cur);
    PG8_STAGE(PG8_SB(0, 0), cB, voffB); PG8_STAGE(PG8_SA(0, 0), cA, voffA); PG8_STAGE(PG8_SB(0, 1), cB + hstepB, voffB); PG8_STAGE(PG8_SA(0, 1), cA + hstep, voffA);
    if (wr == 1) PG8_BAR;
    PG8_WAIT_V(4); PG8_BAR;
    PG8_STAGE(PG8_SB(1, 0), cB + kstep, voffB); PG8_STAGE(PG8_SA(1, 0), cA + kstep, voffA); PG8_STAGE(PG8_SB(1, 1), cB + hstepB + kstep, voffB);
    PG8_WAIT_V(6); PG8_BAR;
    PG8_STAMP();
    for (;;) {
        const bool has_next = S.next(ui + 1, nxt);
        const char* nA = has_next ? (const char*)g.A + (size_t)nxt.pm * tstep : cA; const char* nB = has_next ? (const char*)g.Bt + (size_t)nxt.pn * tstep : cB;
        for (int t = 0; t < nt; t += 2) {
            const bool last = (t == nt - 2);
            const char* a1 = cA + (size_t)(t + 1) * kstep;
            const char* a2 = last ? nA : cA + (size_t)(t + 2) * kstep; const char* b2 = last ? nB : cB + (size_t)(t + 2) * kstep;
            const char* a3 = a2 + kstep; const char* b3 = b2 + kstep;
            if (last && has_next) S.a_ready(nxt);
            PG8_LDB(B0, 0, 0); PG8_SCHED; PG8_LDA(At, 0, 0); PG8_STAGE(PG8_SA(1, 1), a1 + hstep, voffA);
            PG8_WAIT_L(8); PG8_BAR; PG8_WAIT_L(0); PG8_MMA(0, 0, At, B0); PG8_BAR; PG8_SCHED;
            PG8_LDB(B1, 0, 1); PG8_STAGE(PG8_SB(0, 0), b2, voffB);
            PG8_BAR; PG8_WAIT_L(0); PG8_MMA(0, 1, At, B1); PG8_BAR;
            PG8_LDA(At, 0, 1); PG8_STAGE(PG8_SA(0, 0), a2, voffA);
            PG8_BAR; PG8_WAIT_L(0); PG8_MMA(1, 0, At, B0); PG8_BAR; PG8_SCHED;
            PG8_STAGE(PG8_SB(0, 1), b2 + hstepB, voffB);
            PG8_WAIT_V(6); PG8_BAR; PG8_MMA(1, 1, At, B1); PG8_BAR;
            PG8_LDB(B0, 1, 0); PG8_SCHED; PG8_LDA(At, 1, 0); PG8_STAGE(PG8_SA(0, 1), a2 + hstep, voffA);
            PG8_WAIT_L(8); PG8_BAR; PG8_WAIT_L(0); PG8_MMA(0, 0, At, B0); PG8_BAR; PG8_SCHED;
            PG8_LDB(B1, 1, 1); PG8_STAGE(PG8_SB(1, 0), b3, voffB);
            PG8_BAR; PG8_WAIT_L(0); PG8_MMA(0, 1, At, B1); PG8_BAR;
            PG8_LDA(At, 1, 1); PG8_STAGE(PG8_SA(1, 0), a3, voffA);
            PG8_BAR; PG8_WAIT_L(0); PG8_MMA(1, 0, At, B0); PG8_BAR; PG8_SCHED;
            PG8_STAGE(PG8_SB(1, 1), b3 + hstepB, voffB);
            PG8_WAIT_V(6); PG8_BAR; PG8_MMA(1, 1, At, B1); PG8_BAR;
        }
        PG8_STAMP();
        if constexpr (FP8) asm volatile("s_nop 15\n\ts_nop 15" ::: "memory");
        if constexpr (!Epi::AFTER_DRAIN) { E(acc, cur, wr, wc, fr, fq); S.done(cur); }
        PG8_STAMP();
        if (!has_next) break;
#pragma unroll
        for (int a = 0; a < 2; ++a)
#pragma unroll
            for (int b = 0; b < 2; ++b)
#pragma unroll
                for (int m = 0; m < 4; ++m)
#pragma unroll
                    for (int n = 0; n < 2; ++n) acc[a][b][m][n] = (f32x4){0.f, 0.f, 0.f, 0.f};
        cur = nxt; cA = nA; cB = nB; ++ui;
    }
    PG8_WAIT_V(0);
    if (wr == 0) PG8_BAR;
    PG8_BAR;
    if constexpr (Epi::AFTER_DRAIN) { E.fused(acc, cur, wr, wc, fr, fq, lds, wid, lane); S.done(cur); }
    PG8_STAMP();
    if (STAMP && wid == 0) { stamps[lane] = lane < nts ? (((unsigned long long)(unsigned)ts_hi << 32) | (unsigned)ts_lo) : 0ull;
        if (lane == 62) stamps[62] = rt_entry; if (lane == 63) stamps[63] = (unsigned long long)wall_clock64(); }
#undef PG8_STAMP
#undef PG8_SA
#undef PG8_SB
#undef PG8_STAGE
#undef PG8_LDA
#undef PG8_LDB
#undef PG8_MMA
#undef PG8_WAIT_V
#undef PG8_WAIT_L
#undef PG8_BAR
#undef PG8_SCHED
}
}
#define XB_TMO      128
#define XB_XCNT(j)  (256  + 64 * (j))
#define XB_XSUB(j)  (1280 + 64 * (j))
#define XB_XGEN(j)  (2304 + 64 * (j))
#define XB_TOP      3328
#define XB_TOPGEN   3392
#define XCD_BAR_WORDS 3456
#define XB_SPIN_CAP (1u << 18)

__device__ __forceinline__ unsigned xb_ld(unsigned* p)              { return __hip_atomic_load(p, __ATOMIC_RELAXED, __HIP_MEMORY_SCOPE_AGENT); }
__device__ __forceinline__ unsigned xb_add(unsigned* p, unsigned v) { return __hip_atomic_fetch_add(p, v, __ATOMIC_RELAXED, __HIP_MEMORY_SCOPE_AGENT); }
__device__ __forceinline__ unsigned xb_xcc_id() { return (unsigned)__builtin_amdgcn_s_getreg((3 << 11) | 20) & 0xFu; }
#define XB_SPIN(cond, bar) do { unsigned _sp = 0; while (cond) { __builtin_amdgcn_s_sleep(1); \
    if ((++_sp & 255u) == 0u) { if (xb_ld(&(bar)[XB_TMO])) break; if (_sp > XB_SPIN_CAP) { atomicAdd(&(bar)[XB_TMO], 1u); break; } } } } while (0)

struct XcdBarrier {
    unsigned* bar; unsigned x;
    volatile LAS unsigned* st;
};

__device__ __forceinline__ XcdBarrier xcd_barrier_post(unsigned* bar, volatile LAS unsigned* st) {
    XcdBarrier b; b.bar = bar; b.x = xb_xcc_id(); b.st = st;
    if (threadIdx.x == 0) (void)xb_add(&bar[XB_XCNT(b.x)], 1u);
    return b;
}
__device__ __forceinline__ void xcd_barrier_complete(unsigned* bar, unsigned x, unsigned& nloc, unsigned& nx) {
    const unsigned G = gridDim.x * gridDim.y * gridDim.z;
    unsigned sum, cnt, mine, sp = 0u;
    for (;;) {
        sum = 0u; cnt = 0u; mine = 0u;
#pragma unroll
        for (unsigned j = 0; j < 16; ++j) { const unsigned c = xb_ld(&bar[XB_XCNT(j)]); sum += c; cnt += (c > 0u) ? 1u : 0u; mine = (j == x) ? c : mine; }
        if (sum == G) break;
        __builtin_amdgcn_s_sleep(1);
        if ((++sp & 255u) == 0u) { if (xb_ld(&bar[XB_TMO])) break; if (sp > XB_SPIN_CAP) { atomicAdd(&bar[XB_TMO], 1u); break; } }
    }
    nloc = mine > 0u ? mine : 1u; nx = cnt > 0u ? cnt : 1u;
}

__device__ __forceinline__ void xcd_barrier(const XcdBarrier& b) {
    asm volatile("s_waitcnt vmcnt(0)" ::: "memory");
    __syncthreads();
    if (threadIdx.x == 0) {
        unsigned* bar = b.bar;
        __builtin_amdgcn_s_waitcnt(0);
        unsigned nloc = b.st[0], nx = b.st[1];
        if (nloc == 0u) { xcd_barrier_complete(bar, b.x, nloc, nx); b.st[0] = nloc; b.st[1] = nx; }
        const unsigned old = xb_add(&bar[XB_XSUB(b.x)], 1u);
        const unsigned gen = old / nloc;
        if (old + 1u == (gen + 1u) * nloc) {
            __builtin_amdgcn_fence(__ATOMIC_RELEASE, "agent");
            asm volatile("s_waitcnt vmcnt(0)" ::: "memory");
            const unsigned og = xb_add(&bar[XB_TOP], 1u);
            const unsigned tg = og / nx;
            if (og + 1u == (tg + 1u) * nx) xb_add(&bar[XB_TOPGEN], 1u);
            else XB_SPIN(xb_ld(&bar[XB_TOPGEN]) == tg, bar);
            __builtin_amdgcn_fence(__ATOMIC_ACQUIRE, "agent");
            xb_add(&bar[XB_XGEN(b.x)], 1u);
            asm volatile("s_waitcnt vmcnt(0)" ::: "memory");
        } else {
            XB_SPIN(xb_ld(&bar[XB_XGEN(b.x)]) == gen, bar);
            __builtin_amdgcn_fence(__ATOMIC_ACQUIRE, "agent");
            asm volatile("s_waitcnt vmcnt(0)" ::: "memory");
        }
    }
    __syncthreads();
}

struct Args { const float* in[34]; float* out; unsigned char* ws; int ph_lo, ph_hi; };
struct Frame { LAS unsigned char* lds; int tid, lane, wave, G, bid; };

#define MFMA16(a, b, c) __builtin_amdgcn_mfma_f32_16x16x32_bf16((a), (b), (c), 0, 0, 0)

struct TrDesc { const float* src; unsigned char* dst; int ldw, K, fp8, nvalid; float sc; };
__device__ __forceinline__ void tr_load(const TrDesc& d, int lane, v4f (&v)[16]) {
    const unsigned long long sp = (unsigned long long)d.src;
    unsigned long long pa = ((unsigned long long)(unsigned)__builtin_amdgcn_readfirstlane((int)(sp >> 32)) << 32) | (unsigned)__builtin_amdgcn_readfirstlane((int)sp);
    const int ldw = __builtin_amdgcn_readfirstlane(d.ldw);
    if (__builtin_amdgcn_readfirstlane(d.fp8)) {
        const unsigned long long step = (unsigned long long)(8 * ldw) * 4ull; const size_t lo = (size_t)(lane >> 3) * ldw + 4 * (lane & 7);
#pragma unroll
        for (int i = 0; i < 16; ++i) { asm volatile("" : "+s"(pa)); v[i] = *(const v4f*)((const float*)pa + lo); pa += step; }
    } else {
        const unsigned long long step = (unsigned long long)(4 * ldw) * 4ull; const size_t lo = (size_t)(lane >> 4) * ldw + 4 * (lane & 15);
#pragma unroll
        for (int i = 0; i < 16; ++i) { asm volatile("" : "+s"(pa)); v[i] = *(const v4f*)((const float*)pa + lo); pa += step; }
    }
}
__device__ __forceinline__ void tr_store(const TrDesc& d, int lane, const v4f (&v)[16], LAS float* scr) {
    if (d.fp8) {
        { LAS float* w = scr + (lane >> 3) * 33 + 4 * (lane & 7);
#pragma unroll
          for (int i = 0; i < 16; ++i) { w[(8 * i) * 33 + 0] = v[i].x; w[(8 * i) * 33 + 1] = v[i].y; w[(8 * i) * 33 + 2] = v[i].z; w[(8 * i) * 33 + 3] = v[i].w; } }
        LDS_WAIT(); asm volatile("" ::: "memory");
        const int c = lane & 7; const float sc = d.sc;
#pragma unroll
        for (int j = 0; j < 4; ++j) { const int n = (lane >> 3) + 8 * j; const LAS float* s = scr + (16 * c) * 33 + n;
            v4u o; o.x = pk4_fp8(s[0 * 33] * sc, s[1 * 33] * sc, s[2 * 33] * sc, s[3 * 33] * sc); o.y = pk4_fp8(s[4 * 33] * sc, s[5 * 33] * sc, s[6 * 33] * sc, s[7 * 33] * sc);
            o.z = pk4_fp8(s[8 * 33] * sc, s[9 * 33] * sc, s[10 * 33] * sc, s[11 * 33] * sc); o.w = pk4_fp8(s[12 * 33] * sc, s[13 * 33] * sc, s[14 * 33] * sc, s[15 * 33] * sc);
            *(v4u*)(d.dst + (size_t)n * d.K + 16 * c) = o; }
    } else {
        { LAS float* w = scr + (lane >> 4) * 65 + 4 * (lane & 15);
#pragma unroll
          for (int i = 0; i < 16; ++i) { w[(4 * i) * 65 + 0] = v[i].x; w[(4 * i) * 65 + 1] = v[i].y; w[(4 * i) * 65 + 2] = v[i].z; w[(4 * i) * 65 + 3] = v[i].w; } }
        LDS_WAIT(); asm volatile("" ::: "memory");
        const int c = lane & 7;
#pragma unroll
        for (int j = 0; j < 8; ++j) { const int n = (lane >> 3) + 8 * j; const LAS float* s = scr + (8 * c) * 65 + n;
            v4u o; o.x = pk2(s[0 * 65], s[1 * 65]); o.y = pk2(s[2 * 65], s[3 * 65]); o.z = pk2(s[4 * 65], s[5 * 65]); o.w = pk2(s[6 * 65], s[7 * 65]);
            if (n < d.nvalid) *(v4u*)(d.dst + ((size_t)n * d.K + 8 * c) * 2) = o; }
    }
    LDS_WAIT(); asm volatile("" ::: "memory");
}
constexpr int I_E1 = 64 * 128, I_E2 = 64 * 64, I_AB = 64, I_OE = 64 * 64, I_IO = 64 * 112, I_OO = 48 * 64, I_WQ = 64 * 32, I_GL = 16 * 16, I_RG = 128, I_V = 256 * 64;
constexpr int TR_N0 = I_E1 + I_E2 + I_AB, TR_N1 = I_OE + I_WQ + I_GL + I_RG + I_V, TR_N2 = I_IO + I_OO + I_WQ + I_V;
__device__ __forceinline__ TrDesc tr_decode(const Args& a, const int part, int r) {
    unsigned char* ws = a.ws; TrDesc d;
#define TR_MK(W_, ldw_, scol0_, K_, dst_, fp8_, drow0_, r_, nblk64_, sc_, nv_) do { const int r__ = (r_), nbk__ = (fp8_) ? (nblk64_) * 2 : (nblk64_), kb__ = r__ / nbk__, nb__ = r__ % nbk__, kt__ = (fp8_) ? 128 : 64, nt__ = (fp8_) ? 32 : 64; \
        d.src = (W_) + (size_t)(kt__ * kb__) * (ldw_) + (scol0_) + nt__ * nb__; d.ldw = (ldw_); d.K = (K_); d.fp8 = (fp8_); d.sc = (sc_); d.nvalid = (nv_); \
        d.dst = (unsigned char*)(dst_) + ((size_t)((drow0_) + nt__ * nb__) * (K_) + kt__ * kb__) * ((fp8_) ? 1 : 2); return d; } while (0)
    if (part == 0) {
        if (r < I_E1) TR_MK(a.in[1], EVEN_IN_SRC, 0, DM, ws + WS_WINE, FP8_INE, 0, r, 128, WIN8_SCALE, 64); r -= I_E1;
        if (r < I_E2) TR_MK(a.in[1], EVEN_IN_SRC, 8224, DM, ws + WS_WINE, FP8_INE, 8192, r, 64, WIN8_SCALE, 64); r -= I_E2;
        TR_MK(a.in[1], EVEN_IN_SRC, 8192, DM, ws + WS_WAB, 0, 0, r, 1, 1.f, 32);
    } else if (part == 1) {
        if (r < I_OE) TR_MK(a.in[13], DM, 0, DM, ws + WS_WOUTE, FP8_OUT, 0, r, 64, WOUT8_SCALE, 64); r -= I_OE;
        if (r < I_WQ) TR_MK(a.in[28], PQ, 0, DM, ws + WS_WQ0, FP8_WQ, 0, r, 32, WIN8_SCALE, 64); r -= I_WQ;
        if (r < I_GL) TR_MK(a.in[23], S5W, 0, S5W, ws + WS_GLU, 0, 0, r, 16, 1.f, 64); r -= I_GL;
        if (r < I_RG) { const int n = r >> 3, which = (r >> 2) & 1; TR_MK((which ? a.in[10] : a.in[8]) + (size_t)n * RGB * RGB, RGB, 0, RGB, ws + WS_RGW + (size_t)n * 256 * RGB * 2, 0, which * 128, r & 3, 2, 1.f, 64); } r -= I_RG;
        TR_MK(a.in[31], DM, 0, PE, ws + WS_VT8_0, 1, 0, r, 64, V8_SCALE, 64);
    } else {
        if (r < I_IO) TR_MK(a.in[14], ODD_IN, 0, DM, ws + WS_WINO, FP8_INO, 0, r, 112, WIN8_SCALE, 64); r -= I_IO;
        if (r < I_OO) TR_MK(a.in[25], DM, 0, ODD_MIX, ws + WS_WOUTO, FP8_OUT, 0, r, 64, WOUT8_SCALE, 64); r -= I_OO;
        if (r < I_WQ) TR_MK(a.in[28] + (size_t)DM * PQ, PQ, 0, DM, ws + WS_WQ1, FP8_WQ, 0, r, 32, WIN8_SCALE, 64); r -= I_WQ;
        TR_MK(a.in[31] + (size_t)PE * DM, DM, 0, PE, ws + WS_VT8_1, 1, 0, r, 64, V8_SCALE, 64);
    }
#undef TR_MK
}
__device__ __forceinline__ void p0_prologue(const Args& a, Frame& F, const int part) {
    unsigned char* ws = a.ws;
    LAS float* scr = (LAS float*)(F.lds + F.wave * 16896);
    const int gw = F.bid * NWAVES + F.wave, NGW = F.G * NWAVES;
#ifndef REP_TR
#define REP_TR 1
#endif
#ifndef REP_ST
#define REP_ST 1
#endif
    _Pragma("unroll 1") for (int rp_ = 0; rp_ < REP_TR; ++rp_)
    {   const int it_hi = part == 0 ? TR_N0 : (part == 1 ? TR_N1 : TR_N2);
        v4f v[16], nv[16]; TrDesc d = tr_decode(a, part, gw < it_hi ? gw : 0), nd = d;
        if (gw < it_hi) tr_load(d, F.lane, v);
        for (int it = gw; it < it_hi; it += NGW) {
            const bool more = it + NGW < it_hi;
            if (more) { nd = tr_decode(a, part, it + NGW); tr_load(nd, F.lane, nv); }
            tr_store(d, F.lane, v, scr);
            d = nd;
#pragma unroll
            for (int i = 0; i < 16; ++i) v[i] = nv[i];
        }
    }
    const size_t gtid = (size_t)F.bid * NTHR + F.tid, gsize = (size_t)F.G * NTHR;
    _Pragma("unroll 1") for (int rp_ = 0; rp_ < REP_ST; ++rp_) {
    if (part == 0)
    {
        const float* xs = a.in[0]; bf16* xb = (bf16*)(ws + WS_XB0); unsigned char* x8 = ws + WS_X8_0;
        const size_t n16 = (size_t)NTOK * DM / 16;
        for (size_t i = gtid; i < n16; i += 2 * gsize) {
            v4f f[2][4];
#pragma unroll
            for (int u = 0; u < 2; ++u) { const size_t ii = i + u * gsize; if (ii < n16) {
#pragma unroll
                for (int j = 0; j < 4; ++j) f[u][j] = *(const v4f*)(xs + 16 * ii + 4 * j); } }
#pragma unroll
            for (int u = 0; u < 2; ++u) { const size_t ii = i + u * gsize; if (ii < n16) {
                v4u o0, o1; o0.x = pk2(f[u][0].x, f[u][0].y); o0.y = pk2(f[u][0].z, f[u][0].w); o0.z = pk2(f[u][1].x, f[u][1].y); o0.w = pk2(f[u][1].z, f[u][1].w);
                o1.x = pk2(f[u][2].x, f[u][2].y); o1.y = pk2(f[u][2].z, f[u][2].w); o1.z = pk2(f[u][3].x, f[u][3].y); o1.w = pk2(f[u][3].z, f[u][3].w);
                *(v4u*)(xb + 16 * ii) = o0; *(v4u*)(xb + 16 * ii + 8) = o1;
                if (FP8_INE) { v4u o; o.x = pk4_fp8(f[u][0].x, f[u][0].y, f[u][0].z, f[u][0].w); o.y = pk4_fp8(f[u][1].x, f[u][1].y, f[u][1].z, f[u][1].w); o.z = pk4_fp8(f[u][2].x, f[u][2].y, f[u][2].z, f[u][2].w); o.w = pk4_fp8(f[u][3].x, f[u][3].y, f[u][3].z, f[u][3].w);
                    *(v4u*)(x8 + 16 * ii) = o; } } }
        }
    }
    if (part == 1)
    {
        const float* ks = a.in[29]; bf16* kh = (bf16*)(ws + WS_KH); bf16* kl = (bf16*)(ws + WS_KL);
        for (size_t i = gtid; i < (size_t)2 * PH * 2 * PNK * PHALF / 8; i += gsize) { const v4f x = *(const v4f*)(ks + 8 * i), y = *(const v4f*)(ks + 8 * i + 4);
            v4u h; h.x = pk2(x.x, x.y); h.y = pk2(x.z, x.w); h.z = pk2(y.x, y.y); h.w = pk2(y.z, y.w);
            v4u l; l.x = pk2(x.x - bflo(h.x), x.y - bfhi(h.x)); l.y = pk2(x.z - bflo(h.y), x.w - bfhi(h.y)); l.z = pk2(y.x - bflo(h.z), y.y - bfhi(h.z)); l.w = pk2(y.z - bflo(h.w), y.w - bfhi(h.w));
            const size_t blk = i >> 11; const int n = (int)(i >> 4) & 127, d8 = (int)i & 15; const size_t j = (blk << 11) + (size_t)((((n >> 4) * 4 + (d8 >> 2)) * 64) + (d8 & 3) * 16 + (n & 15));
            *(v4u*)(kh + 8 * j) = h; *(v4u*)(kl + 8 * j) = l; }
    }
    if (part >= 1)
    {
        const float* us = a.in[30] + (size_t)(part - 1) * PE * DM; unsigned char* u8 = ws + (part == 1 ? WS_U8_0 : WS_U8_1);
        const size_t n16 = (size_t)PE * DM / 16; const float sc = U8_SCALE;
        for (size_t i = gtid; i < n16; i += 4 * gsize) {
            v4f f[4][4];
#pragma unroll
            for (int u = 0; u < 4; ++u) { const size_t ii = i + u * gsize; if (ii < n16) {
#pragma unroll
                for (int j = 0; j < 4; ++j) f[u][j] = *(const v4f*)(us + 16 * ii + 4 * j); } }
#pragma unroll
            for (int u = 0; u < 4; ++u) { const size_t ii = i + u * gsize; if (ii < n16) {
                v4u o; o.x = pk4_fp8(f[u][0].x * sc, f[u][0].y * sc, f[u][0].z * sc, f[u][0].w * sc); o.y = pk4_fp8(f[u][1].x * sc, f[u][1].y * sc, f[u][1].z * sc, f[u][1].w * sc);
                o.z = pk4_fp8(f[u][2].x * sc, f[u][2].y * sc, f[u][2].z * sc, f[u][2].w * sc); o.w = pk4_fp8(f[u][3].x * sc, f[u][3].y * sc, f[u][3].z * sc, f[u][3].w * sc);
                *(v4u*)(u8 + 16 * ii) = o; } }
        }
    }
    }
}

__device__ __forceinline__ void gdn_prep_phase(const Args& a, Frame& F) {
    const bf16* proj = (const bf16*)(a.ws + WS_HB);
    bf16* qkvn = (bf16*)(a.ws + WS_WB);
    const float* cw = a.in[2];
    const int gw = F.bid * NWAVES + F.wave, NGW = F.G * NWAVES;
    for (int it = gw; it < 12 * 512; it += NGW) {
        const int tg = it / 12, j = it % 12, c0 = j * 512 + F.lane * 8, t0 = tg * 16;
        float w[4][8];
#pragma unroll
        for (int k = 0; k < 4; ++k) { const v4f w0 = *(const v4f*)(cw + k * 6144 + c0), w1 = *(const v4f*)(cw + k * 6144 + c0 + 4);
            w[k][0] = w0.x; w[k][1] = w0.y; w[k][2] = w0.z; w[k][3] = w0.w; w[k][4] = w1.x; w[k][5] = w1.y; w[k][6] = w1.z; w[k][7] = w1.w; }
        float xm3[8], xm2[8], xm1[8], xc[8];
        if ((t0 & (SEQ - 1)) == 0) {
#pragma unroll
            for (int e = 0; e < 8; ++e) { xm3[e] = 0.f; xm2[e] = 0.f; xm1[e] = 0.f; }
        } else {
            unpack8(*(const v4u*)(proj + (size_t)(t0 - 3) * EVEN_IN + c0), xm3);
            unpack8(*(const v4u*)(proj + (size_t)(t0 - 2) * EVEN_IN + c0), xm2);
            unpack8(*(const v4u*)(proj + (size_t)(t0 - 1) * EVEN_IN + c0), xm1);
        }
        bf16* dst = qkvn + (size_t)(j >> 2) * NTOK * GW + (size_t)(j & 3) * 512 + F.lane * 8;
        v4u rw[16];
#pragma unroll
        for (int i = 0; i < 16; ++i) rw[i] = *(const v4u*)(proj + (size_t)(t0 + i) * EVEN_IN + c0);
#pragma unroll
        for (int i = 0; i < 16; ++i) {
            const int t = t0 + i;
            unpack8(rw[i], xc);
            float y[8]; float ss = 0.f;
#pragma unroll
            for (int e = 0; e < 8; ++e) { float v = w[0][e] * xm3[e] + w[1][e] * xm2[e] + w[2][e] * xm1[e] + w[3][e] * xc[e]; v = siluf_(v); y[e] = v; ss += v * v; }
            if (j < 8) {
                ss = row16_sum(ss);
                float r = rsqrtf(ss + RMS_EPS); if (j < 4) r *= 0.08838834764831845f;
#pragma unroll
                for (int e = 0; e < 8; ++e) y[e] *= r;
            }
            *(v4u*)(dst + (size_t)t * GW) = pack8(y);
#pragma unroll
            for (int e = 0; e < 8; ++e) { xm3[e] = xm2[e]; xm2[e] = xm1[e]; xm1[e] = xc[e]; }
        }
    }
}

__device__ __forceinline__ void ab_proj_phase(const Args& a, Frame& F) {
    const bf16* xb = (const bf16*)(a.ws + WS_XB0);
    const bf16* wab = (const bf16*)(a.ws + WS_WAB);
    float* beta = (float*)(a.ws + WS_BETA); float* eg = (float*)(a.ws + WS_EG);
    LAS float* red = (LAS float*)F.lds;
    const int m = F.lane & 15, q = F.lane >> 4;
    for (int blk = F.bid; blk < NTOK / 32; blk += F.G) {
        const int r0 = blk * 32;
        v4f acc[2][2];
#pragma unroll
        for (int i = 0; i < 2; ++i)
#pragma unroll
            for (int j = 0; j < 2; ++j) acc[i][j] = (v4f){0.f, 0.f, 0.f, 0.f};
        for (int ks = 0; ks < 16; ++ks) {
            const int k = F.wave * 512 + ks * 32 + 8 * q;
            v8s af[2], bfr[2];
#pragma unroll
            for (int i = 0; i < 2; ++i) { af[i] = *(const v8s*)(xb + (size_t)(r0 + 16 * i + m) * DM + k); bfr[i] = *(const v8s*)(wab + (size_t)(16 * i + m) * DM + k); }
#pragma unroll
            for (int i = 0; i < 2; ++i)
#pragma unroll
                for (int j = 0; j < 2; ++j) acc[i][j] = MFMA16(bfr[j], af[i], acc[i][j]);
        }
#pragma unroll
        for (int i = 0; i < 2; ++i)
#pragma unroll
            for (int j = 0; j < 2; ++j) *(LAS v4f*)(red + ((F.wave * 4 + i * 2 + j) * 64 + F.lane) * 4) = acc[i][j];
        __syncthreads();
        for (int o = F.tid; o < 1024; o += NTHR) {
            float s = 0.f;
#pragma unroll
            for (int w = 0; w < 8; ++w) s += red[w * 1024 + o];
            const int tile = o >> 8, ln = (o >> 2) & 63, r = o & 3, i = tile >> 1, j = tile & 1;
            const int row = r0 + 16 * i + (ln & 15), col = 16 * j + 4 * (ln >> 4) + r;
            if (col < 16) { const float g = -__expf(a.in[3][col]) * softplusf_(s + a.in[4][col]); eg[(size_t)row * 16 + col] = g; }
            else beta[(size_t)row * 16 + (col - 16)] = sigmoidf_(s);
        }
        __syncthreads();
    }
}

__device__ __forceinline__ void rg_gates_phase(const Args& a, Frame& F) {
    const bf16* proj = (const bf16*)(a.ws + WS_HB);
    const bf16* rgw = (const bf16*)(a.ws + WS_RGW);
    unsigned* ABout = (unsigned*)(a.ws + WS_A);
    const float* convw = a.in[6]; const float* convb = a.in[7]; const float* ba = a.in[9]; const float* bx = a.in[11]; const float* lam = a.in[12];
    LAS float* xr = (LAS float*)F.lds;
    LAS bf16* Bw = (LAS bf16*)(F.lds + 33792);
    LAS float* cw = (LAS float*)(F.lds + 33792 + 69632);
    const int rt = F.wave & 3, ch = F.wave >> 2, m = F.lane & 15, q = F.lane >> 4;
    const int tl = F.tid >> 3, cg = (F.tid & 7) * 16;
    int cur_n = -1;
    float kba[4][4], kbx[4][4], ksp[4][4];
    v4u raw[4][2];
#define RG_LOAD(u_) do { const int t_ = ((u_) >> 4) * 64 + tl, ts_ = t_ & (SEQ - 1), n_ = (u_) & 15; \
        _Pragma("unroll") for (int k = 0; k < 4; ++k) { const bool ok_ = ts_ + k - 3 >= 0; const bf16* p_ = proj + (size_t)(t_ + (ok_ ? k - 3 : 0)) * EVEN_IN + PE_RGIN + n_ * 128 + cg; \
            raw[k][0] = *(const v4u*)p_; raw[k][1] = *(const v4u*)(p_ + 8); if (!ok_) { raw[k][0] = (v4u){0u, 0u, 0u, 0u}; raw[k][1] = (v4u){0u, 0u, 0u, 0u}; } } } while (0)
    if (F.bid < 2048) RG_LOAD(F.bid);
    for (int u = F.bid; u < 2048; u += F.G) {
        const int tt = u >> 4, n = u & 15, t0 = tt * 64;
        __syncthreads();
        if (n != cur_n) {
            cur_n = n;
#pragma unroll
            for (int i = 0; i < 8; ++i) { const int f = F.tid + NTHR * i, row = f >> 4, c8 = (f & 15) * 8; *(LAS v4u*)(Bw + row * 136 + c8) = *(const v4u*)(rgw + ((size_t)n * 256 + row) * RGB + c8); }
            for (int o = F.tid; o < 640; o += NTHR) { const int k = o >> 7, c = o & 127; cw[o] = (k < 4) ? convw[k * RGW + n * 128 + c] : convb[n * 128 + c]; }
#pragma unroll
            for (int jj = 0; jj < 4; ++jj) { const int C = n * 128 + 16 * (4 * ch + jj) + 4 * q;
                const v4f b0 = *(const v4f*)(ba + C), b1 = *(const v4f*)(bx + C), lm = *(const v4f*)(lam + C);
#pragma unroll
                for (int r = 0; r < 4; ++r) { kba[jj][r] = b0[r]; kbx[jj][r] = b1[r]; ksp[jj][r] = 8.0f * softplusf_(-lm[r]); } }
            __syncthreads();
        }
        {
#pragma unroll
            for (int hh = 0; hh < 2; ++hh) {
                float acc[8];
                { const v4f b0 = *(const LAS v4f*)(cw + 512 + cg + hh * 8), b1 = *(const LAS v4f*)(cw + 512 + cg + hh * 8 + 4); acc[0] = b0.x; acc[1] = b0.y; acc[2] = b0.z; acc[3] = b0.w; acc[4] = b1.x; acc[5] = b1.y; acc[6] = b1.z; acc[7] = b1.w; }
#pragma unroll
                for (int k = 0; k < 4; ++k) { float x[8]; unpack8(raw[k][hh], x);
                    const v4f w0 = *(const LAS v4f*)(cw + k * 128 + cg + hh * 8), w1 = *(const LAS v4f*)(cw + k * 128 + cg + hh * 8 + 4);
                    acc[0] += w0.x * x[0]; acc[1] += w0.y * x[1]; acc[2] += w0.z * x[2]; acc[3] += w0.w * x[3]; acc[4] += w1.x * x[4]; acc[5] += w1.y * x[5]; acc[6] += w1.z * x[6]; acc[7] += w1.w * x[7]; }
                *(LAS v4f*)(xr + tl * 132 + cg + hh * 8) = (v4f){acc[0], acc[1], acc[2], acc[3]};
                *(LAS v4f*)(xr + tl * 132 + cg + hh * 8 + 4) = (v4f){acc[4], acc[5], acc[6], acc[7]};
            }
        }
        LDS_BARRIER();
        if (u + F.G < 2048) RG_LOAD(u + F.G);
        {   v8s Af[4];
#pragma unroll
            for (int ks = 0; ks < 4; ++ks) { const v4f x0 = *(const LAS v4f*)(xr + (16 * rt + m) * 132 + 32 * ks + 8 * q), x1 = *(const LAS v4f*)(xr + (16 * rt + m) * 132 + 32 * ks + 8 * q + 4);
                v4u p; p.x = pk2(x0.x, x0.y); p.y = pk2(x0.z, x0.w); p.z = pk2(x1.x, x1.y); p.w = pk2(x1.z, x1.w); Af[ks] = __builtin_bit_cast(v8s, p); }
#pragma unroll
            for (int jj = 0; jj < 4; ++jj) {
                const int jt = 4 * ch + jj;
                v4f accr = (v4f){0.f, 0.f, 0.f, 0.f}, acci = (v4f){0.f, 0.f, 0.f, 0.f};
#pragma unroll
                for (int ks = 0; ks < 4; ++ks) {
                    const v8s Br = *(const LAS v8s*)(Bw + (16 * jt + m) * 136 + 32 * ks + 8 * q);
                    const v8s Bi = *(const LAS v8s*)(Bw + (128 + 16 * jt + m) * 136 + 32 * ks + 8 * q);
                    accr = MFMA16(Br, Af[ks], accr); acci = MFMA16(Bi, Af[ks], acci);
                }
                const int cc = 16 * jt + 4 * q, C = n * 128 + cc, row = 16 * rt + m;
                const v4f xv = *(const LAS v4f*)(xr + row * 132 + cc);
                v4u pk;
#pragma unroll
                for (int r = 0; r < 4; ++r) {
                    const float rr = sigmoidf_(accr[r] + kba[jj][r]), ii = sigmoidf_(acci[r] + kbx[jj][r]);
                    const float la = -rr * ksp[jj][r], x2 = 2.0f * la;
                    const float om = (x2 > -0.125f) ? -x2 * (1.0f + x2 * (0.5f + x2 * (0.16666667f + x2 * (0.041666668f + x2 * 0.0083333333f)))) : 1.0f - __expf(x2);
                    pk[r] = pk2(la, __builtin_amdgcn_sqrtf(fmaxf(om, 0.f)) * (ii * xv[r]));
                }
                *(v4u*)(ABout + (size_t)(t0 + row) * RGW + C) = pk;
            }
        }
    }
#undef RG_LOAD
}

constexpr size_t GDN_O = WS_WB + 96 * MiB, GDN_UT = WS_WB + 160 * MiB, GDN_W = WS_RES, GDN_QD = WS_RES + 32 * MiB, GDN_KT = WS_RES + 64 * MiB, GDN_AQK = WS_RES + 96 * MiB, GDN_GL = WS_RES + 112 * MiB;

__device__ __forceinline__ void gdn_chunk_prep_phase(const Args& a, Frame& F) {
    const bf16* qb = (const bf16*)(a.ws + WS_WB); const bf16* kb = qb + (size_t)NTOK * GW; const bf16* vb = kb + (size_t)NTOK * GW;
    const float* G = (const float*)(a.ws + WS_EG); const float* beta = (const float*)(a.ws + WS_BETA);
    float* UT = (float*)(a.ws + GDN_UT); bf16* Wg = (bf16*)(a.ws + GDN_W); bf16* QD = (bf16*)(a.ws + GDN_QD); bf16* KT = (bf16*)(a.ws + GDN_KT); bf16* AQK = (bf16*)(a.ws + GDN_AQK); float* GL = (float*)(a.ws + GDN_GL);
    const int half = F.wave >> 2, wv = F.wave & 3, ht = F.tid & 255, m = F.lane & 15, q = F.lane >> 4;
    constexpr int HALF_BYTES = 3 * 17408 + 17408 + 1024;
    LAS unsigned char* hb = F.lds + half * HALF_BYTES;
    LAS bf16* Kt = (LAS bf16*)hb;
    LAS bf16* Qt = Kt + 64 * 136;
    LAS bf16* Vt = Qt + 64 * 136;
    LAS float* Mm = (LAS float*)(hb + 3 * 17408);
    LAS float* gcs = (LAS float*)(hb + 4 * 17408);
    v4u pK[4], pQ[4], pV[4]; float pg = 0.f, pbt = 0.f;
    const int lr_ = ht >> 4, lsg_ = (ht & 15) * 8;
#define CA_PREFETCH(it_) do { const int c_ = (it_) & 31, h_ = ((it_) >> 5) & 15, b_ = (it_) >> 9; const size_t r0_ = (size_t)b_ * SEQ + (size_t)c_ * 64; const size_t go_ = (r0_ + lr_) * GW + h_ * HD + lsg_; \
        _Pragma("unroll") for (int i = 0; i < 4; ++i) { pK[i] = *(const v4u*)(kb + go_ + (size_t)16 * i * GW); pQ[i] = *(const v4u*)(qb + go_ + (size_t)16 * i * GW); pV[i] = *(const v4u*)(vb + go_ + (size_t)16 * i * GW); } \
        if (wv == 0) { pg = G[(r0_ + F.lane) * 16 + h_]; pbt = beta[(r0_ + F.lane) * 16 + h_]; } } while (0)
    if (F.bid * 2 < 2048) CA_PREFETCH(F.bid * 2 + half);
    for (int it0 = F.bid * 2; it0 < 2048; it0 += F.G * 2) {
        const int it = it0 + half, sl = (it & 31) * 64 + (it >> 5);
        LDS_BARRIER();
        {
#pragma unroll
            for (int i = 0; i < 4; ++i) { *(LAS v4u*)(Kt + (16 * i + lr_) * 136 + lsg_) = pK[i]; *(LAS v4u*)(Qt + (16 * i + lr_) * 136 + lsg_) = pQ[i]; *(LAS v4u*)(Vt + (16 * i + lr_) * 136 + lsg_) = pV[i]; }
            if (wv == 0) {
                float gv = pg;
#pragma unroll
                for (int o = 1; o < 64; o <<= 1) { const float t = __shfl_up(gv, o); if (F.lane >= o) gv += t; }
                gcs[F.lane] = gv; gcs[64 + F.lane] = pbt; gcs[128 + F.lane] = __expf(gv);
                if (F.lane == 63) GL[sl] = __expf(gv);
            }
        }
        LDS_BARRIER();
        {
            const int i = 16 * wv + m; const float gci = gcs[i], bi = gcs[64 + i];
            v8s Ki[4], Qi[4];
#pragma unroll
            for (int ks = 0; ks < 4; ++ks) { Ki[ks] = *(const LAS v8s*)(Kt + i * 136 + 32 * ks + 8 * q); Qi[ks] = *(const LAS v8s*)(Qt + i * 136 + 32 * ks + 8 * q); }
            for (int jt = 0; jt < 4; ++jt) {
                v4f mk = (v4f){0.f, 0.f, 0.f, 0.f}, ak = (v4f){0.f, 0.f, 0.f, 0.f};
                if (jt <= wv) {
                    v4f kk = (v4f){0.f, 0.f, 0.f, 0.f}, qk = (v4f){0.f, 0.f, 0.f, 0.f};
#pragma unroll
                    for (int ks = 0; ks < 4; ++ks) { const v8s Kj = *(const LAS v8s*)(Kt + (16 * jt + m) * 136 + 32 * ks + 8 * q); kk = MFMA16(Kj, Ki[ks], kk); qk = MFMA16(Kj, Qi[ks], qk); }
                    const v4f gj = *(const LAS v4f*)(gcs + 16 * jt + 4 * q);
#pragma unroll
                    for (int r = 0; r < 4; ++r) { const int j = 16 * jt + 4 * q + r; const float gm = __expf(gci - gj[r]);
                        mk[r] = (j < i) ? bi * kk[r] * gm : 0.f; ak[r] = (j <= i) ? qk[r] * gm : 0.f; }
                }
                *(LAS v4f*)(Mm + i * 68 + 16 * jt + 4 * q) = mk;
                v2u w; w.x = pk2(ak[0], ak[1]); w.y = pk2(ak[2], ak[3]);
                *(v2u*)(AQK + (size_t)sl * 4096 + (((wv * 2 + (jt >> 1)) * 64 + ((jt & 1) * 2 + (q >> 1)) * 16 + m) * 8 + 4 * (q & 1))) = w;
            }
        }
        {
            const int r = ht >> 2, sg = (ht & 3) * 32; const float eq = gcs[128 + r];
#pragma unroll
            for (int i = 0; i < 4; ++i) { float x[8]; unpack8(*(const LAS v4u*)(Qt + r * 136 + sg + 8 * i), x);
#pragma unroll
                for (int e = 0; e < 8; ++e) x[e] *= eq;
                *(v4u*)(QD + (size_t)sl * 8192 + ((((r >> 4) * 4 + (ht & 3)) * 64 + i * 16 + (r & 15)) * 8)) = pack8(x); }
            const int d = ht >> 1, tb = (ht & 1) * 32; const float gl = gcs[63];
#pragma unroll
            for (int i = 0; i < 4; ++i) { float x[8];
#pragma unroll
                for (int e = 0; e < 8; ++e) { const int t = tb + 8 * i + e; const v4f g4 = *(const LAS v4f*)(gcs + tb + 8 * i + (e & 4)); x[e] = bf2f(Kt[t * 136 + d]) * __expf(gl - g4[e & 3]); }
                *(v4u*)(KT + (size_t)sl * 8192 + ((((d >> 4) * 2 + (ht & 1)) * 64 + i * 16 + (d & 15)) * 8)) = pack8(x); }
        }
        if (it0 + F.G * 2 < 2048) CA_PREFETCH(it0 + F.G * 2 + half);
        LDS_BARRIER();
        LAS bf16* T1t = Qt;
        LAS bf16* T2t = (LAS bf16*)Mm;
        if (wv == 0) {
            const int cc = F.lane; int ccv = cc;
            float X[64];
#ifndef REP_SUB
#define REP_SUB 1
#endif
#pragma unroll 1
            for (int rs_ = 0; rs_ < REP_SUB; ++rs_)
#pragma unroll
            for (int i = 0; i < 64; ++i) {
                float acc0 = 0.f, acc1 = 0.f;
#pragma unroll
                for (int j4 = 0; j4 < (i + 3) / 4; ++j4) { const v4f mv = *(const LAS v4f*)(Mm + i * 68 + 4 * j4);
                    if (4 * j4 + 0 < i) acc0 += mv.x * X[4 * j4 + 0];
                    if (4 * j4 + 1 < i) acc1 += mv.y * X[4 * j4 + 1];
                    if (4 * j4 + 2 < i) acc0 += mv.z * X[4 * j4 + 2];
                    if (4 * j4 + 3 < i) acc1 += mv.w * X[4 * j4 + 3]; }
                X[i] = ((i == ccv) ? 1.f : 0.f) - (acc0 + acc1);
                asm volatile("" : "+v"(X[i]), "+v"(ccv) :: "memory");
            }
            const float s1 = gcs[64 + cc], s2 = s1 * gcs[128 + cc];
            LDS_WAIT(); asm volatile("" ::: "memory");
#pragma unroll
            for (int i = 0; i < 64; ++i) { T1t[i * 72 + cc] = (bf16)(pk2(X[i] * s1, 0.f) & 0xffffu); T2t[i * 72 + cc] = (bf16)(pk2(X[i] * s2, 0.f) & 0xffffu); }
        }
        LDS_BARRIER();
        {
#pragma unroll
            for (int dd = 0; dd < 2; ++dd) { const int dt = 2 * wv + dd;
                v8s Vf[2], Kf[2];
#pragma unroll
                for (int ks = 0; ks < 2; ++ks) { const LAS bf16* vp = Vt + (32 * ks + 8 * q) * 136 + 16 * dt + m; const LAS bf16* kp = Kt + (32 * ks + 8 * q) * 136 + 16 * dt + m;
                    v4u vv, kk;
                    vv.x = (unsigned)vp[0 * 136] | ((unsigned)vp[1 * 136] << 16); vv.y = (unsigned)vp[2 * 136] | ((unsigned)vp[3 * 136] << 16); vv.z = (unsigned)vp[4 * 136] | ((unsigned)vp[5 * 136] << 16); vv.w = (unsigned)vp[6 * 136] | ((unsigned)vp[7 * 136] << 16);
                    kk.x = (unsigned)kp[0 * 136] | ((unsigned)kp[1 * 136] << 16); kk.y = (unsigned)kp[2 * 136] | ((unsigned)kp[3 * 136] << 16); kk.z = (unsigned)kp[4 * 136] | ((unsigned)kp[5 * 136] << 16); kk.w = (unsigned)kp[6 * 136] | ((unsigned)kp[7 * 136] << 16);
                    Vf[ks] = __builtin_bit_cast(v8s, vv); Kf[ks] = __builtin_bit_cast(v8s, kk); }
#pragma unroll
                for (int ti = 0; ti < 4; ++ti) {
                    v4f du = (v4f){0.f, 0.f, 0.f, 0.f}, dw = (v4f){0.f, 0.f, 0.f, 0.f};
#pragma unroll
                    for (int ks = 0; ks < 2; ++ks) { const v8s t1 = *(const LAS v8s*)(T1t + (16 * ti + m) * 72 + 32 * ks + 8 * q), t2 = *(const LAS v8s*)(T2t + (16 * ti + m) * 72 + 32 * ks + 8 * q);
                        du = MFMA16(t1, Vf[ks], du); dw = MFMA16(Kf[ks], t2, dw); }
                    *(v4f*)(UT + (size_t)sl * 8192 + ((dt * 4 + ti) * 64 + F.lane) * 4) = du;
                    v2u ww; ww.x = pk2(dw[0], dw[1]); ww.y = pk2(dw[2], dw[3]);
                    *(v2u*)(Wg + (size_t)sl * 8192 + (((ti * 4 + (dt >> 1)) * 64 + ((dt & 1) * 2 + (q >> 1)) * 16 + m) * 8 + 4 * (q & 1))) = ww;
                }
            }
        }
    }
#undef CA_PREFETCH
}

__device__ __forceinline__ void gdn_chunk_rec_phase(const Args& a, Frame& F) {
    const float* UT = (const float*)(a.ws + GDN_UT); const bf16* Wg = (const bf16*)(a.ws + GDN_W); const bf16* QD = (const bf16*)(a.ws + GDN_QD); const bf16* KT = (const bf16*)(a.ws + GDN_KT);
    const bf16* AQK = (const bf16*)(a.ws + GDN_AQK); const float* GL = (const float*)(a.ws + GDN_GL);
    float* og = (float*)(a.ws + GDN_O);
    LAS bf16* ST = (LAS bf16*)F.lds;
    LAS bf16* VNT = ST + 2 * 64 * 136;
    const int m = F.lane & 15, q = F.lane >> 4, tt = F.wave >> 1, nta = F.wave & 1;
    for (int item = F.bid; item < 128; item += F.G) {
        const int bh = (item & 7) * 8 + (item >> 4), cg = (item >> 3) & 1, b = bh >> 4, h = bh & 15;
        const size_t row0 = (size_t)b * SEQ;
        __syncthreads();
        for (int o = F.tid; o < 64 * 136 / 2; o += NTHR) ((LAS unsigned*)ST)[o] = 0u;
        v4f S[4] = {(v4f){0.f, 0.f, 0.f, 0.f}, (v4f){0.f, 0.f, 0.f, 0.f}, (v4f){0.f, 0.f, 0.f, 0.f}, (v4f){0.f, 0.f, 0.f, 0.f}};
        v8s Wf[2][4], QDf[2][4], AQf[2][2], KTf[2][2]; v4f UTv[2][2]; float egl[2];
#define GDN_PFA(ci, s_) do { const size_t it_ = (size_t)(ci) * 64 + bh; \
            _Pragma("unroll") for (int ks = 0; ks < 4; ++ks) Wf[s_][ks] = *(const v8s*)(Wg + it_ * 8192 + ((tt * 4 + ks) * 64 + F.lane) * 8); \
            _Pragma("unroll") for (int j = 0; j < 2; ++j) UTv[s_][j] = *(const v4f*)(UT + it_ * 8192 + (((cg * 4 + nta * 2 + j) * 4 + tt) * 64 + F.lane) * 4); } while (0)
#define GDN_PFQ(ci, s_) do { const size_t it_ = (size_t)(ci) * 64 + bh; \
            _Pragma("unroll") for (int ks = 0; ks < 4; ++ks) QDf[s_][ks] = *(const v8s*)(QD + it_ * 8192 + ((tt * 4 + ks) * 64 + F.lane) * 8); \
            _Pragma("unroll") for (int ks = 0; ks < 2; ++ks) AQf[s_][ks] = *(const v8s*)(AQK + it_ * 4096 + ((tt * 2 + ks) * 64 + F.lane) * 8); } while (0)
#define GDN_PFK(ci, s_) do { const size_t it_ = (size_t)(ci) * 64 + bh; \
            _Pragma("unroll") for (int ks = 0; ks < 2; ++ks) KTf[s_][ks] = *(const v8s*)(KT + it_ * 8192 + ((F.wave * 2 + ks) * 64 + F.lane) * 8); \
            egl[s_] = GL[it_]; } while (0)
#define GDN_STEP(c, s_) do { \
            const LAS bf16* STc = ST + ((c) & 1) * 64 * 136; LAS bf16* STn = ST + (((c) + 1) & 1) * 64 * 136; \
            v8s STf[2][4]; \
            _Pragma("unroll") for (int j = 0; j < 2; ++j) _Pragma("unroll") for (int ks = 0; ks < 4; ++ks) STf[j][ks] = *(const LAS v8s*)(STc + (32 * nta + 16 * j + m) * 136 + 32 * ks + 8 * q); \
            _Pragma("unroll") for (int j = 0; j < 2; ++j) { v4f P = (v4f){0.f, 0.f, 0.f, 0.f}; \
                _Pragma("unroll") for (int ks = 0; ks < 4; ++ks) P = MFMA16(Wf[s_][ks], STf[j][ks], P); \
                const v4f vn = UTv[s_][j] - P; v2u w; w.x = pk2(vn[0], vn[1]); w.y = pk2(vn[2], vn[3]); *(LAS v2u*)(VNT + (32 * nta + 16 * j + m) * 72 + 16 * tt + 4 * q) = w; } \
            GDN_PFA(((c) + 2 < 32 ? (c) + 2 : 31), s_); \
            LDS_BARRIER(); \
            _Pragma("unroll") for (int j = 0; j < 2; ++j) { v4f O = (v4f){0.f, 0.f, 0.f, 0.f}; \
                _Pragma("unroll") for (int ks = 0; ks < 4; ++ks) O = MFMA16(STf[j][ks], QDf[s_][ks], O); \
                _Pragma("unroll") for (int ks = 0; ks < 2; ++ks) { const v8s vf = *(const LAS v8s*)(VNT + (32 * nta + 16 * j + m) * 72 + 32 * ks + 8 * q); O = MFMA16(vf, AQf[s_][ks], O); } \
                *(v4f*)(og + (row0 + (size_t)(c) * 64 + 16 * tt + m) * GW + h * HD + cg * 64 + 32 * nta + 16 * j + 4 * q) = O; } \
            GDN_PFQ(((c) + 2 < 32 ? (c) + 2 : 31), s_); \
            { v8s vf[4][2]; \
                _Pragma("unroll") for (int nt = 0; nt < 4; ++nt) _Pragma("unroll") for (int ks = 0; ks < 2; ++ks) vf[nt][ks] = *(const LAS v8s*)(VNT + (16 * nt + m) * 72 + 32 * ks + 8 * q); \
                _Pragma("unroll") for (int nt = 0; nt < 4; ++nt) { \
                    S[nt] = S[nt] * egl[s_]; \
                    _Pragma("unroll") for (int ks = 0; ks < 2; ++ks) S[nt] = MFMA16(KTf[s_][ks], vf[nt][ks], S[nt]); } \
                _Pragma("unroll") for (int nt = 0; nt < 4; ++nt) { v2u w; w.x = pk2(S[nt][0], S[nt][1]); w.y = pk2(S[nt][2], S[nt][3]); \
                    *(LAS v2u*)(STn + (16 * nt + m) * 136 + 16 * F.wave + 4 * q) = w; } } \
            GDN_PFK(((c) + 2 < 32 ? (c) + 2 : 31), s_); \
            LDS_BARRIER(); } while (0)
        GDN_PFA(0, 0); GDN_PFQ(0, 0); GDN_PFK(0, 0); GDN_PFA(1, 1); GDN_PFQ(1, 1); GDN_PFK(1, 1);
        __syncthreads();
        for (int c = 0; c < 32; c += 2) { GDN_STEP(c, 0); GDN_STEP(c + 1, 1); }
#undef GDN_PFQ
#undef GDN_PFK
#undef GDN_STEP
#undef GDN_PFA
#undef GDN_PFB
    }
}

__device__ __forceinline__ void gdn_gate_phase(const Args& a, Frame& F) {
    const float* og = (const float*)(a.ws + GDN_O);
    const bf16* proj = (const bf16*)(a.ws + WS_HB);
    unsigned char* mixed = a.ws + WS_MIXED;
    const float* nw = a.in[5];
    const int gw = F.bid * NWAVES + F.wave, NGW = F.G * NWAVES;
    const int cl = (F.lane & 15) * 8;
    const v4f n0 = *(const v4f*)(nw + cl), n1 = *(const v4f*)(nw + cl + 4);
    for (int t = gw; t < NTOK; t += NGW) {
#pragma unroll
        for (int j = 0; j < 4; ++j) {
            const int c = j * 512 + F.lane * 8;
            const v4f o0 = *(const v4f*)(og + (size_t)t * GW + c), o1 = *(const v4f*)(og + (size_t)t * GW + c + 4);
            float z[8]; unpack8(*(const v4u*)(proj + (size_t)t * EVEN_IN + PE_Z + c), z);
            float ss = (o0.x * o0.x + o0.y * o0.y) + (o0.z * o0.z + o0.w * o0.w) + (o1.x * o1.x + o1.y * o1.y) + (o1.z * o1.z + o1.w * o1.w);
            ss = row16_sum(ss);
            const float r = rsqrtf(ss * (1.0f / 128.0f) + RMS_EPS);
            float y[8];
            y[0] = o0.x * r * n0.x * siluf_(z[0]); y[1] = o0.y * r * n0.y * siluf_(z[1]); y[2] = o0.z * r * n0.z * siluf_(z[2]); y[3] = o0.w * r * n0.w * siluf_(z[3]);
            y[4] = o1.x * r * n1.x * siluf_(z[4]); y[5] = o1.y * r * n1.y * siluf_(z[5]); y[6] = o1.z * r * n1.z * siluf_(z[6]); y[7] = o1.w * r * n1.w * siluf_(z[7]);
#if FP8_OUT
            { v2u w; w.x = pk4_fp8(MIX8_SCALE * y[0], MIX8_SCALE * y[1], MIX8_SCALE * y[2], MIX8_SCALE * y[3]); w.y = pk4_fp8(MIX8_SCALE * y[4], MIX8_SCALE * y[5], MIX8_SCALE * y[6], MIX8_SCALE * y[7]); *(v2u*)(mixed + (size_t)t * DM + c) = w; }
#else
            *(v4u*)((bf16*)mixed + (size_t)t * DM + c) = pack8(y);
#endif
        }
    }
}

__device__ __forceinline__ void rg_scan_phase(const Args& a, Frame& F) {
    const unsigned* ABin = (const unsigned*)(a.ws + WS_A);
    const bf16* proj = (const bf16*)(a.ws + WS_HB);
    unsigned char* mixed = a.ws + WS_MIXED;
    LAS float* sA = (LAS float*)F.lds; LAS float* sH = sA + 64 * 32;
    const int c4 = (F.lane & 7) * 4, seg = F.wave * 8 + (F.lane >> 3);
    for (int item = F.bid; item < 256; item += F.G) {
        const int b = item >> 6, c = (item & 63) * 32 + c4;
        const size_t r0 = (size_t)b * SEQ + (size_t)seg * 32;
        float Ap[4] = {1.f, 1.f, 1.f, 1.f}, Hh[4] = {0.f, 0.f, 0.f, 0.f};
#pragma unroll 8
        for (int t = 0; t < 32; ++t) { const v4u w = *(const v4u*)(ABin + (r0 + t) * RGW + c);
#pragma unroll
            for (int e = 0; e < 4; ++e) { const float av = __expf(bflo(w[e])), bv = bfhi(w[e]); Hh[e] = av * Hh[e] + bv; Ap[e] *= av; } }
        __syncthreads();
        *(LAS v4f*)(sA + seg * 32 + c4) = (v4f){Ap[0], Ap[1], Ap[2], Ap[3]}; *(LAS v4f*)(sH + seg * 32 + c4) = (v4f){Hh[0], Hh[1], Hh[2], Hh[3]};
        __syncthreads();
        v4f hin = (v4f){0.f, 0.f, 0.f, 0.f};
        for (int s = 0; s < seg; ++s) hin = *(const LAS v4f*)(sA + s * 32 + c4) * hin + *(const LAS v4f*)(sH + s * 32 + c4);
        float hcur[4] = {hin.x, hin.y, hin.z, hin.w};
#pragma unroll 8
        for (int t = 0; t < 32; ++t) {
            const v4u w = *(const v4u*)(ABin + (r0 + t) * RGW + c);
            const v2u gw2 = *(const v2u*)(proj + (r0 + t) * EVEN_IN + PE_RGGATE + c);
            const float g[4] = {bflo(gw2.x), bfhi(gw2.x), bflo(gw2.y), bfhi(gw2.y)};
            float o[4];
#pragma unroll
            for (int e = 0; e < 4; ++e) { const float av = __expf(bflo(w[e])), bv = bfhi(w[e]); hcur[e] = av * hcur[e] + bv; o[e] = hcur[e] * gelu_tanh(g[e]); }
#if FP8_OUT
            *(unsigned*)(mixed + (r0 + t) * DM + GW + c) = pk4_fp8(clamp448(MIX8_SCALE * o[0]), clamp448(MIX8_SCALE * o[1]), clamp448(MIX8_SCALE * o[2]), clamp448(MIX8_SCALE * o[3]));
#else
            { v2u ow; ow.x = pk2(o[0], o[1]); ow.y = pk2(o[2], o[3]); *(v2u*)((bf16*)mixed + (r0 + t) * DM + GW + c) = ow; }
#endif
        }
    }
}

__device__ __forceinline__ void ln_phase(Frame& F, const bf16* res, const bf16* mixb, const float* g, const float* bb, float* outf, bf16* outb, unsigned char* out8) {
    const int gw = F.bid * NWAVES + F.wave, NGW = F.G * NWAVES;
    for (int row = gw; row < NTOK; row += NGW) {
        const bf16* rr = res + (size_t)row * DM; const bf16* mr = mixb + (size_t)row * DM;
        float y[8][8]; float s = 0.f;
#pragma unroll
        for (int j = 0; j < 8; ++j) {
            float x[8], mv[8]; unpack8(*(const v4u*)(rr + (64 * j + F.lane) * 8), x); unpack8(*(const v4u*)(mr + (64 * j + F.lane) * 8), mv);
#pragma unroll
            for (int e = 0; e < 8; ++e) { y[j][e] = DN_ALPHA * x[e] + mv[e]; s += y[j][e]; }
        }
        const float mean = wave_sum(s) * (1.0f / DM); float s2 = 0.f;
#pragma unroll
        for (int j = 0; j < 8; ++j)
#pragma unroll
            for (int e = 0; e < 8; ++e) { y[j][e] -= mean; s2 += y[j][e] * y[j][e]; }
        const float rstd = rsqrtf(wave_sum(s2) * (1.0f / DM) + LN_EPS);
#pragma unroll
        for (int j = 0; j < 8; ++j) {
            const int c = (64 * j + F.lane) * 8;
            const v4f g0 = *(const v4f*)(g + c), g1 = *(const v4f*)(g + c + 4), b0 = *(const v4f*)(bb + c), b1 = *(const v4f*)(bb + c + 4);
            float o[8];
            o[0] = y[j][0] * rstd * g0.x + b0.x; o[1] = y[j][1] * rstd * g0.y + b0.y; o[2] = y[j][2] * rstd * g0.z + b0.z; o[3] = y[j][3] * rstd * g0.w + b0.w;
            o[4] = y[j][4] * rstd * g1.x + b1.x; o[5] = y[j][5] * rstd * g1.y + b1.y; o[6] = y[j][6] * rstd * g1.z + b1.z; o[7] = y[j][7] * rstd * g1.w + b1.w;
            if (outf) { *(v4f*)(outf + (size_t)row * DM + c) = (v4f){o[0], o[1], o[2], o[3]}; *(v4f*)(outf + (size_t)row * DM + c + 4) = (v4f){o[4], o[5], o[6], o[7]}; }
            if (outb) *(v4u*)(outb + (size_t)row * DM + c) = pack8(o);
            if (out8) { v2u w; w.x = pk4_fp8(clamp448(o[0]), clamp448(o[1]), clamp448(o[2]), clamp448(o[3])); w.y = pk4_fp8(clamp448(o[4]), clamp448(o[5]), clamp448(o[6]), clamp448(o[7])); *(v2u*)(out8 + (size_t)row * DM + c) = w; }
        }
    }
}

__device__ __forceinline__ unsigned ordkey(float f) { const unsigned u = __float_as_uint(f); return (u & 0x80000000u) ? ~u : (u | 0x80000000u); }
__device__ __forceinline__ void split8(const v4f a, const v4f b, v8s& hi, v8s& lo) {
    v4u h; h.x = pk2(a.x, a.y); h.y = pk2(a.z, a.w); h.z = pk2(b.x, b.y); h.w = pk2(b.z, b.w);
    v4u l; l.x = pk2(a.x - bflo(h.x), a.y - bfhi(h.x)); l.y = pk2(a.z - bflo(h.y), a.w - bfhi(h.y)); l.z = pk2(b.x - bflo(h.z), b.y - bfhi(h.z)); l.w = pk2(b.z - bflo(h.w), b.w - bfhi(h.w));
    hi = __builtin_bit_cast(v8s, h); lo = __builtin_bit_cast(v8s, l);
}
__device__ __forceinline__ void peer_topk_phase(Frame& F, const bf16* q, const bf16* kh, const bf16* kl, int* idx, float* gate, unsigned char* Wz) {
    LAS float* sc = (LAS float*)F.lds;
    const int m = F.lane & 15, kq = F.lane >> 4;
    for (int u = F.bid; u < NTOK / 16; u += F.G) {
        const int t0 = u * 16;
        __syncthreads();
#ifndef REP_SC
#define REP_SC 1
#endif
#pragma unroll 1
        for (int hpi = 0; hpi < 2 * REP_SC; ++hpi) {
            const int hp = 2 * F.wave + (hpi & 1);
            v8s Qh[4];
#pragma unroll
            for (int ks = 0; ks < 4; ++ks) Qh[ks] = *(const v8s*)((const unsigned char*)q + tl_off((size_t)(t0 + m), hp * 128 + 32 * ks + 8 * kq, PQ / 256));
            v8s Kh[3][4];
#define TK_LOAD(kt_, s_) do { _Pragma("unroll") for (int ks = 0; ks < 4; ++ks) { const size_t off = (size_t)hp * 16384 + (((kt_) * 4 + ks) * 64 + F.lane) * 8; Kh[s_][ks] = *(const v8s*)(kh + off); } } while (0)
            TK_LOAD(0, 0); TK_LOAD(1, 1);
            __builtin_amdgcn_sched_barrier(0);
#pragma unroll
            for (int kt = 0; kt < 8; ++kt) {
                if (kt + 2 < 8) TK_LOAD(kt + 2, (kt + 2) % 3);
                __builtin_amdgcn_sched_barrier(0);
                v4f acc = (v4f){0.f, 0.f, 0.f, 0.f};
#pragma unroll
                for (int ks = 0; ks < 4; ++ks) acc = MFMA16(Kh[kt % 3][ks], Qh[ks], acc);
                LAS float* dst = sc + (m * 16 + hp) * 129 + 16 * kt + 4 * kq;
                dst[0] = acc[0]; dst[1] = acc[1]; dst[2] = acc[2]; dst[3] = acc[3];
                __builtin_amdgcn_sched_barrier(0);
            }
#undef TK_LOAD
        }
        __syncthreads();
        if (F.tid < 256) {
            LAS float* L = sc + F.tid * 129;
            unsigned a[16];
#pragma unroll
            for (int p = 0; p < 16; ++p) a[p] = 0u;
#pragma unroll 4
            for (int i = 0; i < 128; ++i) {
                unsigned x = (ordkey(L[i]) & ~127u) | (unsigned)(127 - i);
#pragma unroll
                for (int p = 0; p < 16; ++p) { const unsigned hi = max(a[p], x); x = min(a[p], x); a[p] = hi; }
            }
            float v[16];
#pragma unroll
            for (int p = 0; p < 16; ++p) v[p] = L[127 - (int)(a[p] & 127u)];
#pragma unroll
            for (int p = 0; p < 16; ++p) { L[p] = v[p]; L[16 + p] = __int_as_float(127 - (int)(a[p] & 127u)); }
        }
        __syncthreads();
        if (F.tid < 128) {
            const LAS float* L1 = sc + (2 * F.tid) * 129; const LAS float* L2 = L1 + 129;
            float v1[16], v2[16];
#pragma unroll
            for (int p = 0; p < 16; ++p) { v1[p] = L1[p]; v2[p] = L2[p]; }
            unsigned b[16];
#pragma unroll
            for (int p = 0; p < 16; ++p) b[p] = 0u;
#pragma unroll
            for (int ci = 0; ci < 16; ++ci)
#pragma unroll
                for (int cj = 0; cj < 16; ++cj)
                    if ((ci + 1) * (cj + 1) <= 16) {
                        unsigned x = (ordkey(v1[ci] + v2[cj]) & ~255u) | (unsigned)(255 - (ci * 16 + cj));
#pragma unroll
                        for (int p = 0; p < 16; ++p) { const unsigned hi = max(b[p], x); x = min(b[p], x); b[p] = hi; }
                    }
            float s[16]; int ex[16];
#pragma unroll
            for (int r = 0; r < 16; ++r) { const int pos = 255 - (int)(b[r] & 255u), ci = pos >> 4, cj = pos & 15;
                s[r] = L1[ci] + L2[cj]; ex[r] = __float_as_int(L1[16 + ci]) * PNK + __float_as_int(L2[16 + cj]); }
            const float s0 = s[0]; float den = 0.f;
#pragma unroll
            for (int r = 0; r < 16; ++r) { s[r] = __expf(s[r] - s0); den += s[r]; }
            const float rden = 1.0f / den;
#pragma unroll
            for (int r = 0; r < 16; ++r) s[r] *= rden;
            const int tok = F.tid >> 3, h = F.tid & 7; const size_t o = (size_t)(t0 + tok) * 128 + h * 16;
#pragma unroll
            for (int r = 0; r < 16; ++r) { idx[o + r] = ex[r]; gate[o + r] = s[r]; }
        }
    }
}

__device__ __forceinline__ void peer_sparse_phase(Frame& F, const int* idx, const float* gate, const bf16* Hb, unsigned char* Wb) {
    const int gw = F.bid * NWAVES + F.wave, NGW = F.G * NWAVES;
    LAS unsigned char* row = F.lds + F.wave * 16384;
    const v4u z = (v4u){0u, 0u, 0u, 0u};
#if HID8
#define H_TROW(t_) (((size_t)((t_) >> 8) * (PE / 256)) * 8 * 8192 + (size_t)((((t_) & 255) >> 6) & 1) * 4 * 8192 + (size_t)(((((t_) & 255) >> 7) * 4 + ((((t_) & 255) >> 4) & 3))) * 1024 + (size_t)((t_) & 15) * 16)
#define H_AT(trow_, e_) ((1.0f / H8_SCALE) * __builtin_amdgcn_cvt_f32_fp8((int)*((const unsigned char*)Hb + (trow_) + (size_t)((e_) >> 8) * 8 * 8192 + (size_t)(((e_) >> 6) & 3) * 8192 + (size_t)(((e_) >> 3) & 3) * 256 + (size_t)(((e_) >> 5) & 1) * 8 + (size_t)((e_) & 7)), 0))
#else
#define H_TROW(t_) (((size_t)((t_) >> 8) * (PE / 256)) * 8 * 16384 + (size_t)((((t_) & 255) >> 6) & 1) * 4 * 16384 + (size_t)((((((t_) & 255) >> 7) * 4 + ((((t_) & 255) >> 4) & 3))) * 2) * 1024 + (size_t)((t_) & 15) * 16)
#define H_AT(trow_, e_) bf2f(*(const bf16*)((const unsigned char*)Hb + (trow_) + (size_t)((e_) >> 8) * 8 * 16384 + (size_t)(((e_) >> 6) & 3) * 16384 + (size_t)(((e_) >> 5) & 1) * 1024 + (size_t)(((e_) >> 3) & 3) * 256 + (size_t)((e_) & 7) * 2))
#endif
    int e0 = 0, e1 = 0; float g0 = 0.f, g1 = 0.f, h0 = 0.f, h1 = 0.f;
    if (gw < NTOK) { e0 = idx[(size_t)gw * 128 + F.lane]; e1 = idx[(size_t)gw * 128 + 64 + F.lane]; g0 = gate[(size_t)gw * 128 + F.lane]; g1 = gate[(size_t)gw * 128 + 64 + F.lane];
        const size_t tr = H_TROW(gw); h0 = H_AT(tr, e0); h1 = H_AT(tr, e1); }
    for (int t = gw; t < NTOK; t += NGW) {
        const int tq = (t + NGW < NTOK) ? t + NGW : t;
        const int ne0 = idx[(size_t)tq * 128 + F.lane], ne1 = idx[(size_t)tq * 128 + 64 + F.lane];
        const float ng0 = gate[(size_t)tq * 128 + F.lane], ng1 = gate[(size_t)tq * 128 + 64 + F.lane];
#pragma unroll
        for (int j = 0; j < 16; ++j) *(LAS v4u*)(row + (64 * j + F.lane) * 16) = z;
        float tot0 = 0.f, tot1 = 0.f; bool first0 = true, first1 = true;
#pragma unroll 8
        for (int j = 0; j < 64; ++j) {
            const int ea = __builtin_amdgcn_readlane(e0, j), eb = __builtin_amdgcn_readlane(e1, j);
            const float ga = __int_as_float(__builtin_amdgcn_readlane(__float_as_int(g0), j)), gb = __int_as_float(__builtin_amdgcn_readlane(__float_as_int(g1), j));
            if (ea == e0) { tot0 += ga; if (j < F.lane) first0 = false; }
            if (eb == e0) { tot0 += gb; }
            if (ea == e1) { tot1 += ga; first1 = false; }
            if (eb == e1) { tot1 += gb; if (j < F.lane) first1 = false; }
        }
        const size_t trn = H_TROW(tq); const float nh0 = H_AT(trn, ne0), nh1 = H_AT(trn, ne1);
        LDS_WAIT(); asm volatile("" ::: "memory");
        if (first0) row[e0] = (unsigned char)(pk4_fp8(clamp448(W8_SCALE * tot0 * gelu_tanh(h0)), 0.f, 0.f, 0.f) & 0xffu);
        if (first1) row[e1] = (unsigned char)(pk4_fp8(clamp448(W8_SCALE * tot1 * gelu_tanh(h1)), 0.f, 0.f, 0.f) & 0xffu);
        LDS_WAIT(); asm volatile("" ::: "memory");
        v4u* wrow = (v4u*)(Wb + (size_t)t * PE);
#pragma unroll
        for (int j = 0; j < 16; ++j) wrow[64 * j + F.lane] = *(const LAS v4u*)(row + (64 * j + F.lane) * 16);
        LDS_WAIT(); asm volatile("" ::: "memory");
        e0 = ne0; e1 = ne1; g0 = ng0; g1 = ng1; h0 = nh0; h1 = nh1;
    }
#undef H_AT
#undef H_TROW
}

__device__ __forceinline__ void sb_attn_phase(const Args& a, Frame& F, unsigned* qctr, const int item_lo, const int item_hi) {
    const bf16* proj = (const bf16*)(a.ws + WS_HB);
    unsigned char* mixed = a.ws + WS_MIXED;
    LAS bf16* Qs = (LAS bf16*)F.lds;
    LAS bf16* Ks = Qs + 128 * 136;
    LAS bf16* Vt = Ks + 64 * 136;
    LAS float* wmaxs = (LAS float*)(Vt + 128 * 72);
    const int m = F.lane & 15, q = F.lane >> 4;
    volatile LAS int* slot = (volatile LAS int*)(F.lds + MISC_OFF + 64);
    for (;;) {
        __syncthreads();
        if (F.tid == 0) slot[0] = (int)__hip_atomic_fetch_add(qctr, 1u, __ATOMIC_RELAXED, __HIP_MEMORY_SCOPE_AGENT);
        __syncthreads();
        const int item = item_lo + slot[0];
        if (item >= item_hi) break;
        const int qb = 15 - (item >> 6), hd = item & 15, b = (item >> 4) & 3;
        const int t0 = qb * 128; const size_t row0 = (size_t)b * SEQ;
        __syncthreads();
        {   const int r = F.tid >> 2, c = (F.tid & 3) * 32;
#pragma unroll
            for (int i = 0; i < 4; ++i) *(LAS v4u*)(Qs + r * 136 + c + 8 * i) = *(const v4u*)(proj + (row0 + t0 + r) * ODD_IN + hd * HD + c + 8 * i); }
        __syncthreads();
        v8s Qf[4];
#pragma unroll
        for (int ks = 0; ks < 4; ++ks) Qf[ks] = *(const LAS v8s*)(Qs + (16 * F.wave + m) * 136 + 32 * ks + 8 * q);
        v4f O[8];
#pragma unroll
        for (int dt = 0; dt < 8; ++dt) O[dt] = (v4f){0.f, 0.f, 0.f, 0.f};
        float R = 0.f;
        const int tq = t0 + 16 * F.wave + m;
        const int lr_ = F.tid >> 3, lc_ = (F.tid & 7) * 16;
        v4u pk0, pk1, pv0, pv1;
#define SB_LOAD(kbx) do { const bf16* p_ = proj + (row0 + (size_t)(kbx) * 64 + lr_) * ODD_IN + hd * HD + lc_; \
            pk0 = *(const v4u*)(p_ + SBW); pk1 = *(const v4u*)(p_ + SBW + 8); pv0 = *(const v4u*)(p_ + 2 * SBW); pv1 = *(const v4u*)(p_ + 2 * SBW + 8); } while (0)
        SB_LOAD((t0 >> 6) + 1);
        for (int kb = (t0 >> 6) + 1; kb >= 0; --kb) {
            const int s0 = kb * 64;
            LDS_BARRIER();
            {   *(LAS v4u*)(Ks + lr_ * 136 + lc_) = pk0; *(LAS v4u*)(Ks + lr_ * 136 + lc_ + 8) = pk1;
                const unsigned vw[8] = {pv0.x, pv0.y, pv0.z, pv0.w, pv1.x, pv1.y, pv1.z, pv1.w};
#pragma unroll
                for (int i = 0; i < 8; ++i) { Vt[(lc_ + 2 * i) * 72 + lr_] = (bf16)(vw[i] & 0xffffu); Vt[(lc_ + 2 * i + 1) * 72 + lr_] = (bf16)(vw[i] >> 16); }
            }
            if (kb > 0) SB_LOAD(kb - 1);
            LDS_BARRIER();
            if (s0 < t0 + 16 * F.wave + 15) {
            v4f S[4];
#pragma unroll
            for (int jt = 0; jt < 4; ++jt) { S[jt] = (v4f){0.f, 0.f, 0.f, 0.f};
#pragma unroll
                for (int ks = 0; ks < 4; ++ks) { const v8s Kf = *(const LAS v8s*)(Ks + (16 * jt + m) * 136 + 32 * ks + 8 * q); S[jt] = MFMA16(Kf, Qf[ks], S[jt]); } }
            float l[4][4], G[4];
            const bool full = (s0 + 63) < (t0 + 16 * F.wave);
            float tg[4], TOT[4];
            float after = 0.f;
            v4u Pw[2];
#define SB_LOGSIG(z_) (-(fmaxf((z_), 0.f) + __builtin_amdgcn_logf(1.0f + __builtin_amdgcn_exp2f(-fabsf(z_)))))
#define SB_GROUPS() _Pragma("unroll") for (int jt = 0; jt < 4; ++jt) { \
                const float g1 = __shfl_xor(G[jt], 16), g2 = __shfl_xor(G[jt], 32), g3 = __shfl_xor(G[jt], 48);     \
                TOT[jt] = (G[jt] + g1) + (g2 + g3); \
                tg[jt] = (((q ^ 1) > q) ? g1 : 0.f) + (((q ^ 2) > q) ? g2 : 0.f) + (((q ^ 3) > q) ? g3 : 0.f); }
#define SB_PACK(jt_) do { const unsigned lo = pk2(w[0], w[1]), hi = pk2(w[2], w[3]); \
                if ((jt_) & 1) { Pw[(jt_) >> 1].z = lo; Pw[(jt_) >> 1].w = hi; } else { Pw[(jt_) >> 1].x = lo; Pw[(jt_) >> 1].y = hi; } } while (0)
            if (full) {
#pragma unroll
                for (int jt = 0; jt < 4; ++jt) { G[jt] = 0.f;
#pragma unroll
                    for (int r = 0; r < 4; ++r) { const float z = S[jt][r] * (0.08838834764831845f * 1.4426950408889634f); S[jt][r] = z; const float lv = SB_LOGSIG(z); l[jt][r] = lv; G[jt] += lv; } }
                SB_GROUPS()
#pragma unroll
                for (int jt = 3; jt >= 0; --jt) {
                    float tail = R + after + tg[jt];
                    float w[4];
#pragma unroll
                    for (int r = 3; r >= 0; --r) { w[r] = __builtin_amdgcn_exp2f(S[jt][r] + l[jt][r] + tail); tail += l[jt][r]; }
                    after += TOT[jt];
                    SB_PACK(jt);
                }
            } else {
#pragma unroll
                for (int jt = 0; jt < 4; ++jt) { G[jt] = 0.f;
#pragma unroll
                    for (int r = 0; r < 4; ++r) { const float z = S[jt][r] * (0.08838834764831845f * 1.4426950408889634f); S[jt][r] = z;
                        const bool mk = (s0 + 16 * jt + 4 * q + r) < tq;
                        const float lv = mk ? SB_LOGSIG(z) : 0.f; l[jt][r] = lv; G[jt] += lv; } }
                SB_GROUPS()
#pragma unroll
                for (int jt = 3; jt >= 0; --jt) {
                    float tail = R + after + tg[jt];
                    float w[4];
#pragma unroll
                    for (int r = 3; r >= 0; --r) {
                        const bool mk = (s0 + 16 * jt + 4 * q + r) < tq;
                        w[r] = mk ? __builtin_amdgcn_exp2f(S[jt][r] + l[jt][r] + tail) : 0.f;
                        tail += l[jt][r];
                    }
                    after += TOT[jt];
                    SB_PACK(jt);
                }
            }
#undef SB_LOGSIG
#undef SB_GROUPS
#undef SB_PACK
            R += after;
#pragma unroll
            for (int kp = 0; kp < 2; ++kp) {
                const v8s Pf = __builtin_bit_cast(v8s, Pw[kp]);
#pragma unroll
                for (int dt = 0; dt < 8; ++dt) {
                    const v2u a0 = *(const LAS v2u*)(Vt + (16 * dt + m) * 72 + 32 * kp + 4 * q), a1 = *(const LAS v2u*)(Vt + (16 * dt + m) * 72 + 32 * kp + 16 + 4 * q);
                    const v4u av = (v4u){a0.x, a0.y, a1.x, a1.y};
                    O[dt] = MFMA16(__builtin_bit_cast(v8s, av), Pf, O[dt]);
                }
            }
            }
            const float wm = wave_max(R);
            if (F.lane == 0) wmaxs[F.wave] = wm;
            LDS_BARRIER();
            float bm = wmaxs[0];
#pragma unroll
            for (int w = 1; w < 8; ++w) bm = fmaxf(bm, wmaxs[w]);
            if (bm < -100.f * 1.4426950408889634f) break;
        }
#pragma unroll
#if FP8_OUT
        for (int dt = 0; dt < 8; ++dt) *(unsigned*)(mixed + (row0 + tq) * ODD_MIX + hd * HD + 16 * dt + 4 * q) = pk4_fp8(clamp448(MIX8_SCALE * O[dt][0]), clamp448(MIX8_SCALE * O[dt][1]), clamp448(MIX8_SCALE * O[dt][2]), clamp448(MIX8_SCALE * O[dt][3]));
#else
        for (int dt = 0; dt < 8; ++dt) { v2u w; w.x = pk2(O[dt][0], O[dt][1]); w.y = pk2(O[dt][2], O[dt][3]); *(v2u*)((bf16*)mixed + (row0 + tq) * ODD_MIX + hd * HD + 16 * dt + 4 * q) = w; }
#endif
#undef SB_LOAD
    }
}

__device__ __forceinline__ void s5_phase(const Args& a, Frame& F) {
    const bf16* proj = (const bf16*)(a.ws + WS_HB);
    bf16* yg = (bf16*)(a.ws + WS_YG);
    LAS float* us = (LAS float*)F.lds;
    LAS float* hre = us + 64 * 16;
    LAS float* him = hre + 64 * 68;
    LAS float* Ere = him + 64 * 68;
    LAS float* Eim = Ere + 8 * 64;
    const int n = F.lane, m = F.lane & 15, q = F.lane >> 4;
    for (int item = F.bid; item < 256; item += F.G) {
        const int b = item >> 6, g = item & 63; const size_t row0 = (size_t)b * SEQ;
        const float dt = __expf(a.in[17][g]);
        const float lr = fminf(a.in[15][g * 64 + n], -1e-4f), li = a.in[16][g * 64 + n];
        const float mag = expf(lr * dt), ab_re = mag * cosf(li * dt), ab_im = mag * sinf(li * dt);
        const float den = lr * lr + li * li, nr = ab_re - 1.0f, ni = ab_im;
        const float cr = (nr * lr + ni * li) / den, ci = (ni * lr - nr * li) / den;
        float bbr[16], bbi[16];
#pragma unroll
        for (int c = 0; c < 16; ++c) { const float br = a.in[18][((size_t)g * 64 + n) * 16 + c], bi = a.in[19][((size_t)g * 64 + n) * 16 + c]; bbr[c] = cr * br - ci * bi; bbi[c] = cr * bi + ci * br; }
        float pr[8], pi[8];
        pr[0] = ab_re; pi[0] = ab_im;
#pragma unroll
        for (int i = 1; i < 8; ++i) { pr[i] = pr[i - 1] * ab_re - pi[i - 1] * ab_im; pi[i] = pr[i - 1] * ab_im + pi[i - 1] * ab_re; }
        v8s Cf[4];
#pragma unroll
        for (int ks = 0; ks < 4; ++ks) { const float* src = (ks < 2 ? a.in[20] : a.in[21]) + ((size_t)g * 16 + m) * 64 + 32 * (ks & 1) + 8 * q; const float sg = ks < 2 ? 1.f : -1.f;
            const v4f x = *(const v4f*)src, y = *(const v4f*)(src + 4);
            v4u p; p.x = pk2(sg * x.x, sg * x.y); p.y = pk2(sg * x.z, sg * x.w); p.z = pk2(sg * y.x, sg * y.y); p.w = pk2(sg * y.z, sg * y.w); Cf[ks] = __builtin_bit_cast(v8s, p); }
        const v4f Dv = *(const v4f*)(a.in[22] + g * 16 + 4 * q);
        float c_re = 0.f, c_im = 0.f;
        const int ur = F.tid >> 1, uc8 = (F.tid & 1) * 8;
        v4u upf = (v4u){0u, 0u, 0u, 0u};
        if (F.tid < 128) upf = *(const v4u*)(proj + (row0 + ur) * ODD_IN + 3 * SBW + g * 16 + uc8);
        __syncthreads();
        for (int ch = 0; ch < SEQ / 64; ++ch) {
            const size_t r0 = row0 + (size_t)ch * 64;
            if (F.tid < 128) { float x[8]; unpack8(upf, x);
                *(LAS v4f*)(us + ur * 16 + uc8) = (v4f){x[0], x[1], x[2], x[3]}; *(LAS v4f*)(us + ur * 16 + uc8 + 4) = (v4f){x[4], x[5], x[6], x[7]};
                if (ch + 1 < SEQ / 64) upf = *(const v4u*)(proj + (r0 + 64 + ur) * ODD_IN + 3 * SBW + g * 16 + uc8); }
            LDS_BARRIER();
            float hlr[8], hli[8]; float h_re = 0.f, h_im = 0.f;
#pragma unroll
            for (int i = 0; i < 8; ++i) { const int t = F.wave * 8 + i;
                const v4f u0 = *(const LAS v4f*)(us + t * 16), u1 = *(const LAS v4f*)(us + t * 16 + 4), u2 = *(const LAS v4f*)(us + t * 16 + 8), u3 = *(const LAS v4f*)(us + t * 16 + 12);
                const float sr = (u0.x * bbr[0] + u0.y * bbr[1] + u0.z * bbr[2] + u0.w * bbr[3]) + (u1.x * bbr[4] + u1.y * bbr[5] + u1.z * bbr[6] + u1.w * bbr[7])
                               + (u2.x * bbr[8] + u2.y * bbr[9] + u2.z * bbr[10] + u2.w * bbr[11]) + (u3.x * bbr[12] + u3.y * bbr[13] + u3.z * bbr[14] + u3.w * bbr[15]);
                const float si = (u0.x * bbi[0] + u0.y * bbi[1] + u0.z * bbi[2] + u0.w * bbi[3]) + (u1.x * bbi[4] + u1.y * bbi[5] + u1.z * bbi[6] + u1.w * bbi[7])
                               + (u2.x * bbi[8] + u2.y * bbi[9] + u2.z * bbi[10] + u2.w * bbi[11]) + (u3.x * bbi[12] + u3.y * bbi[13] + u3.z * bbi[14] + u3.w * bbi[15]);
                const float nre = ab_re * h_re - ab_im * h_im + sr, nim = ab_re * h_im + ab_im * h_re + si; h_re = nre; h_im = nim; hlr[i] = nre; hli[i] = nim; }
            Ere[F.wave * 64 + n] = h_re; Eim[F.wave * 64 + n] = h_im;
            LDS_BARRIER();
            float in_re = c_re, in_im = c_im;
#pragma unroll
            for (int w = 0; w < 8; ++w) {
                if (w == F.wave) { in_re = c_re; in_im = c_im; }
                const float er = Ere[w * 64 + n], ei = Eim[w * 64 + n];
                const float nre = pr[7] * c_re - pi[7] * c_im + er, nim = pr[7] * c_im + pi[7] * c_re + ei; c_re = nre; c_im = nim;
            }
#pragma unroll
            for (int i = 0; i < 8; ++i) { const int t = F.wave * 8 + i;
                hre[t * 68 + n] = hlr[i] + (pr[i] * in_re - pi[i] * in_im); him[t * 68 + n] = hli[i] + (pr[i] * in_im + pi[i] * in_re); }
            LDS_BARRIER();
            if (F.wave < 4) {
                const int t = F.wave * 16 + m;
                v4f acc = (v4f){0.f, 0.f, 0.f, 0.f};
#pragma unroll
                for (int ks = 0; ks < 4; ++ks) { const LAS float* hp = (ks < 2 ? hre : him) + t * 68 + 32 * (ks & 1) + 8 * q;
                    const v4f x = *(const LAS v4f*)hp, y = *(const LAS v4f*)(hp + 4);
                    v4u p; p.x = pk2(x.x, x.y); p.y = pk2(x.z, x.w); p.z = pk2(y.x, y.y); p.w = pk2(y.z, y.w);
                    acc = MFMA16(Cf[ks], __builtin_bit_cast(v8s, p), acc); }
                const v4f uv = *(const LAS v4f*)(us + t * 16 + 4 * q);
                v2u w; w.x = pk2(gelu_tanh(acc[0] + Dv.x * uv.x), gelu_tanh(acc[1] + Dv.y * uv.y)); w.y = pk2(gelu_tanh(acc[2] + Dv.z * uv.z), gelu_tanh(acc[3] + Dv.w * uv.w));
                *(v2u*)(yg + (r0 + t) * S5W + g * 16 + 4 * q) = w;
            }
            LDS_BARRIER();
        }
    }
}

namespace pg8 {
struct EpiGlu {
    static constexpr bool PERM = true, AFTER_DRAIN = false;
    unsigned char* O; int ldo; int ocol0; const bf16_t* Y; int ldy; const float* bias;
    __device__ __forceinline__ void operator()(const f32x4 (&acc)[2][2][4][2], const Unit& u, int wr, int wc, int fr, int fq) const {
        const int row0 = u.pm * BM + wr * 64 + fr, col0 = u.pn * BM + wc * 64 + 8 * fq;
#pragma unroll
        for (int ai = 0; ai < 2; ++ai)
#pragma unroll
            for (int m = 0; m < 4; ++m) { const int row = row0 + ai * HALF + m * 16;
#pragma unroll
                for (int bj = 0; bj < 2; ++bj) { const int col = col0 + bj * 32;
                    const f32x4 b0 = *(const f32x4*)(bias + col), b1 = *(const f32x4*)(bias + col + 4);
                    const f32x4 v0 = acc[ai][bj][m][0] + b0, v1 = acc[ai][bj][m][1] + b1;
                    const u32x4 yw = *(const u32x4*)(Y + (size_t)row * ldy + col);
                    float y[8]; unpack8(yw, y);
#if !FP8_OUT
                    { u32x4 wb; wb.x = pk2(y[0] * sigmoidf_(v0[0]), y[1] * sigmoidf_(v0[1])); wb.y = pk2(y[2] * sigmoidf_(v0[2]), y[3] * sigmoidf_(v0[3]));
                      wb.z = pk2(y[4] * sigmoidf_(v1[0]), y[5] * sigmoidf_(v1[1])); wb.w = pk2(y[6] * sigmoidf_(v1[2]), y[7] * sigmoidf_(v1[3]));
                      *(u32x4*)((bf16_t*)O + (size_t)row * ldo + ocol0 + col) = wb; continue; }
#endif
                    v2u w; w.x = pk4_fp8(clamp448(MIX8_SCALE * y[0] * sigmoidf_(v0[0])), clamp448(MIX8_SCALE * y[1] * sigmoidf_(v0[1])), clamp448(MIX8_SCALE * y[2] * sigmoidf_(v0[2])), clamp448(MIX8_SCALE * y[3] * sigmoidf_(v0[3])));
                    w.y = pk4_fp8(clamp448(MIX8_SCALE * y[4] * sigmoidf_(v1[0])), clamp448(MIX8_SCALE * y[5] * sigmoidf_(v1[1])), clamp448(MIX8_SCALE * y[6] * sigmoidf_(v1[2])), clamp448(MIX8_SCALE * y[7] * sigmoidf_(v1[3])));
                    *(v2u*)(O + (size_t)row * ldo + ocol0 + col) = w; } }
    }
};
struct EpiTiled {
    static constexpr bool PERM = true, AFTER_DRAIN = false;
    bf16_t* O; int ntn;
    __device__ __forceinline__ void operator()(const f32x4 (&acc)[2][2][4][2], const Unit& u, int wr, int wc, int fr, int fq) const {
        unsigned char* base = (unsigned char*)O + ((size_t)(u.pm * ntn + u.pn) * 8 + wr * 4 + wc) * 16384 + (size_t)(fq * 16 + fr) * 16;
#pragma unroll
        for (int ai = 0; ai < 2; ++ai)
#pragma unroll
            for (int m = 0; m < 4; ++m)
#pragma unroll
                for (int bj = 0; bj < 2; ++bj) { const f32x4 v0 = acc[ai][bj][m][0], v1 = acc[ai][bj][m][1];
                    u32x4 w; w.x = cvt_pk_bf16(v0[0], v0[1]); w.y = cvt_pk_bf16(v0[2], v0[3]); w.z = cvt_pk_bf16(v1[0], v1[1]); w.w = cvt_pk_bf16(v1[2], v1[3]);
                    *(u32x4*)(base + (size_t)(((ai * 4 + m) * 2 + bj) * 1024)) = w; }
    }
};
struct EpiTiled8 {
    static constexpr bool PERM = true, AFTER_DRAIN = false;
    unsigned char* O; int ntn;
    __device__ __forceinline__ void operator()(const f32x4 (&acc)[2][2][4][2], const Unit& u, int wr, int wc, int fr, int fq) const {
        unsigned char* base = O + ((size_t)(u.pm * ntn + u.pn) * 8 + wr * 4 + wc) * 8192 + (size_t)(fq * 16 + fr) * 16;
#pragma unroll
        for (int ai = 0; ai < 2; ++ai)
#pragma unroll
            for (int m = 0; m < 4; ++m) { u32x4 w;
                { const f32x4 v0 = acc[ai][0][m][0] * H8_SCALE, v1 = acc[ai][0][m][1] * H8_SCALE; w.x = pk4_fp8(clamp448(v0[0]), clamp448(v0[1]), clamp448(v0[2]), clamp448(v0[3])); w.y = pk4_fp8(clamp448(v1[0]), clamp448(v1[1]), clamp448(v1[2]), clamp448(v1[3])); }
                { const f32x4 v0 = acc[ai][1][m][0] * H8_SCALE, v1 = acc[ai][1][m][1] * H8_SCALE; w.z = pk4_fp8(clamp448(v0[0]), clamp448(v0[1]), clamp448(v0[2]), clamp448(v0[3])); w.w = pk4_fp8(clamp448(v1[0]), clamp448(v1[1]), clamp448(v1[2]), clamp448(v1[3])); }
                *(u32x4*)(base + (size_t)((ai * 4 + m) * 1024)) = w; }
    }
};
struct EpiNull { static constexpr bool PERM = true, AFTER_DRAIN = false; float* sink;
    __device__ __forceinline__ void operator()(const f32x4 (&acc)[2][2][4][2], const Unit& u, int wr, int wc, int fr, int fq) const {
        float s = 0.f;
#pragma unroll
        for (int a = 0; a < 2; ++a)
#pragma unroll
            for (int b = 0; b < 2; ++b)
#pragma unroll
                for (int m = 0; m < 4; ++m)
#pragma unroll
                    for (int n = 0; n < 2; ++n) s += acc[a][b][m][n][0] + acc[a][b][m][n][1] + acc[a][b][m][n][2] + acc[a][b][m][n][3];
        if (s == 123456.789f) sink[0] = s; } };
struct EpiFixed { static constexpr bool PERM = true, AFTER_DRAIN = false; EpiBf16<0> e;
    __device__ __forceinline__ void operator()(const f32x4 (&acc)[2][2][4][2], const Unit& u, int wr, int wc, int fr, int fq) const { const Unit z{0, 0}; e(acc, z, wr, wc, fr, fq); } };
}

struct RangeOrder : pg8::StaticOrder {
    int i0, i1;
    __device__ bool next(int i, pg8::Unit& u) const { return (i + i0 < i1) && pg8::StaticOrder::next(i + i0, u); }
};
template <int SW, int SX, class Epi>
__device__ __forceinline__ void gemm8_range(Frame& F, const unsigned char* A, const unsigned char* Bt, int M, int N, int K, int i0, int i1, const Epi& E) {
    if (i0 >= i1) return;
    pg8::Gemm g{(const bf16*)A, (const bf16*)Bt, M, N, K / 2}; RangeOrder S; S.init(M, N, F.G, F.bid); S.i0 = i0; S.i1 = i1;
    pg8::gemm_phase<Epi, RangeOrder, false, true, SW, SX>(F.lds, g, S, E, nullptr);
}
struct SameOrder : pg8::StaticOrder {
    int rounds;
    __device__ bool next(int i, pg8::Unit& u) const { if (i >= rounds) return false; u.pm = 0; u.pn = i; return true; }
};
template <int SW, int SX, class Epi>
__device__ __forceinline__ void gemm8_same(Frame& F, const unsigned char* A, const unsigned char* Bt, int M, int N, int K, int rounds, const Epi& E) {
    pg8::Gemm g{(const bf16*)A, (const bf16*)Bt, M, N, K / 2}; SameOrder S; S.init(M, N, F.G, F.bid); S.rounds = rounds;
    pg8::gemm_phase<Epi, SameOrder, false, true, SW, SX>(F.lds, g, S, E, nullptr);
}
template <class Epi>
__device__ __forceinline__ void gemm(Frame& F, const bf16* A, const bf16* Bt, int M, int N, int K, const Epi& E) {
    pg8::Gemm g{A, Bt, M, N, K}; pg8::StaticOrder S; S.init(M, N, F.G, F.bid);
    pg8::gemm_phase<Epi, pg8::StaticOrder, false, false>(F.lds, g, S, E, nullptr);
}
template <int SW, int SX, class Epi>
__device__ __forceinline__ void gemm8(Frame& F, const unsigned char* A, const unsigned char* Bt, int M, int N, int K, const Epi& E) {
    pg8::Gemm g{(const bf16*)A, (const bf16*)Bt, M, N, K / 2}; pg8::StaticOrder S; S.init(M, N, F.G, F.bid);
    pg8::gemm_phase<Epi, pg8::StaticOrder, false, true, SW, SX>(F.lds, g, S, E, nullptr);
}

#if HID8
#define PEER_EU const pg8::EpiTiled8 EU{ws + WS_HB, PE / 256}
#else
#define PEER_EU const pg8::EpiTiled EU{(bf16*)(ws + WS_HB), PE / 256}
#endif
#define PEER_LAYER(PB, L, HBF, H8, RESF, OUTF, OUTB, OUT8)                                                                                                            \
    if (IN(PB)) { if (FP8_WQ) gemm8<E8_WIN, E8_1>(F, (const unsigned char*)(H8), ws + ((L) ? WS_WQ1 : WS_WQ0), NTOK, PQ, DM, pg8::EpiTiled{(bf16*)(ws + WS_Q), PQ / 256}); \
        else gemm(F, (const bf16*)(HBF), (const bf16*)(ws + ((L) ? WS_WQ1 : WS_WQ0)), NTOK, PQ, DM, pg8::EpiTiled{(bf16*)(ws + WS_Q), PQ / 256}); SEAM(PB); }     \
    if (IN(PB + 1)) {     \
        { const int gsplit = F.bid & 7;     \
          PEER_EU;                                                                                     \
          gemm8_range<E8_U, E8_1>(F, (const unsigned char*)(H8), ws + ((L) ? WS_U8_1 : WS_U8_0), NTOK, PE, DM, 0, gsplit, EU);                                   \
          __syncthreads();                                                                                                                                        \
          REPEAT(REP_TOPK) peer_topk_phase(F, (const bf16*)(ws + WS_Q), (const bf16*)(ws + WS_KH) + (size_t)(L) * PH * 2 * PNK * PHALF, (const bf16*)(ws + WS_KL) + (size_t)(L) * PH * 2 * PNK * PHALF, (int*)(ws + WS_IDX), (float*)(ws + WS_GATE), ws + WS_WB);      \
          __syncthreads();                                                                                                                                        \
          if (!(L)) { p0_prologue(a, F, 2); __syncthreads(); }                                                                                                    \
          gemm8_range<E8_U, E8_1>(F, (const unsigned char*)(H8), ws + ((L) ? WS_U8_1 : WS_U8_0), NTOK, PE, DM, gsplit, 1 << 20, EU); }                           \
        SEAM(PB + 1); }    \
    if (IN(PB + 2)) { if (EXP_U == 1) gemm8<E8_U, E8_1>(F, (const unsigned char*)(H8), ws + ((L) ? WS_U8_1 : WS_U8_0), NTOK, PE, DM, pg8::EpiBf16<0>{(bf16*)(ws + WS_HB), PE, nullptr, 0, 0}); \
        if (EXP_U == 3) gemm8<E8_U, E8_1>(F, (const unsigned char*)(H8), ws + ((L) ? WS_U8_1 : WS_U8_0), NTOK, PE, DM, pg8::EpiFixed{pg8::EpiBf16<0>{(bf16*)(ws + WS_RES) + (size_t)F.bid * 256 * 256, 256, nullptr, 0, 0}}); \
        if (EXP_U == 2) gemm8<E8_U, E8_1>(F, (const unsigned char*)(H8), ws + ((L) ? WS_U8_1 : WS_U8_0), NTOK, PE, DM, pg8::EpiNull{(float*)(ws + WS_Q)}); \
        if (EXP_V) gemm8<E8_V, E8_W>(F, ws + WS_X8_1 - WS_X8_1 + WS_WB, ws + ((L) ? WS_VT8_1 : WS_VT8_0), NTOK, DM, PE, pg8::EpiBf16<0>{(bf16*)(ws + WS_MIX), DM, nullptr, 0, 0}); \
        REPEAT(REP_SPARSE) peer_sparse_phase(F, (const int*)(ws + WS_IDX), (const float*)(ws + WS_GATE), (const bf16*)(ws + WS_HB), ws + WS_WB); SEAM(PB + 2); }   \
    if (IN(PB + 3)) { gemm8<E8_V, E8_W>(F, ws + WS_WB, ws + ((L) ? WS_VT8_1 : WS_VT8_0), NTOK, DM, PE, pg8::EpiBf16<0>{(bf16*)(ws + WS_MIX), DM, nullptr, 0, 0}); SEAM(PB + 3); } \
    if (IN(PB + 4)) { REPEAT(REP_LN) ln_phase(F, (RESF), (const bf16*)(ws + WS_MIX), a.in[32] + (L) * DM, a.in[33] + (L) * DM, (OUTF), (OUTB), (OUT8)); SEAM(PB + 4); }

constexpr int N_PHASES = 22;
#ifndef ATTN_SPLIT
#define ATTN_SPLIT 448
#endif
#ifndef REP_PRO
#define REP_PRO 1
#endif
#ifndef REP_P2
#define REP_P2 1
#endif
#ifndef REP_REC
#define REP_REC 1
#endif
#ifndef REP_GS
#define REP_GS 1
#endif
#ifndef REP_LN
#define REP_LN 1
#endif
#ifndef REP_TOPK
#define REP_TOPK 1
#endif
#ifndef REP_SPARSE
#define REP_SPARSE 1
#endif
#ifndef REP_ATTN
#define REP_ATTN 1
#endif
#ifndef REP_S5
#define REP_S5 1
#endif
#ifndef REP_G8
#define REP_G8 1
#endif
#ifndef REP_G16
#define REP_G16 1
#endif
#ifndef REP_GP
#define REP_GP -1
#endif
#define RG16(p) (((p) == REP_GP) ? 2 : REP_G16)
#ifndef REP_PREP
#define REP_PREP 1
#endif
#ifndef REP_AB
#define REP_AB 1
#endif
#ifndef REP_RGG
#define REP_RGG 1
#endif
#ifndef REP_GATE
#define REP_GATE 1
#endif
#ifndef REP_SCAN
#define REP_SCAN 1
#endif
#ifndef REP_CA
#define REP_CA 1
#endif
#ifndef REP_CB
#define REP_CB 1
#endif
#ifndef EXP_U
#define EXP_U 0
#endif
#ifndef EXP_V
#define EXP_V 0
#endif
#ifndef SKEW_STEPS
#define SKEW_STEPS 0
#endif
#define SKEW_DELAY() do { _Pragma("unroll 1") for (int s_ = 0; s_ < SKEW_STEPS * (F.bid & 7); ++s_) __builtin_amdgcn_s_sleep(32); } while (0)
#define REPEAT(n) _Pragma("unroll 1") for (int rep_ = 0; rep_ < (n); ++rep_)

__global__ void __launch_bounds__(NTHR, 2) fwd_kernel(Args a) {
    extern __shared__ __attribute__((aligned(16))) unsigned char lds_raw[];
    Frame F; F.lds = (LAS unsigned char*)lds_raw; F.tid = threadIdx.x; F.lane = F.tid & 63; F.wave = __builtin_amdgcn_readfirstlane(F.tid >> 6); F.G = gridDim.x; F.bid = blockIdx.x;
    unsigned char* ws = a.ws;
    volatile LAS unsigned* MISC = (volatile LAS unsigned*)(F.lds + MISC_OFF);
    if (F.tid < 32) MISC[F.tid] = 0u;
    __syncthreads();
    const bool one_launch = (a.ph_hi - a.ph_lo) > 1;
    XcdBarrier bar; bar.bar = (unsigned*)(ws + WS_CTL) + CW_BAR; bar.x = 0; bar.st = nullptr;
    if (one_launch) bar = xcd_barrier_post((unsigned*)(ws + WS_CTL) + CW_BAR, MISC + 8);
    const int lo = a.ph_lo, hi = a.ph_hi;
#ifndef RG_UNDER
#define RG_UNDER 1
#endif
    const bool rg_under_ = RG_UNDER && one_launch && F.G == 256 && REP_CB == 1 && REP_SCAN == 1;
#define IN(k) (lo <= (k) && (k) < hi)
#ifdef PROBE_WAIT
#ifndef PROBE_MASK
#define PROBE_MASK 0xffffffu
#endif
    unsigned long long wait_total = 0ull;
#ifndef PROBE_PHM
#define PROBE_PHM 0u
#endif
    unsigned long long tprev_ = __builtin_amdgcn_s_memrealtime();
#define SEAM(k) do { if (IN((k) + 1)) { const unsigned long long t0_ = __builtin_amdgcn_s_memrealtime(); xcd_barrier(bar); const unsigned long long t1_ = __builtin_amdgcn_s_memrealtime(); if ((PROBE_MASK >> (k)) & 1) wait_total += t1_ - t0_; \
        if ((PROBE_PHM >> (k)) & 1) wait_total += (t1_ - tprev_) * 4; tprev_ = t1_; } } while (0)
#else
#define SEAM(k) do { if (IN((k) + 1)) xcd_barrier(bar); } while (0)
#endif

#ifdef EXTRA_BARS
    if (one_launch) { _Pragma("unroll 1") for (int i_ = 0; i_ < EXTRA_BARS; ++i_) xcd_barrier(bar); }
#endif
    if (IN(0)) { REPEAT(REP_PRO) p0_prologue(a, F, 0); SEAM(0); }
#if FP8_INE
    if (IN(1)) {
        const int gsplit = F.bid % 7;
        const pg8::EpiBf16<0> E1{(bf16*)(ws + WS_HB), EVEN_IN, nullptr, 0, 0};
        gemm8_range<E8_WIN, E8_1>(F, ws + WS_X8_0, ws + WS_WINE, NTOK, EVEN_IN, DM, 0, gsplit, E1);
        __syncthreads();
        p0_prologue(a, F, 1);
        __syncthreads();
        gemm8_range<E8_WIN, E8_1>(F, ws + WS_X8_0, ws + WS_WINE, NTOK, EVEN_IN, DM, gsplit, 1 << 20, E1);
        SEAM(1); }
#else
    if (IN(1)) { p0_prologue(a, F, 1); __syncthreads(); REPEAT(RG16(1)) gemm(F, (const bf16*)(ws + WS_XB0), (const bf16*)(ws + WS_WINE), NTOK, EVEN_IN, DM, pg8::EpiBf16<0>{(bf16*)(ws + WS_HB), EVEN_IN, nullptr, 0, 0}); SEAM(1); }
#endif
    if (IN(2)) { REPEAT(REP_P2) { REPEAT(REP_PREP) gdn_prep_phase(a, F); REPEAT(REP_AB) ab_proj_phase(a, F); REPEAT(REP_RGG) rg_gates_phase(a, F); } SEAM(2); }
    if (IN(3)) { REPEAT(REP_REC) { REPEAT(REP_CA) gdn_chunk_prep_phase(a, F); if (one_launch) xcd_barrier(bar);
#ifdef PROBE_CB
        { const unsigned long long t0_ = __builtin_amdgcn_s_memrealtime(); gdn_chunk_rec_phase(a, F); wait_total += (__builtin_amdgcn_s_memrealtime() - t0_) * PROBE_CB; }
#else
        if (rg_under_) { if (F.bid < 128) gdn_chunk_rec_phase(a, F); else { Frame F2 = F; F2.bid = F.bid - 128; F2.G = 128; rg_scan_phase(a, F2); } }
        else { REPEAT(REP_CB) gdn_chunk_rec_phase(a, F); }
#endif
        } SEAM(3); }
    if (IN(4)) { REPEAT(REP_GS) { REPEAT(REP_GATE) gdn_gate_phase(a, F); if (!rg_under_) { REPEAT(REP_SCAN) rg_scan_phase(a, F); } } SEAM(4); }
#if FP8_OUT
    if (IN(5)) { REPEAT(RG16(5)) gemm8<E8_WOUT, E8_MIX>(F, ws + WS_MIXED, ws + WS_WOUTE, NTOK, DM, DM, pg8::EpiBf16<0>{(bf16*)(ws + WS_MIX), DM, nullptr, 0, 0}); SEAM(5); }
#else
    if (IN(5)) { REPEAT(RG16(5)) gemm(F, (const bf16*)(ws + WS_MIXED), (const bf16*)(ws + WS_WOUTE), NTOK, DM, DM, pg8::EpiBf16<0>{(bf16*)(ws + WS_MIX), DM, nullptr, 0, 0}); SEAM(5); }
#endif
    if (IN(6)) { REPEAT(REP_LN) ln_phase(F, (const bf16*)(ws + WS_XB0), (const bf16*)(ws + WS_MIX), a.in[26], a.in[27], (float*)nullptr, (bf16*)(ws + WS_XB1), ws + WS_X8_1); SEAM(6); }
    PEER_LAYER(7, 0, ws + WS_XB1, ws + WS_X8_1, (const bf16*)(ws + WS_XB1), (float*)nullptr, (bf16*)(ws + WS_XB0), ws + WS_X8_0)
#if FP8_INO
    if (IN(12)) { REPEAT(RG16(12)) gemm8<E8_WIN, E8_1>(F, ws + WS_X8_0, ws + WS_WINO, NTOK, ODD_IN, DM, pg8::EpiBf16<0>{(bf16*)(ws + WS_HB), ODD_IN, nullptr, 0, 0}); SEAM(12); }
#else
    if (IN(12)) { REPEAT(RG16(12)) gemm(F, (const bf16*)(ws + WS_XB0), (const bf16*)(ws + WS_WINO), NTOK, ODD_IN, DM, pg8::EpiBf16<0>{(bf16*)(ws + WS_HB), ODD_IN, nullptr, 0, 0}); SEAM(12); }
#endif
    if (IN(13)) { REPEAT(REP_S5) s5_phase(a, F); SEAM(13); }
    if (IN(14)) {
        gemm(F, (const bf16*)(ws + WS_YG), (const bf16*)(ws + WS_GLU), NTOK, S5W, S5W, pg8::EpiGlu{ws + WS_MIXED, ODD_MIX, SBW, (const bf16*)(ws + WS_YG), S5W, a.in[24]});
        sb_attn_phase(a, F, (unsigned*)(ws + WS_CTL) + 16384, 0, 1024); SEAM(14); }
#if FP8_OUT
    if (IN(15)) { REPEAT(RG16(15)) gemm8<E8_WOUT, E8_MIX>(F, ws + WS_MIXED, ws + WS_WOUTO, NTOK, DM, ODD_MIX, pg8::EpiBf16<0>{(bf16*)(ws + WS_MIX), DM, nullptr, 0, 0}); SEAM(15); }
#else
    if (IN(15)) { REPEAT(RG16(15)) gemm(F, (const bf16*)(ws + WS_MIXED), (const bf16*)(ws + WS_WOUTO), NTOK, DM, ODD_MIX, pg8::EpiBf16<0>{(bf16*)(ws + WS_MIX), DM, nullptr, 0, 0}); SEAM(15); }
#endif
    if (IN(16)) { REPEAT(REP_LN) ln_phase(F, (const bf16*)(ws + WS_XB0), (const bf16*)(ws + WS_MIX), a.in[26] + DM, a.in[27] + DM, (float*)nullptr, (bf16*)(ws + WS_XB1), ws + WS_X8_1); SEAM(16); }
    PEER_LAYER(17, 1, ws + WS_XB1, ws + WS_X8_1, (const bf16*)(ws + WS_XB1), a.out, (bf16*)nullptr, (unsigned char*)nullptr)
#ifdef PROBE_WAIT
    if ((PROBE_WAIT < 0) || ((int)F.bid == PROBE_WAIT)) { const unsigned long long t0_ = __builtin_amdgcn_s_memrealtime(); while (__builtin_amdgcn_s_memrealtime() - t0_ < wait_total) __builtin_amdgcn_s_sleep(8); }
#endif
#undef IN
#undef SEAM
}

#ifndef MK_ONE_LAUNCH
#define MK_ONE_LAUNCH 1
#endif
extern "C" void kernel_launch(void* const* d_in, const int* in_sizes, int n_in, void* d_out, int out_size, void* d_ws, size_t ws_size, hipStream_t stream) {
    static int grid = 0;
    if (grid == 0) {
        if (n_in != 34 || in_sizes[0] != NTOK * DM || out_size != NTOK * DM || ws_size < WS_END) { fprintf(stderr, "kernel_launch: unexpected shapes (n_in %d, in0 %d, out %d, ws %zu < %zu); nothing launched\n", n_in, n_in > 0 ? in_sizes[0] : -1, out_size, ws_size, (size_t)WS_END); grid = -1; return; }
        int dev = 0, cus = 0, per_cu = 0;
        if (hipGetDevice(&dev) != hipSuccess || hipDeviceGetAttribute(&cus, hipDeviceAttributeMultiprocessorCount, dev) != hipSuccess) { grid = -1; return; }
        if (hipFuncSetAttribute((const void*)fwd_kernel, hipFuncAttributeMaxDynamicSharedMemorySize, LDS_BYTES) != hipSuccess) { fprintf(stderr, "kernel_launch: hipFuncSetAttribute failed\n"); grid = -1; return; }
        if (hipOccupancyMaxActiveBlocksPerMultiprocessor(&per_cu, (const void*)fwd_kernel, NTHR, LDS_BYTES) != hipSuccess || per_cu < 1) { fprintf(stderr, "kernel_launch: occupancy query says %d blocks per CU\n", per_cu); }
        (void)hipGetLastError();
        grid = cus;
    }
    if (grid < 0) return;
    (void)hipMemsetAsync((char*)d_ws + WS_CTL, 0, CTL_ZERO_BYTES, stream);
    Args a{};
    for (int i = 0; i < 34; ++i) a.in[i] = (const float*)d_in[i];
    a.out = (float*)d_out; a.ws = (unsigned char*)d_ws;
#if MK_ONE_LAUNCH
    a.ph_lo = 0; a.ph_hi = N_PHASES;
    hipLaunchKernelGGL(fwd_kernel, dim3(grid), dim3(NTHR), LDS_BYTES, stream, a);
#else
    for (int p = 0; p < N_PHASES; ++p) { a.ph_lo = p; a.ph_hi = p + 1; hipLaunchKernelGGL(fwd_kernel, dim3(grid), dim3(NTHR), LDS_BYTES, stream, a); }
#endif
}
```
